# Optimizing an MI355X kernel written in HIP

```python
import math
import jax, jax.numpy as jnp
from jax import lax
import numpy as np

D_MODEL = 2048
BATCH = 4
SEQ = 4096
DEPTH = 1
DEC_BATCH = 128
DEC_SEQ = 8
PAST_LEN = 16384
PAGE_SIZE = 128

ATT_HEADS = 32
ATT_KV_HEADS = 8
ATT_GROUP = ATT_HEADS // ATT_KV_HEADS
ATT_HEAD_DIM = 64
WINDOW = 128
ATT_BLOCK = WINDOW
N_BUCKETS = 32
MAX_DISTANCE = 128
ML_HEADS = 4
ML_DK = 256
ML_DV = 512
ML_CONV = 4
ML_CHUNK = 64
PEER_HEADS = 8
PEER_NKEYS = 128
PEER_N_EXPERTS = PEER_NKEYS * PEER_NKEYS
PEER_TOPK = 16
PEER_DQ = 256
PEER_BLOCK = 64

ATT_Q_W = ATT_HEADS * ATT_HEAD_DIM
ATT_KV_W = ATT_KV_HEADS * ATT_HEAD_DIM
ML_QK_W = ML_HEADS * ML_DK
ML_V_W = ML_HEADS * ML_DV
IN_W = ATT_Q_W + 2 * ATT_KV_W + 2 * ML_QK_W + 2 * ML_V_W + 2 * ML_HEADS + 2 * D_MODEL
ALPHA = (2.0 * DEPTH) ** 0.25
BETA = (8.0 * DEPTH) ** -0.25
LN_EPS = 1e-5
NEG = -1e30

kernel_name = 'hybrid_swa_mlstm_peer_step'


def _split_points():
    widths = (ATT_Q_W, ATT_KV_W, ATT_KV_W, 2 * ML_QK_W, ML_V_W, ML_HEADS, ML_HEADS, ML_V_W, D_MODEL, D_MODEL)
    pts, acc = [], 0
    for w in widths[:-1]:
        acc += w
        pts.append(acc)
    return pts


def layer_norm(x, g, b):
    xf = x.astype(jnp.float32)
    mu = xf.mean(-1, keepdims=True)
    var = jnp.mean(jnp.square(xf - mu), -1, keepdims=True)
    return ((xf - mu) * lax.rsqrt(var + LN_EPS) * g + b).astype(x.dtype)


def head_norm(h, g):
    mu = h.mean(-1, keepdims=True)
    var = jnp.mean(jnp.square(h - mu), -1, keepdims=True)
    return (h - mu) * lax.rsqrt(var + LN_EPS) * g.reshape(ML_HEADS, ML_DV).astype(jnp.float32)


def t5_bucket(dist):
    max_exact = N_BUCKETS // 2
    d = jnp.maximum(dist, 0)
    dl = jnp.maximum(d, max_exact).astype(jnp.float32)
    large = max_exact + (jnp.log(dl / max_exact) / math.log(MAX_DISTANCE / max_exact)
                         * (N_BUCKETS - max_exact)).astype(jnp.int32)
    large = jnp.minimum(large, N_BUCKETS - 1)
    return jnp.where(d < max_exact, d, large)


def sink_attention(q, k, v, dist, mask, rel_table, sinks):
    lq, lk = dist.shape
    bias = jnp.transpose(rel_table[t5_bucket(dist)], (2, 0, 1))
    bias = bias.reshape(ATT_KV_HEADS, ATT_GROUP, lq, lk).astype(jnp.float32)
    s = jnp.einsum('bnqhgd,bnkhd->bnhgqk', q, k).astype(jnp.float32) * (ATT_HEAD_DIM ** -0.5) + bias
    s = jnp.where(mask, s, NEG)
    sink = sinks.astype(jnp.float32).reshape(ATT_KV_HEADS, ATT_GROUP, 1, 1)
    m = jnp.maximum(s.max(-1, keepdims=True), sink)
    p = jnp.exp(s - m)
    p = p / (p.sum(-1, keepdims=True) + jnp.exp(sink - m))
    return jnp.einsum('bnhgqk,bnkhd->bnqhgd', p.astype(v.dtype), v)


def swa_prompt(q, k, v, rel_table, sinks):
    B, T = q.shape[:2]
    nb = T // ATT_BLOCK
    qb = q.reshape(B, nb, ATT_BLOCK, ATT_KV_HEADS, ATT_GROUP, ATT_HEAD_DIM)
    kb = k.reshape(B, nb, ATT_BLOCK, ATT_KV_HEADS, ATT_HEAD_DIM)
    vb = v.reshape(B, nb, ATT_BLOCK, ATT_KV_HEADS, ATT_HEAD_DIM)
    pad = ((0, 0), (1, 0), (0, 0), (0, 0), (0, 0))
    kk = jnp.concatenate([jnp.pad(kb, pad)[:, :-1], kb], axis=2)
    vv = jnp.concatenate([jnp.pad(vb, pad)[:, :-1], vb], axis=2)
    qi = jnp.arange(ATT_BLOCK)[:, None] + ATT_BLOCK
    kj = jnp.arange(2 * ATT_BLOCK)[None, :]
    dist = qi - kj
    band = (dist >= 0) & (dist < WINDOW)
    has_prev = jnp.arange(nb)[:, None, None] > 0
    mask = band[None] & (has_prev | (kj >= ATT_BLOCK)[None])
    out = sink_attention(qb, kk, vv, dist, mask[None, :, None, None], rel_table, sinks)
    return out.reshape(B, T, ATT_KV_HEADS, ATT_GROUP, ATT_HEAD_DIM)


def swa_sample(q, k, v, kwin, vwin, rel_table, sinks):
    T = q.shape[1]
    wc = kwin.shape[1]
    kk = jnp.concatenate([kwin.astype(k.dtype), k], axis=1)
    vv = jnp.concatenate([vwin.astype(v.dtype), v], axis=1)
    dist = (jnp.arange(T)[:, None] + wc) - jnp.arange(wc + T)[None, :]
    mask = (dist >= 0) & (dist < WINDOW)
    out = sink_attention(q[:, None], kk[:, None], vv[:, None], dist, mask, rel_table, sinks)[:, 0]
    return out, kk[:, T:], vv[:, T:]


def causal_conv(x, buf, w, b):
    T = x.shape[1]
    xx = jnp.concatenate([buf.astype(x.dtype), x], axis=1)
    y = b + xx[:, 0:T] * w[0]
    for j in range(1, ML_CONV):
        y = y + xx[:, j:j + T] * w[j]
    return y, xx[:, T:]


def _to_chunks(a, nc, L):
    a = a.reshape((a.shape[0], nc, L) + a.shape[2:])
    return jnp.moveaxis(jnp.moveaxis(a, 1, 0), 2, 3)


def mlstm_chunkwise(q, k, v, i_pre, logf, C0, n0, m0):
    B, T = q.shape[:2]
    L = min(ML_CHUNK, T)
    nc = -(-T // L)
    pad = nc * L - T
    p4 = ((0, 0), (0, pad), (0, 0), (0, 0))
    p3 = ((0, 0), (0, pad), (0, 0))
    qc = _to_chunks(jnp.pad(q, p4), nc, L)
    kc = _to_chunks(jnp.pad(k, p4), nc, L)
    vc = _to_chunks(jnp.pad(v, p4), nc, L)
    ic = _to_chunks(jnp.pad(i_pre, p3, constant_values=NEG), nc, L)
    fc = _to_chunks(jnp.pad(logf, p3), nc, L)
    tri = jnp.tril(jnp.ones((L, L), bool))

    def step(carry, xs):
        C, n, m = carry
        qx, kx, vx, ix, fx = xs
        bcum = jnp.cumsum(fx, axis=-1)
        dmat = jnp.where(tri, bcum[..., :, None] - bcum[..., None, :] + ix[..., None, :], NEG)
        inter = bcum + m[..., None]
        mt = jnp.maximum(inter, dmat.max(-1))
        s = jnp.einsum('bhtd,bhsd->bhts', qx, kx) * jnp.exp(dmat - mt[..., None])
        w_in = jnp.exp(inter - mt)
        num = jnp.einsum('bhts,bhsv->bhtv', s, vx) + w_in[..., None] * jnp.einsum('bhtd,bhdv->bhtv', qx, C)
        den = s.sum(-1) + w_in * jnp.einsum('bhtd,bhd->bht', qx, n)
        h = num / jnp.maximum(jnp.abs(den), jnp.exp(-mt))[..., None]
        b_last = bcum[..., -1]
        dec = b_last[..., None] - bcum + ix
        m_new = jnp.maximum(b_last + m, dec.max(-1))
        wk = jnp.exp(dec - m_new[..., None])
        decay = jnp.exp(b_last + m - m_new)
        C_new = decay[..., None, None] * C + jnp.einsum('bhsd,bhsv->bhdv', wk[..., None] * kx, vx)
        n_new = decay[..., None] * n + jnp.einsum('bhs,bhsd->bhd', wk, kx)
        return (C_new, n_new, m_new), h

    (C1, n1, m1), hs = lax.scan(step, (C0, n0, m0), (qc, kc, vc, ic, fc))
    h = jnp.transpose(hs, (1, 0, 3, 2, 4)).reshape(B, nc * L, ML_HEADS, ML_DV)[:, :T]
    return h, C1, n1, m1


def token_mixer(h, state, rel_table, w_in, b_i, b_f, conv_w, conv_b, ml_norm_g, sinks, w_a, w_b, w_out):
    B, T, _ = h.shape
    aq, ak, av, mqk, mv, mi, mf, mo, ga, gb = jnp.split(h @ w_in, _split_points(), axis=-1)
    aq = aq.reshape(B, T, ATT_KV_HEADS, ATT_GROUP, ATT_HEAD_DIM)
    ak = ak.reshape(B, T, ATT_KV_HEADS, ATT_HEAD_DIM)
    av = av.reshape(B, T, ATT_KV_HEADS, ATT_HEAD_DIM)
    if state is None:
        att = swa_prompt(aq, ak, av, rel_table, sinks)
        keep = min(WINDOW, T)
        k_keep, v_keep = ak[:, T - keep:], av[:, T - keep:]
        conv_buf = jnp.zeros((B, ML_CONV - 1, 2 * ML_QK_W), h.dtype)
        C0 = jnp.zeros((B, ML_HEADS, ML_DK, ML_DV), jnp.float32)
        n0 = jnp.zeros((B, ML_HEADS, ML_DK), jnp.float32)
        m0 = jnp.zeros((B, ML_HEADS), jnp.float32)
    else:
        kwin, vwin, conv_buf, C0, n0, m0 = state
        att, k_keep, v_keep = swa_sample(aq, ak, av, kwin, vwin, rel_table, sinks)
    y_a = att.reshape(B, T, ATT_Q_W) @ w_a
    qk, conv_keep = causal_conv(mqk, conv_buf, conv_w, conv_b)
    qk = jax.nn.silu(qk).astype(jnp.float32)
    mq = qk[..., :ML_QK_W].reshape(B, T, ML_HEADS, ML_DK)
    mk = qk[..., ML_QK_W:].reshape(B, T, ML_HEADS, ML_DK) * (ML_DK ** -0.5)
    mvv = mv.astype(jnp.float32).reshape(B, T, ML_HEADS, ML_DV)
    i_pre = (mi + b_i).astype(jnp.float32)
    logf = jax.nn.log_sigmoid((mf + b_f).astype(jnp.float32))
    hm, C1, n1, m1 = mlstm_chunkwise(mq, mk, mvv, i_pre, logf, C0.astype(jnp.float32),
                                     n0.astype(jnp.float32), m0.astype(jnp.float32))
    hm = head_norm(hm, ml_norm_g).reshape(B, T, ML_V_W).astype(h.dtype)
    y_b = (jax.nn.sigmoid(mo) * hm) @ w_b
    y = (jax.nn.sigmoid(ga) * y_a + jax.nn.sigmoid(gb) * y_b) @ w_out
    return y, (k_keep, v_keep, conv_keep, C1, n1, m1)


def peer_ffn(h, w_pq, sub_keys, peer_u, peer_v):
    B, T, D = h.shape
    xt = h.reshape(B * T, D)
    n_tok = B * T
    npad = (-n_tok) % PEER_BLOCK
    xt = jnp.pad(xt, ((0, npad), (0, 0))).reshape(-1, PEER_BLOCK, D)

    def block(xb):
        q = (xb @ w_pq).reshape(PEER_BLOCK, PEER_HEADS, 2, PEER_DQ // 2)
        s = jnp.einsum('thpd,hpkd->thpk', q, sub_keys).astype(jnp.float32)
        sv, si = lax.top_k(s, PEER_TOPK)
        cand = (sv[..., 0, :, None] + sv[..., 1, None, :]).reshape(PEER_BLOCK, PEER_HEADS, PEER_TOPK * PEER_TOPK)
        cid = (si[..., 0, :, None] * PEER_NKEYS + si[..., 1, None, :]).reshape(PEER_BLOCK, PEER_HEADS, PEER_TOPK * PEER_TOPK)
        top_s, pos = lax.top_k(cand, PEER_TOPK)
        eid = jnp.take_along_axis(cid, pos, axis=-1)
        g = jax.nn.softmax(top_s, axis=-1)
        act = jax.nn.gelu(jnp.einsum('thkd,td->thk', peer_u[eid], xb).astype(jnp.float32), approximate=False)
        return jnp.einsum('thk,thkd->td', (g * act).astype(xb.dtype), peer_v[eid])

    out = lax.map(block, xt)
    return out.reshape(-1, D)[:n_tok].reshape(B, T, D)


def decoder_layer(x, c, state, prm):
    (rel_table, w_ada, b_ada, w_in, b_i, b_f, conv_w, conv_b, ml_norm_g, sinks,
     w_a, w_b, w_out, ln1_g, ln1_b, w_pq, sub_keys, peer_u, peer_v, ln2_g, ln2_b) = prm
    ada = jax.nn.silu(c) @ w_ada + b_ada
    sh1, sc1, g1, sh2, sc2, g2 = jnp.split(ada[:, None, :], 6, axis=-1)
    h1 = x * (1 + sc1) + sh1
    mix, new_state = token_mixer(h1, state, rel_table, w_in, b_i, b_f, conv_w, conv_b, ml_norm_g,
                                 sinks, w_a, w_b, w_out)
    x = layer_norm(ALPHA * x + g1 * mix, ln1_g, ln1_b)
    h2 = x * (1 + sc2) + sh2
    x = layer_norm(ALPHA * x + g2 * peer_ffn(h2, w_pq, sub_keys, peer_u, peer_v), ln2_g, ln2_b)
    return x, new_state


def _stack_states(per_layer):
    return [jnp.stack([s[i] for s in per_layer]) for i in range(6)]


def setup_inputs(seed: int = 0) -> dict:
    key = jax.random.key(seed)
    ks = jax.random.split(key, 40)
    f32 = jnp.float32

    def nrm(k, shape, scale):
        return jax.random.normal(k, shape, f32) * scale

    W_C = min(WINDOW, PAST_LEN)
    D = D_MODEL
    return {
        'x_prompt': nrm(ks[0], (BATCH, SEQ, D), 1.0),
        'x_sample': nrm(ks[1], (DEC_BATCH, DEC_SEQ, D), 1.0),
        'c_prompt': nrm(ks[2], (BATCH, D), 1.0),
        'c_sample': nrm(ks[3], (DEC_BATCH, D), 1.0),
        'cache_k_win': nrm(ks[4], (DEPTH, DEC_BATCH, W_C, ATT_KV_HEADS, ATT_HEAD_DIM), 1.0),
        'cache_v_win': nrm(ks[5], (DEPTH, DEC_BATCH, W_C, ATT_KV_HEADS, ATT_HEAD_DIM), 1.0),
        'state_conv': nrm(ks[6], (DEPTH, DEC_BATCH, ML_CONV - 1, 2 * ML_QK_W), 1.0),
        'state_C': nrm(ks[7], (DEPTH, DEC_BATCH, ML_HEADS, ML_DK, ML_DV), 0.1),
        'state_n': nrm(ks[8], (DEPTH, DEC_BATCH, ML_HEADS, ML_DK), 0.1),
        'state_m': nrm(ks[9], (DEPTH, DEC_BATCH, ML_HEADS), 0.5),
        'rel_bias_table': nrm(ks[10], (N_BUCKETS, ATT_HEADS), 0.5),
        'w_ada': nrm(ks[11], (DEPTH, D, 6 * D), 0.5 * D ** -0.5),
        'b_ada': nrm(ks[12], (DEPTH, 6 * D), 0.02),
        'w_in': nrm(ks[13], (DEPTH, D, IN_W), D ** -0.5),
        'b_i': nrm(ks[14], (DEPTH, ML_HEADS), 0.1),
        'b_f': 3.0 + nrm(ks[15], (DEPTH, ML_HEADS), 0.1),
        'conv_w': nrm(ks[16], (DEPTH, ML_CONV, 2 * ML_QK_W), ML_CONV ** -0.5),
        'conv_b': nrm(ks[17], (DEPTH, 2 * ML_QK_W), 0.02),
        'ml_norm_g': 1.0 + nrm(ks[18], (DEPTH, ML_V_W), 0.02),
        'att_sinks': nrm(ks[19], (DEPTH, ATT_HEADS), 0.5),
        'w_a': nrm(ks[20], (DEPTH, ATT_Q_W, D), BETA * ATT_Q_W ** -0.5),
        'w_b': nrm(ks[21], (DEPTH, ML_V_W, D), BETA * ML_V_W ** -0.5),
        'w_out': nrm(ks[22], (DEPTH, D, D), BETA * D ** -0.5),
        'ln1_g': 1.0 + nrm(ks[23], (DEPTH, D), 0.02),
        'ln1_b': nrm(ks[24], (DEPTH, D), 0.02),
        'w_pq': nrm(ks[25], (DEPTH, D, PEER_HEADS * PEER_DQ), D ** -0.5),
        'peer_sub_keys': nrm(ks[26], (DEPTH, PEER_HEADS, 2, PEER_NKEYS, PEER_DQ // 2), (PEER_DQ // 2) ** -0.5),
        'peer_u': nrm(ks[27], (DEPTH, PEER_N_EXPERTS, D), D ** -0.5),
        'peer_v': nrm(ks[28], (DEPTH, PEER_N_EXPERTS, D), BETA * PEER_HEADS ** -0.5),
        'ln2_g': 1.0 + nrm(ks[29], (DEPTH, D), 0.02),
        'ln2_b': nrm(ks[30], (DEPTH, D), 0.02),
    }


def reference(x_prompt, x_sample, c_prompt, c_sample, cache_k_win, cache_v_win, state_conv,
              state_C, state_n, state_m, rel_bias_table, w_ada, b_ada, w_in, b_i, b_f, conv_w, conv_b,
              ml_norm_g, att_sinks, w_a, w_b, w_out, ln1_g, ln1_b, w_pq, peer_sub_keys, peer_u, peer_v,
              ln2_g, ln2_b):
    yp, ys = x_prompt, x_sample
    new_p, new_s = [], []
    for l in range(DEPTH):
        prm = (rel_bias_table, w_ada[l], b_ada[l], w_in[l], b_i[l], b_f[l], conv_w[l], conv_b[l],
               ml_norm_g[l], att_sinks[l], w_a[l], w_b[l], w_out[l], ln1_g[l], ln1_b[l], w_pq[l],
               peer_sub_keys[l], peer_u[l], peer_v[l], ln2_g[l], ln2_b[l])
        yp, sp = decoder_layer(yp, c_prompt, None, prm)
        ys, ss = decoder_layer(ys, c_sample, (cache_k_win[l], cache_v_win[l], state_conv[l],
                                              state_C[l], state_n[l], state_m[l]), prm)
        new_p.append(sp)
        new_s.append(ss)
    kw_p, vw_p, conv_p, C_p, n_p, m_p = _stack_states(new_p)
    kw_s, vw_s, conv_s, C_s, n_s, m_s = _stack_states(new_s)
    return (yp, ys, kw_p, vw_p, conv_p, C_p, n_p, m_p, kw_s, vw_s, conv_s, C_s, n_s, m_s)
```

```cpp
#include <hip/hip_runtime.h>
#include <cstdio>
#include <cstdint>
#include <cmath>

#define GAS __attribute__((address_space(1)))
#define LAS __attribute__((address_space(3)))
typedef unsigned short bf16_t;
typedef short bf16x8 __attribute__((ext_vector_type(8)));
typedef float f32x4 __attribute__((ext_vector_type(4)));
typedef float f32x2 __attribute__((ext_vector_type(2)));
typedef unsigned u32x4 __attribute__((ext_vector_type(4)));
typedef unsigned u32x2 __attribute__((ext_vector_type(2)));

constexpr int D = 2048, BATCH = 4, SEQ = 4096, DEC_BATCH = 128, DEC_SEQ = 8;
constexpr int MP = BATCH * SEQ, MS = DEC_BATCH * DEC_SEQ, M = MP + MS;
constexpr int NB = BATCH + DEC_BATCH;
constexpr int HEADS = 32, KVH = 8, HD = 64, WINDOW = 128;
constexpr int MLH = 4, DK = 256, DV = 512;
constexpr int PH = 8, NKEYS = 128, TOPK = 16, DQ = 256;
constexpr int INW = 13320, NW = 13312;
constexpr int C_AQ = 0, C_AK = 2048, C_AV = 2560, C_MQK = 3072, C_MV = 5120, C_MO = 7168, C_GA = 9216, C_GB = 11264;
constexpr int SRC_MIF = 7168;
constexpr float LN_EPS = 1e-5f;
constexpr float ALPHA = 1.189207115002721f;

constexpr size_t O_YP = 0, O_YS = O_YP + (size_t)MP * D, O_KWP = O_YS + (size_t)MS * D, O_VWP = O_KWP + 4 * 128 * 512, O_CONVP = O_VWP + 4 * 128 * 512,
                 O_CP = O_CONVP + 4 * 3 * 2048, O_NP = O_CP + (size_t)4 * 4 * 256 * 512, O_MPO = O_NP + 4 * 4 * 256, O_KWS = O_MPO + 16,
                 O_VWS = O_KWS + (size_t)128 * 128 * 512, O_CONVS = O_VWS + (size_t)128 * 128 * 512, O_CS = O_CONVS + (size_t)128 * 3 * 2048,
                 O_NS = O_CS + (size_t)128 * 4 * 256 * 512, O_MSO = O_NS + 128 * 4 * 256, O_END = O_MSO + 512;

constexpr size_t MiB = 1u << 20;
constexpr size_t WS_CTL = 0, CTL_ZERO_BYTES = 1 * MiB;
constexpr size_t WS_ADA = 1 * MiB;
constexpr size_t WS_H2I = 60 * MiB, WS_HSC = 100 * MiB;
constexpr size_t WS_WMIF = 8 * MiB;
constexpr size_t WS_MIF = 9 * MiB;
constexpr size_t WS_EID = 10 * MiB;
constexpr size_t WS_GATE = 19 * MiB;
constexpr size_t WS_W4T = 28 * MiB;
constexpr size_t WS_WINT = 60 * MiB;
constexpr size_t WS_H1 = 112 * MiB;
constexpr size_t WS_HMO = 180 * MiB;
constexpr size_t WS_Z = 248 * MiB;
constexpr size_t WS_T = 316 * MiB;
constexpr size_t WS_BIG = 452 * MiB;
constexpr size_t WS_U8 = 896 * MiB;
constexpr size_t WS_V8 = 928 * MiB;
constexpr size_t WS_PSC = 960 * MiB;
constexpr size_t WS_W4F8 = 962 * MiB;
constexpr size_t WS_WINF8 = 978 * MiB;
constexpr size_t WS_END = 1004 * MiB;
static_assert(WS_BIG + (size_t)M * NW * 2 <= WS_END, "ws map");
static_assert(WS_T + (size_t)M * D * 4 <= WS_BIG && WS_Z + (size_t)M * D * 2 <= WS_T && WS_HMO + (size_t)M * D * 2 <= WS_Z && WS_H1 + (size_t)M * D * 2 <= WS_HMO, "ws map");
static_assert(WS_WINT + (size_t)NW * D * 2 <= WS_H1 && WS_W4T + (size_t)4 * D * D * 2 <= WS_WINT && WS_GATE + (size_t)M * 128 * 4 <= WS_W4T && WS_EID + (size_t)M * 128 * 4 <= WS_GATE, "ws map");
constexpr size_t WS_QC = WS_T;
constexpr size_t WS_KWT = WS_T + 32 * MiB;
constexpr size_t WS_VT = WS_T + 64 * MiB;
constexpr size_t WS_SM = WS_T + 128 * MiB;
constexpr size_t WS_MG = WS_GATE;
constexpr int MG_A1 = 0, MG_G = 65536, MG_WIN = 131072, MG_EMI = 196608, MG_WK = 262144, MG_DEC = 327680;
constexpr int MG_AC = 393216, MG_RS = 655360, MG_NALL = 720896;
constexpr size_t WS_SKB = WS_PSC + 256 * 1024;
constexpr size_t SLAB_BYTES = (size_t)16384 * 128;
constexpr size_t WS_PEERO = WS_BIG;
constexpr size_t WS_COEF = WS_BIG + 140 * MiB;
constexpr size_t WS_ATT8 = WS_H1;
constexpr size_t WS_HMO8 = WS_H1 + 34 * MiB;
constexpr size_t WS_H1F8 = WS_HMO;
constexpr size_t WS_Z8 = WS_HMO;
constexpr size_t WS_H28 = WS_HMO;
constexpr float ACT_S = 8.0f, Z_S = 16.0f, W_S = 64.0f;
constexpr int CW_BAR = 4096;

constexpr int RING_BYTES = 131072;
constexpr int LDS_BYTES = 163840;
constexpr int LDSCTL_OFF = LDS_BYTES - 1024, MISC_OFF = LDSCTL_OFF + 320;
constexpr int NWAVES = 8, NTHREADS = 512;
#ifndef ATT_P3
#define ATT_P3 64
#endif
#ifndef SAMP_P3
#define SAMP_P3 512
#endif

typedef __bf16 bf16x2_t __attribute__((ext_vector_type(2)));
__device__ __forceinline__ unsigned pk2(float lo, float hi) { f32x2 v = {lo, hi}; bf16x2_t b = __builtin_convertvector(v, bf16x2_t); return __builtin_bit_cast(unsigned, b); }
__device__ __forceinline__ unsigned f2bf(float f) { return pk2(f, 0.f) & 0xffffu; }
__device__ __forceinline__ float bf2f(unsigned short b) { return __builtin_bit_cast(float, (unsigned)b << 16); }
__device__ __forceinline__ float bflo(unsigned w) { return __builtin_bit_cast(float, w << 16); }
__device__ __forceinline__ float bfhi(unsigned w) { return __builtin_bit_cast(float, w & 0xffff0000u); }
__device__ __forceinline__ float sigmoidf_(float x) { return 1.0f / (1.0f + expf(-x)); }
__device__ __forceinline__ float xsum16(float x) { const auto q = __builtin_amdgcn_permlane16_swap(__float_as_uint(x), __float_as_uint(x), false, false); return __uint_as_float(q[0]) + __uint_as_float(q[1]); }
__device__ __forceinline__ float xsum32(float x) { const auto q = __builtin_amdgcn_permlane32_swap(__float_as_uint(x), __float_as_uint(x), false, false); return __uint_as_float(q[0]) + __uint_as_float(q[1]); }
__device__ __forceinline__ float row_sum16(float x) {
    x += __builtin_bit_cast(float, __builtin_amdgcn_update_dpp(0, __builtin_bit_cast(int, x), 0xB1, 0xF, 0xF, true));
    x += __builtin_bit_cast(float, __builtin_amdgcn_update_dpp(0, __builtin_bit_cast(int, x), 0x4E, 0xF, 0xF, true));
    x += __builtin_bit_cast(float, __builtin_amdgcn_update_dpp(0, __builtin_bit_cast(int, x), 0x141, 0xF, 0xF, true));
    x += __builtin_bit_cast(float, __builtin_amdgcn_update_dpp(0, __builtin_bit_cast(int, x), 0x140, 0xF, 0xF, true));
    return x;
}
__device__ __forceinline__ float wave_sum(float v) { return xsum32(xsum16(row_sum16(v))); }
__device__ __forceinline__ float wave_max(float x) {
    x = fmaxf(x, __builtin_bit_cast(float, __builtin_amdgcn_update_dpp(0, __builtin_bit_cast(int, x), 0xB1, 0xF, 0xF, true)));
    x = fmaxf(x, __builtin_bit_cast(float, __builtin_amdgcn_update_dpp(0, __builtin_bit_cast(int, x), 0x4E, 0xF, 0xF, true)));
    x = fmaxf(x, __builtin_bit_cast(float, __builtin_amdgcn_update_dpp(0, __builtin_bit_cast(int, x), 0x141, 0xF, 0xF, true)));
    x = fmaxf(x, __builtin_bit_cast(float, __builtin_amdgcn_update_dpp(0, __builtin_bit_cast(int, x), 0x140, 0xF, 0xF, true)));
    { const auto q = __builtin_amdgcn_permlane16_swap(__float_as_uint(x), __float_as_uint(x), false, false); x = fmaxf(__uint_as_float(q[0]), __uint_as_float(q[1])); }
    { const auto q = __builtin_amdgcn_permlane32_swap(__float_as_uint(x), __float_as_uint(x), false, false); x = fmaxf(__uint_as_float(q[0]), __uint_as_float(q[1])); }
    return x;
}
__device__ __forceinline__ float sat8(float v) { return __builtin_amdgcn_fmed3f(v, -448.0f, 448.0f); }
__device__ __forceinline__ unsigned pk4_i8(float a, float b, float c, float d) {
    const float mg = 12582912.0f; const unsigned ua = __builtin_bit_cast(unsigned, a + mg), ub = __builtin_bit_cast(unsigned, b + mg), uc = __builtin_bit_cast(unsigned, c + mg), ud = __builtin_bit_cast(unsigned, d + mg);
    return (ua & 255u) | ((ub & 255u) << 8) | ((uc & 255u) << 16) | (ud << 24); }
__device__ __forceinline__ unsigned pk4_fp8(float a, float b, float c, float d) { int p = 0; p = __builtin_amdgcn_cvt_pk_fp8_f32(sat8(a), sat8(b), p, false); p = __builtin_amdgcn_cvt_pk_fp8_f32(sat8(c), sat8(d), p, true); return (unsigned)p; }
#define LDS_WAIT() asm volatile("s_waitcnt lgkmcnt(0)" ::: "memory")
#define VM_WAIT() asm volatile("s_waitcnt vmcnt(0)" ::: "memory")

namespace pg8 {
constexpr int BM = 256, BK = 64, HALF = 128, HTB = HALF * BK * 2, STAGE_BYTES = 8 * HTB, NXCD = 8, WGM = 8;
__host__ __device__ __forceinline__ int lds_byte(int r, int c) { const int st = (r >> 4) * 2 + (c >> 5), rr = r & 15, cc = c & 31, ob = rr * 64 + cc * 2; return st * 1024 + (ob ^ (((ob >> 9) & 1) << 5)); }
__host__ __device__ __forceinline__ void stage_rc(int b, int& R, int& C) { const int st = b / 1024, sb = b % 1024, swz = sb ^ (((sb >> 9) & 1) << 5); R = (st >> 1) * 16 + swz / 64; C = (st & 1) * 32 + (swz % 64) / 2; }
__host__ __device__ __forceinline__ int perm32(int rho) { const int n = rho >> 4, i = rho & 15; return 8 * (i >> 2) + 4 * n + (i & 3); }
struct Unit { int pm, pn; };
struct Gemm { const bf16_t* A; const bf16_t* Bt; int M, N, K, lda; };
struct StaticOrder {
    int nM, nN, nwg, G, c;
    __host__ __device__ void init(int M_, int N_, int G_, int c_) { nM = M_ / BM; nN = N_ / BM; nwg = nM * nN; G = G_; c = c_; }
    __host__ __device__ bool next(int i, Unit& u) const {
        const long L = (long)i * G + c; if (L >= nwg) return false;
        int wgid = (int)L; { const int q = nwg / NXCD, r = nwg % NXCD, xcd = wgid % NXCD, off = wgid / NXCD; wgid = (xcd < r ? xcd * (q + 1) : r * (q + 1) + (xcd - r) * q) + off; }
        const int nig = WGM * nN, gid = wgid / nig, fm = gid * WGM, gsz = (nM - fm) < WGM ? (nM - fm) : WGM;
        u.pm = fm + ((wgid % nig) % gsz); u.pn = (wgid % nig) / gsz; return true;
    }
};
__host__ __device__ __forceinline__ int p2_recent_tile(int rt) { return rt < 8 ? (rt >> 1) * 16 + 14 + (rt & 1) : 64 + (rt - 8); }
__host__ __device__ __forceinline__ int p2_old_tile(int k) { return (k / 14) * 16 + (k % 14); }
__host__ __device__ __forceinline__ void grid_map(int L, int nM, int nN, int& pm, int& pn) {
    const int nwg = nM * nN; int wgid = L; { const int q = nwg / NXCD, r = nwg % NXCD, xcd = wgid % NXCD, off = wgid / NXCD; wgid = (xcd < r ? xcd * (q + 1) : r * (q + 1) + (xcd - r) * q) + off; }
    const int nig = WGM * nN, gid = wgid / nig, fm = gid * WGM, gsz = (nM - fm) < WGM ? (nM - fm) : WGM;
    pm = fm + ((wgid % nig) % gsz); pn = (wgid % nig) / gsz;
}
struct P2Bf16Order {
    int G, c;
    __host__ __device__ bool next(int i, Unit& u) const { const int L = i * G + c; if (L >= 12 * 20) return false; int a, b; grid_map(L, 12, 20, a, b); u.pm = p2_recent_tile(a); u.pn = 8 + b; return true; }
};
struct P2F8Order {
    int G, c;
    __host__ __device__ bool next(int i, Unit& u) const { const int L = i * G + c; int a, b;
        if (L < 56 * 52) {
            constexpr int nwg = 56 * 52; int wgid = L; { const int q = nwg / NXCD, xcd = wgid % NXCD, off = wgid / NXCD; wgid = xcd * q + off; }
            const int chunk = wgid / 224, q2 = wgid % 224; u.pm = p2_old_tile(q2 >> 2); u.pn = chunk * 4 + (q2 & 3); return true; }
        const int L2 = L - 56 * 52; if (L2 >= 12 * 32) return false;
        grid_map(L2, 12, 32, a, b); u.pm = p2_recent_tile(a); u.pn = b < 8 ? b : b + 20; return true; }
};
__device__ __forceinline__ unsigned cvt_pk_bf16(float lo, float hi) { unsigned r; asm volatile("v_cvt_pk_bf16_f32 %0, %1, %2" : "=v"(r) : "v"(lo), "v"(hi)); return r; }

typedef int i32x8 __attribute__((ext_vector_type(8)));
typedef int i32x4v __attribute__((ext_vector_type(4)));
__device__ __forceinline__ i32x8 cat16(bf16x8 lo, bf16x8 hi) { return __builtin_shufflevector(__builtin_bit_cast(i32x4v, lo), __builtin_bit_cast(i32x4v, hi), 0, 1, 2, 3, 4, 5, 6, 7); }
template <class Epi, class Sched, bool F8 = false>
__device__ __forceinline__ void gemm_phase(LAS unsigned char* lds, const Gemm g, const Sched& S, const Epi& E) {
    const int tid = threadIdx.x, wid = __builtin_amdgcn_readfirstlane(tid >> 6), lane = tid & 63, wr = wid >> 2, wc = wid & 3, fr = lane & 15, fq = lane >> 4;
    const int K = g.K, nt = K / BK, lda = g.lda;
    unsigned voffA[2], voffB[2];
    { int R, C; stage_rc(tid * 16, R, C); const int Rb = Epi::PERM ? ((R & ~31) + perm32(R & 31)) : R;
        voffA[0] = (unsigned)(R * lda + C) * 2u; voffB[0] = (unsigned)(Rb * K + C) * 2u; voffA[1] = voffA[0] + (unsigned)(64 * lda) * 2u; voffB[1] = voffB[0] + (unsigned)(64 * K) * 2u; }
    const size_t kstep = (size_t)(BK * 2);
    const size_t hstepA = (size_t)HALF * lda * 2, hstepB = (size_t)HALF * K * 2;
    const size_t tstepA = 2 * hstepA, tstepB = 2 * hstepB;
    const unsigned ldsw = (unsigned)wid * 1024u;
    const int aoff = lds_byte(wr * 64 + fr, fq * 8), boff = lds_byte(wc * 32 + fr, fq * 8);
#define PG8_SA(b, h) (((b) * 2 + (h)) * HTB)
#define PG8_SB(b, h) ((4 + (b) * 2 + (h)) * HTB)
#define PG8_STAGE(bufoff, gbase, voff) do { _Pragma("unroll") for (int _i = 0; _i < 2; ++_i) \
        __builtin_amdgcn_global_load_lds((const unsigned*)((const char*)(gbase) + (voff)[_i]), (LAS unsigned*)(lds + (bufoff) + ldsw + _i * 8192), 16, 0, 0); } while (0)
#define PG8_LDA(dst, b, h) do { _Pragma("unroll") for (int m = 0; m < 4; ++m) { if constexpr (F8) dst##8[m] = cat16(*(const LAS bf16x8*)(lds + PG8_SA(b, h) + aoff + m * 2048), *(const LAS bf16x8*)(lds + PG8_SA(b, h) + aoff + m * 2048 + 1024)); \
        else { _Pragma("unroll") for (int k = 0; k < 2; ++k) dst[m][k] = *(const LAS bf16x8*)(lds + PG8_SA(b, h) + aoff + m * 2048 + k * 1024); } } } while (0)
#define PG8_LDB(dst, b, h) do { _Pragma("unroll") for (int n = 0; n < 2; ++n) { if constexpr (F8) dst##8[n] = cat16(*(const LAS bf16x8*)(lds + PG8_SB(b, h) + boff + n * 2048), *(const LAS bf16x8*)(lds + PG8_SB(b, h) + boff + n * 2048 + 1024)); \
        else { _Pragma("unroll") for (int k = 0; k < 2; ++k) dst[n][k] = *(const LAS bf16x8*)(lds + PG8_SB(b, h) + boff + n * 2048 + k * 1024); } } } while (0)
#define PG8_MMA(ai, bj, At, Bt) do { __builtin_amdgcn_s_setprio(1); _Pragma("unroll") for (int m = 0; m < 4; ++m) _Pragma("unroll") for (int n = 0; n < 2; ++n) { \
        if constexpr (F8) asm volatile("v_mfma_scale_f32_16x16x128_f8f6f4 %0, %1, %2, %0, %3, %3 op_sel_hi:[0,0,0]" : "+v"(acc[ai][bj][m][n]) : "v"(Bt##8[n]), "v"(At##8[m]), "v"(f8scale)); \
        else { _Pragma("unroll") for (int k = 0; k < 2; ++k) acc[ai][bj][m][n] = __builtin_amdgcn_mfma_f32_16x16x32_bf16(Bt[n][k], At[m][k], acc[ai][bj][m][n], 0, 0, 0); } } __builtin_amdgcn_s_setprio(0); } while (0)
#define PG8_WAIT_V(n) asm volatile("s_waitcnt vmcnt(" #n ")" ::: "memory")
#define PG8_WAIT_L(n) asm volatile("s_waitcnt lgkmcnt(" #n ")" ::: "memory")
#define PG8_BAR __builtin_amdgcn_s_barrier()
#define PG8_SCHED __builtin_amdgcn_sched_barrier(0)
    Unit cur, nxt; int ui = 0;
    if (!S.next(0, cur)) return;
    f32x4 acc[2][2][4][2];
#pragma unroll
    for (int a = 0; a < 2; ++a)
#pragma unroll
        for (int b = 0; b < 2; ++b)
#pragma unroll
            for (int m = 0; m < 4; ++m)
#pragma unroll
                for (int n = 0; n < 2; ++n) acc[a][b][m][n] = (f32x4){0.f, 0.f, 0.f, 0.f};
    bf16x8 At[4][2], B0[2][2], B1[2][2]; i32x8 At8[4], B08[2], B18[2];
    int f8scale = 0x7F7F7F7F; asm volatile("" : "+v"(f8scale));
    const char* cA = (const char*)g.A + (size_t)cur.pm * tstepA; const char* cB = (const char*)g.Bt + (size_t)cur.pn * tstepB;
    PG8_STAGE(PG8_SB(0, 0), cB, voffB); PG8_STAGE(PG8_SB(0, 1), cB + hstepB, voffB); PG8_STAGE(PG8_SA(0, 0), cA, voffA); PG8_STAGE(PG8_SA(0, 1), cA + hstepA, voffA);
    if (wr == 1) PG8_BAR;
    PG8_WAIT_V(2); PG8_BAR;
    PG8_STAGE(PG8_SB(1, 0), cB + kstep, voffB); PG8_STAGE(PG8_SA(1, 0), cA + kstep, voffA); PG8_STAGE(PG8_SB(1, 1), cB + hstepB + kstep, voffB);
    PG8_WAIT_V(6); PG8_BAR;
    for (;;) {
        const bool has_next = S.next(ui + 1, nxt);
        const char* nA = has_next ? (const char*)g.A + (size_t)nxt.pm * tstepA : cA; const char* nB = has_next ? (const char*)g.Bt + (size_t)nxt.pn * tstepB : cB;
        for (int t = 0; t < nt; t += 2) {
            const bool last = (t == nt - 2);
            const char* a1 = cA + (size_t)(t + 1) * kstep;
            const char* a2 = last ? nA : cA + (size_t)(t + 2) * kstep; const char* b2 = last ? nB : cB + (size_t)(t + 2) * kstep;
            const char* a3 = a2 + kstep; const char* b3 = b2 + kstep;
            PG8_LDB(B0, 0, 0); PG8_LDB(B1, 0, 1); PG8_SCHED; PG8_LDA(At, 0, 0); PG8_STAGE(PG8_SA(1, 1), a1 + hstepA, voffA);
            PG8_WAIT_V(8); PG8_WAIT_L(0); PG8_BAR; PG8_MMA(0, 0, At, B0); PG8_MMA(0, 1, At, B1); PG8_BAR; PG8_SCHED;
            PG8_LDA(At, 0, 1); PG8_STAGE(PG8_SB(0, 0), b2, voffB); PG8_STAGE(PG8_SB(0, 1), b2 + hstepB, voffB); PG8_STAGE(PG8_SA(0, 0), a2, voffA);
            PG8_WAIT_V(8); PG8_WAIT_L(0); PG8_BAR; PG8_MMA(1, 0, At, B0); PG8_MMA(1, 1, At, B1); PG8_BAR; PG8_SCHED;
            PG8_LDB(B0, 1, 0); PG8_LDB(B1, 1, 1); PG8_SCHED; PG8_LDA(At, 1, 0); PG8_STAGE(PG8_SA(0, 1), a2 + hstepA, voffA);
            PG8_WAIT_V(8); PG8_WAIT_L(0); PG8_BAR; PG8_MMA(0, 0, At, B0); PG8_MMA(0, 1, At, B1); PG8_BAR; PG8_SCHED;
            PG8_LDA(At, 1, 1); PG8_STAGE(PG8_SB(1, 0), b3, voffB); PG8_STAGE(PG8_SB(1, 1), b3 + hstepB, voffB); PG8_STAGE(PG8_SA(1, 0), a3, voffA);
            PG8_WAIT_V(8); PG8_WAIT_L(0); PG8_BAR; PG8_MMA(1, 0, At, B0); PG8_MMA(1, 1, At, B1); PG8_BAR; PG8_SCHED;
        }
        if (wr == 0) PG8_BAR;
        if constexpr (F8) asm volatile("s_nop 15\n\ts_nop 15" ::: "memory");
        { int fr_e = fr, fq_e = fq; asm volatile("" : "+v"(fr_e), "+v"(fq_e)); E(acc, cur, wr, wc, fr_e, fq_e); }
        if (!has_next) break;
#pragma unroll
        for (int a = 0; a < 2; ++a)
#pragma unroll
            for (int b = 0; b < 2; ++b)
#pragma unroll
                for (int m = 0; m < 4; ++m)
#pragma unroll
                    for (int n = 0; n < 2; ++n) acc[a][b][m][n] = (f32x4){0.f, 0.f, 0.f, 0.f};
        cur = nxt; cA = nA; cB = nB; ++ui;
        if (wr == 1) PG8_BAR;
    }
    PG8_WAIT_V(0);
    PG8_BAR;
#undef PG8_SA
#undef PG8_SB
#undef PG8_STAGE
#undef PG8_LDA
#undef PG8_LDB
#undef PG8_MMA
#undef PG8_WAIT_V
#undef PG8_WAIT_L
#undef PG8_BAR
#undef PG8_SCHED
}

struct EpiBig {
    static constexpr bool PERM = true;
    bf16_t* O; int ldc; int sig_from; int split, add0, add1; float os;
    __device__ __forceinline__ void operator()(const f32x4 (&acc)[2][2][4][2], const Unit& u, int wr, int wc, int fr, int fq) const {
        const int row0 = u.pm * BM + wr * 64 + fr, col0 = (u.pn + (u.pn < split ? add0 : add1)) * BM + wc * 32 + 8 * fq; const bool sg = u.pn >= sig_from;
#pragma unroll
        for (int ai = 0; ai < 2; ++ai)
#pragma unroll
            for (int m = 0; m < 4; ++m) { bf16_t* rowp = O + (size_t)(row0 + ai * HALF + m * 16) * ldc + col0;
#pragma unroll
                for (int bj = 0; bj < 2; ++bj) { f32x4 v0 = acc[ai][bj][m][0] * os, v1 = acc[ai][bj][m][1] * os;
                    if (sg) {
#pragma unroll
                        for (int e = 0; e < 4; ++e) { v0[e] = __builtin_amdgcn_rcpf(1.0f + __expf(-v0[e])); v1[e] = __builtin_amdgcn_rcpf(1.0f + __expf(-v1[e])); } }
                    u32x4 w; w.x = cvt_pk_bf16(v0[0], v0[1]); w.y = cvt_pk_bf16(v0[2], v0[3]); w.z = cvt_pk_bf16(v1[0], v1[1]); w.w = cvt_pk_bf16(v1[2], v1[3]);
                    *(u32x4*)(rowp + bj * HALF) = w; } }
    }
};
template <bool ACCUM> struct EpiGate {
    static constexpr bool PERM = true;
    bf16_t* Z; const bf16_t* G; int ldg; float os; unsigned char* Z8;
    __device__ __forceinline__ void operator()(const f32x4 (&acc)[2][2][4][2], const Unit& u, int wr, int wc, int fr, int fq) const {
        const int row0 = u.pm * BM + wr * 64 + fr, col0 = u.pn * BM + wc * 32 + 8 * fq;
#pragma unroll
        for (int ai = 0; ai < 2; ++ai)
#pragma unroll
            for (int m = 0; m < 4; ++m) { const size_t r = (size_t)(row0 + ai * HALF + m * 16);
#pragma unroll
                for (int bj = 0; bj < 2; ++bj) { const f32x4 v0 = acc[ai][bj][m][0], v1 = acc[ai][bj][m][1];
                    const u32x4 gw = *(const u32x4*)(G + r * ldg + col0 + bj * HALF);
                    float o[8] = { v0[0] * os * bflo(gw.x), v0[1] * os * bfhi(gw.x), v0[2] * os * bflo(gw.y), v0[3] * os * bfhi(gw.y), v1[0] * os * bflo(gw.z), v1[1] * os * bfhi(gw.z), v1[2] * os * bflo(gw.w), v1[3] * os * bfhi(gw.w) };
                    bf16_t* zp = Z + r * D + col0 + bj * HALF;
                    if (ACCUM) { const u32x4 zw = *(const u32x4*)zp; o[0] += bflo(zw.x); o[1] += bfhi(zw.x); o[2] += bflo(zw.y); o[3] += bfhi(zw.y); o[4] += bflo(zw.z); o[5] += bfhi(zw.z); o[6] += bflo(zw.w); o[7] += bfhi(zw.w); }
                    if (ACCUM) { u32x2 w8; w8.x = pk4_fp8(o[0] * Z_S, o[1] * Z_S, o[2] * Z_S, o[3] * Z_S); w8.y = pk4_fp8(o[4] * Z_S, o[5] * Z_S, o[6] * Z_S, o[7] * Z_S); *(u32x2*)(Z8 + r * D + col0 + bj * HALF) = w8; }
                    else { u32x4 w; w.x = cvt_pk_bf16(o[0], o[1]); w.y = cvt_pk_bf16(o[2], o[3]); w.z = cvt_pk_bf16(o[4], o[5]); w.w = cvt_pk_bf16(o[6], o[7]); *(u32x4*)zp = w; } } }
    }
};
struct EpiRes {
    static constexpr bool PERM = true;
    bf16_t* T; const float* xp; const float* xs; const float* ada; float os;
    __device__ __forceinline__ void operator()(const f32x4 (&acc)[2][2][4][2], const Unit& u, int wr, int wc, int fr, int fq) const {
        const int row0 = u.pm * BM + wr * 64 + fr, col0 = u.pn * BM + wc * 32 + 8 * fq;
#pragma unroll
        for (int ai = 0; ai < 2; ++ai)
#pragma unroll
            for (int m = 0; m < 4; ++m) { const int r = row0 + ai * HALF + m * 16;
                const float* xrow = r < MP ? xp + (size_t)r * D : xs + (size_t)(r - MP) * D;
                const int b = r < MP ? (r >> 12) : BATCH + ((r - MP) >> 3);
                const float* g1 = ada + (size_t)b * (6 * D) + 2 * D;
#pragma unroll
                for (int bj = 0; bj < 2; ++bj) { const int c = col0 + bj * HALF;
                    const f32x4 x0 = *(const f32x4*)(xrow + c), x1 = *(const f32x4*)(xrow + c + 4), g0 = *(const f32x4*)(g1 + c), g4 = *(const f32x4*)(g1 + c + 4);
                    const f32x4 v0 = x0 * ALPHA + g0 * (acc[ai][bj][m][0] * os), v1 = x1 * ALPHA + g4 * (acc[ai][bj][m][1] * os);
                    u32x4 w; w.x = cvt_pk_bf16(v0[0], v0[1]); w.y = cvt_pk_bf16(v0[2], v0[3]); w.z = cvt_pk_bf16(v1[0], v1[1]); w.w = cvt_pk_bf16(v1[2], v1[3]);
                    *(u32x4*)(T + (size_t)r * D + c) = w; } }
    }
};
struct EpiPlain {
    static constexpr bool PERM = true;
    bf16_t* O; float os;
    __device__ __forceinline__ void operator()(const f32x4 (&acc)[2][2][4][2], const Unit& u, int wr, int wc, int fr, int fq) const {
        const int row0 = u.pm * BM + wr * 64 + fr, col0 = u.pn * BM + wc * 32 + 8 * fq;
#pragma unroll
        for (int ai = 0; ai < 2; ++ai)
#pragma unroll
            for (int m = 0; m < 4; ++m) { bf16_t* rowp = O + (size_t)(row0 + ai * HALF + m * 16) * D + col0;
#pragma unroll
                for (int bj = 0; bj < 2; ++bj) { const f32x4 v0 = acc[ai][bj][m][0] * os, v1 = acc[ai][bj][m][1] * os;
                    u32x4 w; w.x = cvt_pk_bf16(v0[0], v0[1]); w.y = cvt_pk_bf16(v0[2], v0[3]); w.z = cvt_pk_bf16(v1[0], v1[1]); w.w = cvt_pk_bf16(v1[2], v1[3]);
                    *(u32x4*)(rowp + bj * HALF) = w; } }
    }
};
}

#define XB_TMO      128
#define XB_XCNT(j)  (256  + 64 * (j))
#define XB_XSUB(j)  (1280 + 64 * (j))
#define XB_XGEN(j)  (2304 + 64 * (j))
#define XB_TOP      3328
#define XB_TOPGEN   3392
#define XCD_BAR_WORDS 3456
#define XB_SPIN_CAP (1u << 22)
__device__ __forceinline__ unsigned xb_ld(unsigned* p)              { return __hip_atomic_load(p, __ATOMIC_RELAXED, __HIP_MEMORY_SCOPE_AGENT); }
__device__ __forceinline__ unsigned xb_add(unsigned* p, unsigned v) { return __hip_atomic_fetch_add(p, v, __ATOMIC_RELAXED, __HIP_MEMORY_SCOPE_AGENT); }
__device__ __forceinline__ unsigned xb_xcc_id() { return (unsigned)__builtin_amdgcn_s_getreg((3 << 11) | 20) & 0xFu; }
#define XB_SPIN(cond, bar) do { unsigned _sp = 0; while (cond) { __builtin_amdgcn_s_sleep(1); \
    if ((++_sp & 255u) == 0u) { if (xb_ld(&(bar)[XB_TMO])) break; if (_sp > XB_SPIN_CAP) { atomicAdd(&(bar)[XB_TMO], 1u); break; } } } } while (0)
struct XcdBarrier { unsigned* bar; unsigned x; volatile LAS unsigned* st; };
__device__ __forceinline__ XcdBarrier xcd_barrier_post(unsigned* bar, volatile LAS unsigned* st) {
    XcdBarrier b; b.bar = bar; b.x = xb_xcc_id(); b.st = st;
    if (threadIdx.x == 0) (void)xb_add(&bar[XB_XCNT(b.x)], 1u);
    return b;
}
__device__ __forceinline__ void xcd_barrier_complete(unsigned* bar, unsigned x, unsigned& nloc, unsigned& nx) {
    const unsigned G = gridDim.x * gridDim.y * gridDim.z;
    unsigned sum, cnt, mine, sp = 0u;
    for (;;) {
        sum = 0u; cnt = 0u; mine = 0u;
#pragma unroll
        for (unsigned j = 0; j < 16; ++j) { const unsigned c = xb_ld(&bar[XB_XCNT(j)]); sum += c; cnt += (c > 0u) ? 1u : 0u; mine = (j == x) ? c : mine; }
        if (sum == G) break;
        __builtin_amdgcn_s_sleep(1);
        if ((++sp & 255u) == 0u) { if (xb_ld(&bar[XB_TMO])) break; if (sp > XB_SPIN_CAP) { atomicAdd(&bar[XB_TMO], 1u); break; } }
    }
    nloc = mine > 0u ? mine : 1u; nx = cnt > 0u ? cnt : 1u;
}
__device__ __forceinline__ void xcd_barrier(const XcdBarrier& b) {
    asm volatile("s_waitcnt vmcnt(0)" ::: "memory");
    __syncthreads();
    if (threadIdx.x == 0) {
        unsigned* bar = b.bar;
        __builtin_amdgcn_s_waitcnt(0);
        unsigned nloc = b.st[0], nx = b.st[1];
        if (nloc == 0u) { xcd_barrier_complete(bar, b.x, nloc, nx); b.st[0] = nloc; b.st[1] = nx; }
        const unsigned old = xb_add(&bar[XB_XSUB(b.x)], 1u);
        const unsigned gen = old / nloc;
        if (old + 1u == (gen + 1u) * nloc) {
            __builtin_amdgcn_fence(__ATOMIC_RELEASE, "agent");
            asm volatile("s_waitcnt vmcnt(0)" ::: "memory");
            const unsigned og = xb_add(&bar[XB_TOP], 1u);
            const unsigned tg = og / nx;
            if (og + 1u == (tg + 1u) * nx) xb_add(&bar[XB_TOPGEN], 1u);
            else XB_SPIN(xb_ld(&bar[XB_TOPGEN]) == tg, bar);
            __builtin_amdgcn_fence(__ATOMIC_ACQUIRE, "agent");
            xb_add(&bar[XB_XGEN(b.x)], 1u);
            asm volatile("s_waitcnt vmcnt(0)" ::: "memory");
        } else {
            XB_SPIN(xb_ld(&bar[XB_XGEN(b.x)]) == gen, bar);
            __builtin_amdgcn_fence(__ATOMIC_ACQUIRE, "agent");
            asm volatile("s_waitcnt vmcnt(0)" ::: "memory");
        }
    }
    __syncthreads();
}

struct Args { const float* in[31]; float* out; unsigned char* ws; int ph_lo, ph_hi, flags, pad; };
typedef const __attribute__((address_space(4))) Args CArgs;

struct Ctx {
    LAS unsigned char* lds;
    int tid, lane, wave, vcu, G;
};

__device__ __forceinline__ void p0_ada(const Ctx& X, const float* cP, const float* cS, const float* w_ada, const float* b_ada, float* ADA) {
    constexpr int NA = 6 * D;
    const int lane = X.lane, w = X.wave, fr = lane & 15, fq = lane >> 4;
    LAS float* red = (LAS float*)X.lds;
    for (int cb = X.vcu; cb < NA / 48; cb += X.G) {
        const int n0 = cb * 48;
        f32x4 acc[9][3];
#pragma unroll
        for (int i = 0; i < 9; ++i)
#pragma unroll
            for (int j = 0; j < 3; ++j) acc[i][j] = (f32x4){0.f, 0.f, 0.f, 0.f};
        for (int ks = 0; ks < 8; ++ks) {
            const int k0 = w * 256 + ks * 32 + 8 * fq;
            bf16x8 bfr[3];
#pragma unroll
            for (int nt = 0; nt < 3; ++nt) {
                float t[8];
#pragma unroll
                for (int j = 0; j < 8; ++j) t[j] = w_ada[(size_t)(k0 + j) * NA + n0 + nt * 16 + fr];
                u32x4 p; p.x = pk2(t[0], t[1]); p.y = pk2(t[2], t[3]); p.z = pk2(t[4], t[5]); p.w = pk2(t[6], t[7]);
                bfr[nt] = __builtin_bit_cast(bf16x8, p);
            }
            { LAS unsigned char* scw = X.lds + 32768 + w * 11520; const int kw = w * 256 + ks * 32 + 4 * (lane & 7);
#pragma unroll
              for (int i = 0; i < 18; ++i) { const int r = 8 * i + (lane >> 3); f32x4 cv = (f32x4){0.f, 0.f, 0.f, 0.f};
                  if (r < NB) { const float* cr = r < BATCH ? cP + (size_t)r * D : cS + (size_t)(r - BATCH) * D; cv = *(const f32x4*)(cr + kw); }
#pragma unroll
                  for (int j = 0; j < 4; ++j) cv[j] = cv[j] * __builtin_amdgcn_rcpf(1.0f + __expf(-cv[j]));
                  u32x2 pw; pw.x = pk2(cv[0], cv[1]); pw.y = pk2(cv[2], cv[3]); *(LAS u32x2*)(scw + r * 80 + (lane & 7) * 8) = pw; }
              asm volatile("s_waitcnt lgkmcnt(0)" ::: "memory");
#pragma unroll
              for (int mt = 0; mt < 9; ++mt) { const bf16x8 afr = *(const LAS bf16x8*)(scw + (mt * 16 + fr) * 80 + fq * 16);
#pragma unroll
                  for (int nt = 0; nt < 3; ++nt) acc[mt][nt] = __builtin_amdgcn_mfma_f32_16x16x32_bf16(afr, bfr[nt], acc[mt][nt], 0, 0, 0); }
              asm volatile("s_waitcnt lgkmcnt(0)" ::: "memory"); }
        }
        for (int rnd = 0; rnd < 8; ++rnd) {
            if (w == rnd) {
#pragma unroll
                for (int mt = 0; mt < 9; ++mt)
#pragma unroll
                    for (int nt = 0; nt < 3; ++nt)
#pragma unroll
                        for (int e = 0; e < 4; ++e) { const int idx = (mt * 16 + 4 * fq + e) * 48 + nt * 16 + fr; red[idx] = (rnd == 0 ? 0.f : red[idx]) + acc[mt][nt][e]; }
            }
            __syncthreads();
        }
        for (int i = X.tid; i < NB * 48; i += NTHREADS) { const int r = i / 48, c = i % 48; ADA[(size_t)r * NA + n0 + c] = red[r * 48 + c] + b_ada[n0 + c]; }
        __syncthreads();
    }
}
__device__ __forceinline__ void p0_transpose_item(const float* W, int ldw, int srccol, int k0, bf16_t* WT, int K, int dstrow, LAS float* scr, int lane, unsigned char* WF8 = nullptr) {
    { f32x4 t[8];
#pragma unroll
      for (int i = 0; i < 8; ++i) t[i] = *(const f32x4*)(W + (size_t)(k0 + 8 * i + (lane >> 3)) * ldw + srccol + 4 * (lane & 7));
#pragma unroll
      for (int i = 0; i < 8; ++i) { LAS float* d = scr + (8 * i + (lane >> 3)) * 33 + 4 * (lane & 7); d[0] = t[i][0]; d[1] = t[i][1]; d[2] = t[i][2]; d[3] = t[i][3]; } }
    LDS_WAIT(); asm volatile("" ::: "memory");
    const int c = lane & 7;
#pragma unroll
    for (int j = 0; j < (WT ? 4 : 0); ++j) { const int n = (lane >> 3) + 8 * j; const LAS float* s = scr + (8 * c) * 33 + n;
        u32x4 o; o.x = pk2(s[0 * 33], s[1 * 33]); o.y = pk2(s[2 * 33], s[3 * 33]); o.z = pk2(s[4 * 33], s[5 * 33]); o.w = pk2(s[6 * 33], s[7 * 33]);
        *(u32x4*)(WT + (size_t)(dstrow + n) * K + k0 + 8 * c) = o; }
    if (WF8) {
        const int c4 = lane & 3;
#pragma unroll
        for (int j = 0; j < 2; ++j) { const int n = (lane >> 2) + 16 * j; const LAS float* sp = scr + (16 * c4) * 33 + n; u32x4 o;
#pragma unroll
            for (int q = 0; q < 4; ++q) o[q] = pk4_fp8(sp[(4 * q) * 33] * W_S, sp[(4 * q + 1) * 33] * W_S, sp[(4 * q + 2) * 33] * W_S, sp[(4 * q + 3) * 33] * W_S);
            *(u32x4*)(WF8 + (size_t)(dstrow + n) * K + k0 + 16 * c4) = o; } }
    LDS_WAIT(); asm volatile("" ::: "memory");
}
__device__ __forceinline__ void p0_transposes(const Ctx& X, CArgs& a) {
    unsigned char* ws = a.ws;
    LAS float* scr = (LAS float*)(X.lds + 32768 + X.wave * 8704);
    const int gw = X.vcu * NWAVES + X.wave, NGW = X.G * NWAVES;
    constexpr int I_IN = (D / 64) * (NW / 32), I_SQ = (D / 64) * (D / 32);
    bf16_t* WinT = (bf16_t*)(ws + WS_WINT); bf16_t* W4T = (bf16_t*)(ws + WS_W4T);
    for (int it = gw; it < I_IN + 4 * I_SQ; it += NGW) {
        if (it < I_IN) { const int nblk = NW / 32, kb = it / nblk, nb = it % nblk; const int n0 = nb * 32; const int src = n0 < SRC_MIF ? n0 : n0 + 8;
            const bool soft = n0 < C_AK || n0 >= C_MO;
            p0_transpose_item(a.in[13], INW, src, kb * 64, soft ? nullptr : WinT, D, n0, scr, X.lane, ws + WS_WINF8); }
        else { int r = it - I_IN; const int wsel = r / I_SQ; r %= I_SQ; const int nblk = D / 32, kb = r / nblk, nb = r % nblk;
            const float* W = wsel == 0 ? a.in[20] : wsel == 1 ? a.in[21] : wsel == 2 ? a.in[22] : a.in[25];
            p0_transpose_item(W, D, nb * 32, kb * 64, nullptr, D, nb * 32, scr, X.lane, ws + WS_W4F8 + (size_t)wsel * D * D); }
    }
    { bf16_t* SKB = (bf16_t*)(ws + WS_SKB); for (int i = blockIdx.x * NTHREADS + X.tid; i < PH * 2 * NKEYS * 128 / 2; i += X.G * NTHREADS) { const f32x2 v = *(const f32x2*)(a.in[26] + 2 * (size_t)i); ((unsigned*)SKB)[i] = pk2(v.x, v.y); } }
    float* WMIF = (float*)(ws + WS_WMIF);
    for (int i = blockIdx.x * NTHREADS + X.tid; i < 8 * D; i += X.G * NTHREADS) { const int j = i / D, k = i % D; WMIF[i] = a.in[13][(size_t)k * INW + SRC_MIF + j]; }
}


__device__ __forceinline__ void p0_peer_fp8(const Ctx& X, CArgs& a, int part, int wi, int nwk) {
    unsigned char* ws = a.ws; float* PSC = (float*)(ws + WS_PSC);
    const int gw = wi * NWAVES + X.wave, NGW = nwk * NWAVES, lane = X.lane;
    for (int it = part * 8192 + 2 * gw; it < (part + 1) * 8192; it += 2 * NGW) {
        f32x4 v[2][8]; float am[2];
#pragma unroll
        for (int rr = 0; rr < 2; ++rr) { const int tb = (it + rr) >> 14, e = (it + rr) & 16383; const float* src = (tb ? a.in[28] : a.in[27]) + (size_t)e * D + 4 * lane;
#pragma unroll
            for (int i = 0; i < 8; ++i) v[rr][i] = __builtin_nontemporal_load((const f32x4*)(src + 256 * i)); }
#pragma unroll
        for (int rr = 0; rr < 2; ++rr) { float m_ = 0.f;
#pragma unroll
            for (int i = 0; i < 8; ++i) m_ = fmaxf(m_, fmaxf(fmaxf(fabsf(v[rr][i][0]), fabsf(v[rr][i][1])), fmaxf(fabsf(v[rr][i][2]), fabsf(v[rr][i][3]))));
            am[rr] = wave_max(m_); }
#pragma unroll
        for (int rr = 0; rr < 2; ++rr) { const int tb = (it + rr) >> 14, e = (it + rr) & 16383; unsigned char* tbl = ws + (tb ? WS_V8 : WS_U8);
            const float top = tb ? 224.0f : 127.0f;
            const float sc = am[rr] > 0.f ? top / am[rr] : 1.0f;
#pragma unroll
            for (int i = 0; i < 8; ++i) { unsigned p;
                if (tb) { int q = 0; q = __builtin_amdgcn_cvt_pk_fp8_f32(v[rr][i][0] * sc, v[rr][i][1] * sc, q, false); q = __builtin_amdgcn_cvt_pk_fp8_f32(v[rr][i][2] * sc, v[rr][i][3] * sc, q, true); p = (unsigned)q; }
                else p = pk4_i8(v[rr][i][0] * sc, v[rr][i][1] * sc, v[rr][i][2] * sc, v[rr][i][3] * sc);
                *(unsigned*)(tbl + (size_t)(2 * i + (lane >> 5)) * SLAB_BYTES + (size_t)e * 128 + 4 * (lane & 31)) = p; }
            if (lane == 0) PSC[tb * 16384 + e] = am[rr] > 0.f ? am[rr] / top : 1.0f; }
    }
}

__device__ __forceinline__ void p1_rows(const Ctx& X, CArgs& a) {
    unsigned char* ws = a.ws;
    const float* ADA = (const float*)(ws + WS_ADA); const float* WMIF = (const float*)(ws + WS_WMIF);
    float* MIF = (float*)(ws + WS_MIF); bf16_t* H1 = (bf16_t*)(ws + WS_H1);
    LAS float* wl = (LAS float*)X.lds;
    for (int i = X.tid; i < 8 * D / 4; i += NTHREADS) ((LAS f32x4*)wl)[i] = ((const f32x4*)WMIF)[i];
    __syncthreads();
    const int gw = X.vcu * NWAVES + X.wave, NGW = X.G * NWAVES, lane = X.lane;
    for (int m = gw; m < M; m += NGW) {
        const float* xrow = m < MP ? a.in[0] + (size_t)m * D : a.in[1] + (size_t)(m - MP) * D;
        const int b = m < MP ? (m >> 12) : BATCH + ((m - MP) >> 3);
        const float* sh = ADA + (size_t)b * 6 * D; const float* sc = sh + D;
        f32x4 v[8]; float dots[8];
#pragma unroll
        for (int j = 0; j < 8; ++j) dots[j] = 0.f;
#pragma unroll
        for (int j = 0; j < 8; ++j) { const int c = 4 * lane + 256 * j; const f32x4 xv = *(const f32x4*)(xrow + c), s1 = *(const f32x4*)(sc + c), s0 = *(const f32x4*)(sh + c);
            v[j] = xv * (s1 + 1.0f) + s0;
#pragma unroll
            for (int q = 0; q < 8; ++q) { const f32x4 wv = *(const LAS f32x4*)(wl + q * D + c); dots[q] += (v[j][0] * wv[0] + v[j][1] * wv[1]) + (v[j][2] * wv[2] + v[j][3] * wv[3]); }
            asm volatile("" ::: "memory"); }
        u32x2* o8 = (u32x2*)(H1 + (size_t)m * D) + lane; unsigned* o4 = (unsigned*)(ws + WS_H1F8 + (size_t)m * D) + lane;
#pragma unroll
        for (int j = 0; j < 8; ++j) { u32x2 w; w.x = pk2(v[j][0], v[j][1]); w.y = pk2(v[j][2], v[j][3]); o8[64 * j] = w; o4[64 * j] = pk4_fp8(v[j][0] * ACT_S, v[j][1] * ACT_S, v[j][2] * ACT_S, v[j][3] * ACT_S); }
#pragma unroll
        for (int q = 0; q < 8; ++q) dots[q] = wave_sum(dots[q]);
        if (lane < 8) { float d = dots[0];
#pragma unroll
            for (int q = 1; q < 8; ++q) d = (lane == q) ? dots[q] : d;
            float r;
            if (lane < 4) r = d + a.in[14][lane];
            else { const float z = d + a.in[15][lane - 4]; r = fminf(z, 0.f) - log1pf(expf(-fabsf(z))); }
            MIF[(size_t)m * 8 + lane] = r; }
    }
    __syncthreads();
}

__device__ __forceinline__ int t5_bucket(int d) {
    if (d < 16) return d;
    int v = 16 + (int)(logf((float)d / 16.0f) / logf(8.0f) * 16.0f);
    return v < 31 ? v : 31;
}
__device__ __forceinline__ void p3_attention(const Ctx& X, CArgs& a, int wi, int nwk, int mrow0, int nrows) {
    unsigned char* ws = a.ws;
    const bf16_t* BIG = (const bf16_t*)(ws + WS_BIG); bf16_t* ATT = (bf16_t*)(ws + WS_H1);
    LAS float* btab = (LAS float*)X.lds;
    for (int i = X.tid; i < HEADS * 128; i += NTHREADS) { const int h = i >> 7, d = i & 127; btab[i] = a.in[10][t5_bucket(d) * HEADS + h]; }
    __syncthreads();
    const float* ck = a.in[4]; const float* cv = a.in[5];
    const int nitems = nrows * HEADS;
    for (int it = wi * NTHREADS + X.tid; it < nitems; it += nwk * NTHREADS) {
        const int mb = it >> 11, rem = it & 2047, head = rem >> 6, m = mrow0 + mb * 64 + (rem & 63);
        const int kvh = head >> 2;
        float q[64], acc[64];
        { const u32x4* qp = (const u32x4*)(BIG + (size_t)m * NW + C_AQ + head * 64);
#pragma unroll
          for (int j = 0; j < 8; ++j) { const u32x4 w = qp[j]; q[8 * j + 0] = bflo(w.x); q[8 * j + 1] = bfhi(w.x); q[8 * j + 2] = bflo(w.y); q[8 * j + 3] = bfhi(w.y); q[8 * j + 4] = bflo(w.z); q[8 * j + 5] = bfhi(w.z); q[8 * j + 6] = bflo(w.w); q[8 * j + 7] = bfhi(w.w); } }
#pragma unroll
        for (int j = 0; j < 64; ++j) acc[j] = 0.f;
        float mx = a.in[19][head], l = 1.0f;
        const bool prompt = m < MP;
        const int t = prompt ? (m & (SEQ - 1)) : ((m - MP) & 7);
        const int bs = prompt ? 0 : ((m - MP) >> 3);
        const int nk = prompt ? (t < 127 ? t + 1 : 128) : 128;
        for (int dist = 0; dist < nk; ++dist) {
            bool from_cache = false; int crow = 0; size_t brow = 0;
            if (prompt) brow = (size_t)(m - dist);
            else { const int j = t + 128 - dist; if (j < 128) { from_cache = true; crow = j; } else brow = (size_t)(MP + bs * 8 + (j - 128)); }
            float s = 0.f;
            if (from_cache) { const f32x4* kp = (const f32x4*)(ck + (((size_t)bs * 128 + crow) * KVH + kvh) * HD);
#pragma unroll
                for (int j = 0; j < 16; ++j) { const f32x4 w = kp[j]; s += (q[4 * j] * w[0] + q[4 * j + 1] * w[1]) + (q[4 * j + 2] * w[2] + q[4 * j + 3] * w[3]); } }
            else { const u32x4* kp = (const u32x4*)(BIG + brow * NW + C_AK + kvh * 64);
#pragma unroll
                for (int j = 0; j < 8; ++j) { const u32x4 w = kp[j];
                    s += (q[8 * j + 0] * bflo(w.x) + q[8 * j + 1] * bfhi(w.x)) + (q[8 * j + 2] * bflo(w.y) + q[8 * j + 3] * bfhi(w.y)) + (q[8 * j + 4] * bflo(w.z) + q[8 * j + 5] * bfhi(w.z)) + (q[8 * j + 6] * bflo(w.w) + q[8 * j + 7] * bfhi(w.w)); } }
            s = s * 0.125f + btab[head * 128 + dist];
            const float mn = fmaxf(mx, s), sc = expf(mx - mn), p = expf(s - mn);
            l = l * sc + p; mx = mn;
            if (from_cache) { const f32x4* vp = (const f32x4*)(cv + (((size_t)bs * 128 + crow) * KVH + kvh) * HD);
#pragma unroll
                for (int j = 0; j < 16; ++j) { const f32x4 w = vp[j]; acc[4 * j] = acc[4 * j] * sc + p * w[0]; acc[4 * j + 1] = acc[4 * j + 1] * sc + p * w[1]; acc[4 * j + 2] = acc[4 * j + 2] * sc + p * w[2]; acc[4 * j + 3] = acc[4 * j + 3] * sc + p * w[3]; } }
            else { const u32x4* vp = (const u32x4*)(BIG + brow * NW + C_AV + kvh * 64);
#pragma unroll
                for (int j = 0; j < 8; ++j) { const u32x4 w = vp[j];
                    acc[8 * j + 0] = acc[8 * j + 0] * sc + p * bflo(w.x); acc[8 * j + 1] = acc[8 * j + 1] * sc + p * bfhi(w.x); acc[8 * j + 2] = acc[8 * j + 2] * sc + p * bflo(w.y); acc[8 * j + 3] = acc[8 * j + 3] * sc + p * bfhi(w.y);
                    acc[8 * j + 4] = acc[8 * j + 4] * sc + p * bflo(w.z); acc[8 * j + 5] = acc[8 * j + 5] * sc + p * bfhi(w.z); acc[8 * j + 6] = acc[8 * j + 6] * sc + p * bflo(w.w); acc[8 * j + 7] = acc[8 * j + 7] * sc + p * bfhi(w.w); } }
        }
        const float inv = 1.0f / l;
        u32x4* op = (u32x4*)(ATT + (size_t)m * D + head * 64);
#pragma unroll
        for (int j = 0; j < 8; ++j) { u32x4 w; w.x = pk2(acc[8 * j] * inv, acc[8 * j + 1] * inv); w.y = pk2(acc[8 * j + 2] * inv, acc[8 * j + 3] * inv); w.z = pk2(acc[8 * j + 4] * inv, acc[8 * j + 5] * inv); w.w = pk2(acc[8 * j + 6] * inv, acc[8 * j + 7] * inv); op[j] = w; }
    }
    __syncthreads();
}

typedef float f32x16 __attribute__((ext_vector_type(16)));
typedef short s16x4 __attribute__((ext_vector_type(4)));
__device__ __forceinline__ void att_prompt_unit(const Ctx& X, CArgs& a, int b, int kvh, int qb) {
    unsigned char* ws = a.ws; const bf16_t* BIG = (const bf16_t*)(ws + WS_BIG); unsigned char* ATT8 = ws + WS_ATT8;
    LAS bf16_t* Kl = (LAS bf16_t*)X.lds;
    LAS bf16_t* VTl = Kl + 256 * 72;
    LAS float* btl = (LAS float*)(VTl + 64 * 260);
    const int tid = X.tid, lane = X.lane, w = X.wave, r32 = lane & 31, hh = lane >> 5;
    constexpr float L2E = 1.4426950408889634f;
    const size_t krow0 = (size_t)b * SEQ + (size_t)qb * 128 - 128;
    __syncthreads();
#pragma unroll
    for (int i = 0; i < 4; ++i) { const int id = i * NTHREADS + tid, key = id >> 3, seg = id & 7;
        u32x4 kw = (u32x4){0u, 0u, 0u, 0u}, vw = kw;
        if (qb > 0 || key >= 128) { const bf16_t* rp = BIG + (krow0 + key) * NW + kvh * 64 + seg * 8; kw = *(const u32x4*)(rp + C_AK); vw = *(const u32x4*)(rp + C_AV); }
        *(LAS u32x4*)(Kl + key * 72 + seg * 8) = kw;
        LAS bf16_t* vp = VTl + (seg * 8) * 260 + key;
        vp[0] = (bf16_t)(vw.x & 0xffffu); vp[260] = (bf16_t)(vw.x >> 16); vp[2 * 260] = (bf16_t)(vw.y & 0xffffu); vp[3 * 260] = (bf16_t)(vw.y >> 16);
        vp[4 * 260] = (bf16_t)(vw.z & 0xffffu); vp[5 * 260] = (bf16_t)(vw.z >> 16); vp[6 * 260] = (bf16_t)(vw.w & 0xffffu); vp[7 * 260] = (bf16_t)(vw.w >> 16); }
    { const int g = tid >> 7, d = tid & 127; btl[tid] = a.in[10][t5_bucket(d) * HEADS + kvh * 4 + g] * L2E; }
    __syncthreads();
    const int g = w >> 1, qh = w & 1, head = kvh * 4 + g;
    const float sink2 = a.in[19][head] * L2E;
    for (int qt = 0; qt < 2; ++qt) {
        const int qo = qh * 64 + qt * 32;
        const size_t qrow = (size_t)b * SEQ + (size_t)qb * 128 + qo + r32;
        bf16x8 Qf[4];
#pragma unroll
        for (int ks = 0; ks < 4; ++ks) Qf[ks] = *(const bf16x8*)(BIG + qrow * NW + C_AQ + head * 64 + ks * 16 + 8 * hh);
        f32x16 sc[5];
        const int T0 = qo >> 5;
#pragma unroll
        for (int kt = 0; kt < 5; ++kt) {
            f32x16 acc;
#pragma unroll
            for (int r = 0; r < 16; ++r) acc[r] = 0.f;
            const LAS bf16_t* kp = Kl + ((T0 + kt) * 32 + r32) * 72 + 8 * hh;
#pragma unroll
            for (int ks = 0; ks < 4; ++ks) acc = __builtin_amdgcn_mfma_f32_32x32x16_bf16(*(const LAS bf16x8*)(kp + ks * 16), Qf[ks], acc, 0, 0, 0);
            const int dbase = 128 - 32 * kt + r32 - 4 * hh;
            const LAS float* bt = btl + g * 128;
            if (qb == 0 && T0 + kt < 4) {
#pragma unroll
                for (int r = 0; r < 16; ++r) sc[kt][r] = -INFINITY;
            } else if (kt >= 1 && kt <= 3) {
#pragma unroll
                for (int r = 0; r < 16; ++r) sc[kt][r] = acc[r] * (0.125f * L2E) + bt[dbase - ((r & 3) + 8 * (r >> 2))];
            } else {
#pragma unroll
                for (int r = 0; r < 16; ++r) { const int dist = dbase - ((r & 3) + 8 * (r >> 2)); const bool valid = (dist >= 0) && (dist < 128);
                    const int dcl = dist < 0 ? 0 : (dist > 127 ? 127 : dist);
                    sc[kt][r] = valid ? acc[r] * (0.125f * L2E) + bt[dcl] : -INFINITY; }
            }
        }
        float mx = sink2;
#pragma unroll
        for (int kt = 0; kt < 5; ++kt)
#pragma unroll
            for (int r = 0; r < 16; ++r) mx = fmaxf(mx, sc[kt][r]);
        mx = fmaxf(mx, __shfl_xor(mx, 32));
        float lsum = 0.f;
        f32x16 O0, O1;
#pragma unroll
        for (int r = 0; r < 16; ++r) { O0[r] = 0.f; O1[r] = 0.f; }
#pragma unroll
        for (int kt = 0; kt < 5; ++kt) {
            float p[16];
#pragma unroll
            for (int r = 0; r < 16; ++r) { p[r] = __builtin_amdgcn_exp2f(sc[kt][r] - mx); lsum += p[r]; }
#pragma unroll
            for (int s2 = 0; s2 < 2; ++s2) {
                u32x4 pw; pw.x = pk2(p[8 * s2], p[8 * s2 + 1]); pw.y = pk2(p[8 * s2 + 2], p[8 * s2 + 3]); pw.z = pk2(p[8 * s2 + 4], p[8 * s2 + 5]); pw.w = pk2(p[8 * s2 + 6], p[8 * s2 + 7]);
                const bf16x8 pf = __builtin_bit_cast(bf16x8, pw);
                const int kb = (T0 + kt) * 32 + 16 * s2 + 4 * hh;
                const LAS bf16_t* v0 = VTl + r32 * 260 + kb; const LAS bf16_t* v1 = v0 + 32 * 260;
                const s16x4 a0 = *(const LAS s16x4*)v0, a1 = *(const LAS s16x4*)(v0 + 8), b0 = *(const LAS s16x4*)v1, b1 = *(const LAS s16x4*)(v1 + 8);
                const bf16x8 vf0 = (bf16x8){a0[0], a0[1], a0[2], a0[3], a1[0], a1[1], a1[2], a1[3]}, vf1 = (bf16x8){b0[0], b0[1], b0[2], b0[3], b1[0], b1[1], b1[2], b1[3]};
                O0 = __builtin_amdgcn_mfma_f32_32x32x16_bf16(vf0, pf, O0, 0, 0, 0);
                O1 = __builtin_amdgcn_mfma_f32_32x32x16_bf16(vf1, pf, O1, 0, 0, 0);
            }
        }
        lsum += __shfl_xor(lsum, 32);
        lsum += __builtin_amdgcn_exp2f(sink2 - mx);
        const float inv = 1.0f / lsum;
        const float is8 = inv * ACT_S; unsigned char* op = ATT8 + qrow * D + head * 64 + 4 * hh;
#pragma unroll
        for (int gq = 0; gq < 4; ++gq) { *(unsigned*)(op + 8 * gq) = pk4_fp8(O0[4 * gq] * is8, O0[4 * gq + 1] * is8, O0[4 * gq + 2] * is8, O0[4 * gq + 3] * is8);
            *(unsigned*)(op + 32 + 8 * gq) = pk4_fp8(O1[4 * gq] * is8, O1[4 * gq + 1] * is8, O1[4 * gq + 2] * is8, O1[4 * gq + 3] * is8); }
    }
}
__device__ __forceinline__ void p4_attention(const Ctx& X, CArgs& a, int wi, int nwk) {
#ifndef NO_MFMA_ATT
    for (int u = ATT_P3 + wi; u < BATCH * KVH * (SEQ / 128); u += nwk) { const int qb = u & 31, kvh = (u >> 5) & 7, b = u >> 8; att_prompt_unit(X, a, b, kvh, qb); }
#endif
    __syncthreads();

}


__device__ __forceinline__ bf16x8 cvt8(const f32x4 x, const f32x4 y) { u32x4 p; p.x = pk2(x[0], x[1]); p.y = pk2(x[2], x[3]); p.z = pk2(y[0], y[1]); p.w = pk2(y[2], y[3]); return __builtin_bit_cast(bf16x8, p); }
__device__ __forceinline__ void att_sample_wave(const Ctx& X, CArgs& a, int b, int kvh, const LAS float* btab  ) {
    unsigned char* ws = a.ws; const bf16_t* BIG = (const bf16_t*)(ws + WS_BIG); unsigned char* ATT8 = ws + WS_ATT8;
    const int lane = X.lane, r32 = lane & 31, hh = lane >> 5;
    constexpr float L2E = 1.4426950408889634f;
    const int g = r32 >> 3, t = r32 & 7, head = kvh * 4 + g;
    const size_t qrow = (size_t)MP + b * 8 + t;
    const float sink2 = a.in[19][head] * L2E;
    const char* ckb = (const char*)(a.in[4] + (((size_t)b * 128) * KVH + kvh) * HD);
    const char* cvb = (const char*)(a.in[5] + (((size_t)b * 128) * KVH + kvh) * HD);
    const char* nkb = (const char*)(BIG + ((size_t)MP + b * 8) * NW + C_AK + kvh * 64);
    const char* nvb = (const char*)(BIG + ((size_t)MP + b * 8) * NW + C_AV + kvh * 64);
    const unsigned loK = (unsigned)(r32 * 2048 + hh * 32), loV = (unsigned)(hh * 4 * 2048 + r32 * 4), loNK = (unsigned)((r32 & 7) * NW * 2 + hh * 16), loNV = (unsigned)(r32 * 2);
    bf16x8 Qf[4];
#pragma unroll
    for (int ks = 0; ks < 4; ++ks) Qf[ks] = *(const bf16x8*)(BIG + qrow * NW + C_AQ + head * 64 + ks * 16 + 8 * hh);
    f32x16 sc[5];
#pragma unroll
    for (int kt = 0; kt < 5; ++kt) {
        f32x16 acc;
#pragma unroll
        for (int r = 0; r < 16; ++r) acc[r] = 0.f;
#pragma unroll
        for (int ks = 0; ks < 4; ++ks) {
            bf16x8 kf;
            if (kt < 4) { const char* kp = ckb + (size_t)kt * 32 * 2048 + ks * 64; kf = cvt8(*(const f32x4*)(kp + loK), *(const f32x4*)(kp + loK + 16)); }
            else { u32x4 z = (u32x4){0u, 0u, 0u, 0u}; if (r32 < 8) z = *(const u32x4*)(nkb + ks * 32 + loNK); kf = __builtin_bit_cast(bf16x8, z); }
            acc = __builtin_amdgcn_mfma_f32_32x32x16_bf16(kf, Qf[ks], acc, 0, 0, 0);
        }
#pragma unroll
        for (int r = 0; r < 16; ++r) { const int jj = kt * 32 + (r & 3) + 8 * (r >> 2) + 4 * hh; const int dist = t + 128 - jj; const bool valid = (dist >= 0) && (dist < 128);
            const int dcl = dist < 0 ? 0 : (dist > 127 ? 127 : dist);
            sc[kt][r] = valid ? acc[r] * (0.125f * L2E) + btab[head * 128 + dcl] : -INFINITY; }
        asm volatile("" ::: "memory");
    }
    float mx = sink2;
#pragma unroll
    for (int kt = 0; kt < 5; ++kt)
#pragma unroll
        for (int r = 0; r < 16; ++r) mx = fmaxf(mx, sc[kt][r]);
    mx = fmaxf(mx, __shfl_xor(mx, 32));
    float lsum = 0.f; f32x16 O0, O1;
#pragma unroll
    for (int r = 0; r < 16; ++r) { O0[r] = 0.f; O1[r] = 0.f; }
#pragma unroll
    for (int kt = 0; kt < 5; ++kt) {
        float p[16];
#pragma unroll
        for (int r = 0; r < 16; ++r) { p[r] = __builtin_amdgcn_exp2f(sc[kt][r] - mx); lsum += p[r]; }
#pragma unroll
        for (int s2 = 0; s2 < 2; ++s2) {
            if (kt == 4 && s2 == 1) continue;
            u32x4 pw; pw.x = pk2(p[8 * s2], p[8 * s2 + 1]); pw.y = pk2(p[8 * s2 + 2], p[8 * s2 + 3]); pw.z = pk2(p[8 * s2 + 4], p[8 * s2 + 5]); pw.w = pk2(p[8 * s2 + 6], p[8 * s2 + 7]);
            const bf16x8 pf = __builtin_bit_cast(bf16x8, pw);
            float v0[8], v1[8];
#pragma unroll
            for (int e = 0; e < 8; ++e) { const int ju = kt * 32 + 16 * s2 + 8 * (e >> 2) + (e & 3);
                if (kt < 4) { const char* vp = cvb + (size_t)ju * 2048; v0[e] = *(const float*)(vp + loV); v1[e] = *(const float*)(vp + loV + 128); }
                else if (ju < 136) { const char* vp = nvb + (size_t)(ju - 128) * NW * 2;
                    v0[e] = bf2f(*(const bf16_t*)(vp + (size_t)hh * 4 * NW * 2 + loNV)); v1[e] = bf2f(*(const bf16_t*)(vp + (size_t)hh * 4 * NW * 2 + loNV + 64)); }
                else { v0[e] = 0.f; v1[e] = 0.f; } }
            u32x4 a0, a1; a0.x = pk2(v0[0], v0[1]); a0.y = pk2(v0[2], v0[3]); a0.z = pk2(v0[4], v0[5]); a0.w = pk2(v0[6], v0[7]); a1.x = pk2(v1[0], v1[1]); a1.y = pk2(v1[2], v1[3]); a1.z = pk2(v1[4], v1[5]); a1.w = pk2(v1[6], v1[7]);
            O0 = __builtin_amdgcn_mfma_f32_32x32x16_bf16(__builtin_bit_cast(bf16x8, a0), pf, O0, 0, 0, 0);
            O1 = __builtin_amdgcn_mfma_f32_32x32x16_bf16(__builtin_bit_cast(bf16x8, a1), pf, O1, 0, 0, 0);
            asm volatile("" ::: "memory");
        }
    }
    lsum += __shfl_xor(lsum, 32);
    lsum += __builtin_amdgcn_exp2f(sink2 - mx);
    const float inv = 1.0f / lsum;
    const float is8 = inv * ACT_S; unsigned char* op = ATT8 + qrow * D + head * 64 + 4 * hh;
#pragma unroll
    for (int gq = 0; gq < 4; ++gq) { *(unsigned*)(op + 8 * gq) = pk4_fp8(O0[4 * gq] * is8, O0[4 * gq + 1] * is8, O0[4 * gq + 2] * is8, O0[4 * gq + 3] * is8);
        *(unsigned*)(op + 32 + 8 * gq) = pk4_fp8(O1[4 * gq] * is8, O1[4 * gq + 1] * is8, O1[4 * gq + 2] * is8, O1[4 * gq + 3] * is8); }
}
__device__ __forceinline__ void p3_sample_attention(const Ctx& X, CArgs& a, int wi, int nwk) {
    LAS float* btab = (LAS float*)X.lds;
    __syncthreads();
    for (int i = X.tid; i < HEADS * 128; i += NTHREADS) { const int h = i >> 7, d = i & 127; btab[i] = a.in[10][t5_bucket(d) * HEADS + h] * 1.4426950408889634f; }
    __syncthreads();
    const int gw = wi * NWAVES + X.wave, NGW = nwk * NWAVES;
    for (int u = gw; u < DEC_BATCH * KVH; u += NGW) att_sample_wave(X, a, u >> 3, u & 7, btab);
    __syncthreads();
}

__device__ __forceinline__ void p3_state_copies(const Ctx& X, CArgs& a, int wi, int nwk) {
    const bf16_t* BIG = (const bf16_t*)(a.ws + WS_BIG); float* out = a.out;
    const int gt = wi * NTHREADS + X.tid, GT = nwk * NTHREADS;
    auto bf4 = [](const bf16_t* p) { const u32x2 w = *(const u32x2*)p; return (f32x4){bflo(w.x), bfhi(w.x), bflo(w.y), bfhi(w.y)}; };
    for (int i = gt; i < 4 * 128 * 128; i += GT) { const int c4 = (i & 127) * 4, w = (i >> 7) & 127, b = i >> 14; const size_t r = (size_t)b * SEQ + (SEQ - 128) + w; const size_t o = ((size_t)(b * 128 + w)) * 512 + c4;
        *(f32x4*)(out + O_KWP + o) = bf4(BIG + r * NW + C_AK + c4); *(f32x4*)(out + O_VWP + o) = bf4(BIG + r * NW + C_AV + c4); }
    for (int i = gt; i < 128 * 128 * 128; i += GT) { const int c4 = (i & 127) * 4, w = (i >> 7) & 127, b = i >> 14; const size_t o = ((size_t)(b * 128 + w)) * 512 + c4;
        if (w < 120) { const size_t sidx = ((size_t)b * 128 + w + 8) * 512 + c4; __builtin_nontemporal_store(__builtin_nontemporal_load((const f32x4*)(a.in[4] + sidx)), (f32x4*)(out + O_KWS + o)); __builtin_nontemporal_store(__builtin_nontemporal_load((const f32x4*)(a.in[5] + sidx)), (f32x4*)(out + O_VWS + o)); }
        else { const size_t r = (size_t)MP + b * 8 + (w - 120); *(f32x4*)(out + O_KWS + o) = bf4(BIG + r * NW + C_AK + c4); *(f32x4*)(out + O_VWS + o) = bf4(BIG + r * NW + C_AV + c4); } }
    for (int i = gt; i < 4 * 3 * 512; i += GT) { const int c4 = (i & 511) * 4, j = (i >> 9) % 3, b = i / (3 * 512); *(f32x4*)(out + O_CONVP + ((size_t)(b * 3 + j)) * 2048 + c4) = bf4(BIG + ((size_t)b * SEQ + SEQ - 3 + j) * NW + C_MQK + c4); }
    for (int i = gt; i < 128 * 3 * 512; i += GT) { const int c4 = (i & 511) * 4, j = (i >> 9) % 3, b = i / (3 * 512); *(f32x4*)(out + O_CONVS + ((size_t)(b * 3 + j)) * 2048 + c4) = bf4(BIG + ((size_t)MP + b * 8 + 5 + j) * NW + C_MQK + c4); }
}

__device__ __forceinline__ void mlstm_unit(const Ctx& X, CArgs& a, size_t row0, int T, int h, int vs,
                                           const float* C0, const float* n0, const float* m0p, const float* convbuf  ,
                                           float* Cout, float* nout, float* mout) {
    unsigned char* ws = a.ws;
    const bf16_t* BIG = (const bf16_t*)(ws + WS_BIG); const float* MIF = (const float*)(ws + WS_MIF); bf16_t* HRAW = (bf16_t*)(ws + WS_HMO);
    LAS float* qk = (LAS float*)X.lds;
    LAS float* red = qk + 512;
    LAS float* nred = red + 512;
    const int tid = X.tid, g = tid >> 6, dv = tid & 63;
    const int ch = tid < 256 ? h * 256 + tid : 1024 + h * 256 + (tid - 256);
    const float w0 = a.in[16][ch], w1 = a.in[16][2048 + ch], w2 = a.in[16][4096 + ch], w3 = a.in[16][6144 + ch], cb = a.in[17][ch];
    float x1 = 0.f, x2 = 0.f, x3 = 0.f;
    if (convbuf) { x3 = convbuf[ch]; x2 = convbuf[2048 + ch]; x1 = convbuf[4096 + ch]; }
    float C[32], nn = 0.f, mprev = 0.f;
#pragma unroll
    for (int j = 0; j < 32; ++j) C[j] = C0 ? C0[(size_t)(32 * g + j) * DV + vs * 64 + dv] : 0.f;
    if (n0 && tid < 256) nn = n0[tid];
    if (m0p) mprev = m0p[0];
    for (int t0 = 0; t0 < T; t0 += 8) {
        float xin[8], vin[8], ig_[8], lf_[8];
#pragma unroll
        for (int u = 0; u < 8; ++u) { const size_t r = row0 + t0 + u;
            xin[u] = bf2f(BIG[r * NW + C_MQK + ch]); vin[u] = bf2f(BIG[r * NW + C_MV + h * DV + vs * 64 + dv]);
            ig_[u] = MIF[r * 8 + h]; lf_[u] = MIF[r * 8 + 4 + h]; }
#pragma unroll
        for (int u = 0; u < 8; ++u) {
            const float x0 = xin[u];
            float y = cb + x3 * w0; y = y + x2 * w1; y = y + x1 * w2; y = y + x0 * w3;
            x3 = x2; x2 = x1; x1 = x0;
            float sv = y / (1.0f + expf(-y));
            if (tid >= 256) sv *= 0.0625f;
            qk[tid] = sv;
            __syncthreads();
            const float mnew = fmaxf(lf_[u] + mprev, ig_[u]);
            const float fg = expf(lf_[u] + mprev - mnew), ig = expf(ig_[u] - mnew);
            const float iv = ig * vin[u];
            float ph = 0.f;
#pragma unroll
            for (int j = 0; j < 32; ++j) { const float kk = qk[256 + 32 * g + j], qq = qk[32 * g + j]; C[j] = fg * C[j] + kk * iv; ph += qq * C[j]; }
            red[g * 64 + dv] = ph;
            if (tid < 256) { nn = fg * nn + ig * qk[256 + tid]; float pn = qk[tid] * nn; pn = wave_sum(pn); if (X.lane == 0) nred[X.wave] = pn; }
            __syncthreads();
            if (tid < 64) { float hs = 0.f;
#pragma unroll
                for (int gg = 0; gg < 8; ++gg) hs += red[gg * 64 + tid];
                const float qn = (nred[0] + nred[1]) + (nred[2] + nred[3]);
                const float den = fmaxf(fabsf(qn), expf(-mnew));
                HRAW[(row0 + t0 + u) * D + h * DV + vs * 64 + tid] = (bf16_t)f2bf(hs / den); }
            mprev = mnew;
        }
    }
#pragma unroll
    for (int j = 0; j < 32; ++j) Cout[(size_t)(32 * g + j) * DV + vs * 64 + dv] = C[j];
    if (vs == 0) { if (tid < 256) nout[tid] = nn; if (tid == 0) mout[0] = mprev; }
    __syncthreads();
}
__device__ __forceinline__ void p3_mlstm(const Ctx& X, CArgs& a) {
    float* out = a.out;
    constexpr int NPU = BATCH * MLH * 8, NSU = DEC_BATCH * MLH * 8;
    for (int u = X.vcu; u < NPU + NSU; u += X.G) {
        if (u < NPU) { const int b = u >> 5, h = (u >> 3) & 3, vs = u & 7;
            mlstm_unit(X, a, (size_t)b * SEQ, SEQ, h, vs, nullptr, nullptr, nullptr, nullptr,
                       out + O_CP + (size_t)(b * MLH + h) * DK * DV, out + O_NP + (size_t)(b * MLH + h) * DK, out + O_MPO + b * MLH + h); }
        else { const int v = u - NPU, b = v >> 5, h = (v >> 3) & 3, vs = v & 7; const size_t bh = (size_t)b * MLH + h;
            mlstm_unit(X, a, (size_t)MP + b * 8, 8, h, vs, a.in[7] + bh * DK * DV, a.in[8] + bh * DK, a.in[9] + bh, a.in[6] + (size_t)b * 3 * 2048,
                       out + O_CS + bh * DK * DV, out + O_NS + bh * DK, out + O_MSO + bh); }
    }
}

__device__ __forceinline__ void p2_gates(const Ctx& X, CArgs& a, int bh) {
    unsigned char* ws = a.ws; const float* MIF = (const float*)(ws + WS_MIF); float* MG = (float*)(ws + WS_MG);
    LAS float* li = (LAS float*)X.lds; LAS float* lf = li + 64 * 65; LAS float* lbc = lf + 64 * 65; LAS float* lrm = lbc + 64 * 65;
    LAS float* lcb = lrm + 64 * 65; LAS float* lcg = lcb + 64; LAS float* lms = lcg + 64;
    const int b = bh >> 2, h = bh & 3, tid = X.tid;
    for (int t = tid; t < SEQ; t += NTHREADS) { const size_t r = (size_t)b * SEQ + t; const int idx = (t >> 6) * 65 + (t & 63); li[idx] = MIF[r * 8 + h]; lf[idx] = MIF[r * 8 + 4 + h]; }
    __syncthreads();
    if (tid < 64) { float bc = 0.f, rm = -3.0e38f;
        for (int t = 0; t < 64; ++t) { const int idx = tid * 65 + t; bc += lf[idx]; const float g = li[idx] - bc; rm = fmaxf(rm, g); lbc[idx] = bc; lrm[idx] = rm; }
        lcb[tid] = bc; lcg[tid] = rm; }
    __syncthreads();
    if (tid == 0) { float m = 0.f; lms[0] = 0.f; for (int c = 0; c < 64; ++c) { m = lcb[c] + fmaxf(m, lcg[c]); lms[c + 1] = m; } }
    __syncthreads();
    for (int t = tid; t < SEQ; t += NTHREADS) { const int c = t >> 6, idx = c * 65 + (t & 63); const float mprev = lms[c], mc = lms[c + 1], bc = lbc[idx], iv = li[idx];
        const float mt = bc + fmaxf(mprev, lrm[idx]); const size_t o = (size_t)bh * SEQ + t;
        MG[MG_A1 + o] = bc - mt; MG[MG_G + o] = iv - bc; MG[MG_WIN + o] = expf(bc + mprev - mt); MG[MG_EMI + o] = expf(-mt); MG[MG_WK + o] = expf(lcb[c] - bc + iv - mc); }
    if (tid < 64) MG[MG_DEC + bh * 64 + tid] = expf(lcb[tid] + lms[tid] - lms[tid + 1]);
    if (tid == 0) a.out[O_MPO + bh] = lms[64];
    __syncthreads();
}

__device__ __forceinline__ void m1_prep_unit(const Ctx& X, CArgs& a, int bh, int c) {
    unsigned char* ws = a.ws; const bf16_t* BIG = (const bf16_t*)(ws + WS_BIG); const float* MG = (const float*)(ws + WS_MG);
    bf16_t* QC = (bf16_t*)(ws + WS_QC); bf16_t* KWT = (bf16_t*)(ws + WS_KWT); bf16_t* VT = (bf16_t*)(ws + WS_VT); bf16_t* SM = (bf16_t*)(ws + WS_SM);
    LAS bf16_t* qs = (LAS bf16_t*)X.lds; LAS bf16_t* ksl = qs + 64 * 264;
    LAS bf16_t* vl = (LAS bf16_t*)X.lds;
    LAS float* wkl = (LAS float*)(X.lds + 2 * 64 * 264 * 2);
    LAS float* rsl = wkl + 64;
    LAS float* a1l = rsl + 64; LAS float* gl = a1l + 64;
    float* MGw = (float*)(ws + WS_MG);
    const int b = bh >> 2, h = bh & 3, tid = X.tid, lane = X.lane, w = X.wave, fr = lane & 15, fq = lane >> 4;
    const size_t row0 = (size_t)b * SEQ + c * 64;
    if (tid < 64) { const size_t o_ = (size_t)bh * SEQ + c * 64 + tid; wkl[tid] = MG[MG_WK + o_]; rsl[tid] = 0.f; a1l[tid] = MG[MG_A1 + o_]; gl[tid] = MG[MG_G + o_]; }
    {
        const int cg = tid & 63, ts = tid >> 6;
        const int ch0 = cg < 32 ? h * 256 + cg * 8 : 1024 + h * 256 + (cg - 32) * 8;
        const int t0 = ts * 8;
        u32x4 xr[11];
#pragma unroll
        for (int i = 0; i < 11; ++i) { const int t = t0 - 3 + i; xr[i] = (u32x4){0u, 0u, 0u, 0u};
            if (t >= 0 || c > 0) xr[i] = *(const u32x4*)(BIG + (size_t)((long)row0 + t) * NW + C_MQK + ch0); }
        const float kscale = cg < 32 ? 1.0f : 0.0625f;
        LAS bf16_t* dstb = (cg < 32 ? qs : ksl) + (cg & 31) * 8;
#pragma unroll
        for (int jp = 0; jp < 4; ++jp) {
            const f32x2 w0 = *(const f32x2*)(a.in[16] + ch0 + 2 * jp), w1 = *(const f32x2*)(a.in[16] + 2048 + ch0 + 2 * jp), w2 = *(const f32x2*)(a.in[16] + 4096 + ch0 + 2 * jp), w3 = *(const f32x2*)(a.in[16] + 6144 + ch0 + 2 * jp), cb = *(const f32x2*)(a.in[17] + ch0 + 2 * jp);
#pragma unroll
            for (int u = 0; u < 8; ++u) { const unsigned a0 = xr[u][jp], a1 = xr[u + 1][jp], a2 = xr[u + 2][jp], a3 = xr[u + 3][jp];
                float ylo = cb.x + bflo(a0) * w0.x; ylo = ylo + bflo(a1) * w1.x; ylo = ylo + bflo(a2) * w2.x; ylo = ylo + bflo(a3) * w3.x;
                float yhi = cb.y + bfhi(a0) * w0.y; yhi = yhi + bfhi(a1) * w1.y; yhi = yhi + bfhi(a2) * w2.y; yhi = yhi + bfhi(a3) * w3.y;
                *(LAS unsigned*)(dstb + (t0 + u) * 264 + 2 * jp) = pk2(ylo * __builtin_amdgcn_rcpf(1.0f + __expf(-ylo)) * kscale, yhi * __builtin_amdgcn_rcpf(1.0f + __expf(-yhi)) * kscale); }
            asm volatile("" ::: "memory"); }
    }
    __syncthreads();
    if (tid < 256) { float ac = 0.f;
#pragma unroll 8
        for (int s2 = 0; s2 < 64; ++s2) ac += bf2f(ksl[s2 * 264 + tid]) * wkl[s2];
        MGw[MG_AC + ((size_t)bh * 64 + c) * 256 + tid] = ac; }
#pragma unroll
    for (int i = 0; i < 4; ++i) { const int id = i * NTHREADS + tid, t = id >> 5, seg = id & 31;
        *(u32x4*)(QC + (row0 + t) * 1024 + h * 256 + seg * 8) = *(const LAS u32x4*)(qs + t * 264 + seg * 8); }
#pragma unroll
    for (int i = 0; i < 4; ++i) { const int id = i * NTHREADS + tid, dk = id & 255, tg = id >> 8;
        const f32x4 wa = *(const LAS f32x4*)(wkl + tg * 8), wb = *(const LAS f32x4*)(wkl + tg * 8 + 4);
        float v[8];
#pragma unroll
        for (int j = 0; j < 8; ++j) v[j] = bf2f(ksl[(tg * 8 + j) * 264 + dk]);
        u32x4 o; o.x = pk2(v[0] * wa[0], v[1] * wa[1]); o.y = pk2(v[2] * wa[2], v[3] * wa[3]); o.z = pk2(v[4] * wb[0], v[5] * wb[1]); o.w = pk2(v[6] * wb[2], v[7] * wb[3]);
        *(u32x4*)(KWT + ((((size_t)bh * 64 + c) * 8 + tg) * 256 + dk) * 8) = o; }
    u32x4 vpre[8];
#pragma unroll
    for (int i = 0; i < 8; ++i) { const int id = i * NTHREADS + tid, t = id >> 6, seg = id & 63; vpre[i] = *(const u32x4*)(BIG + (row0 + t) * NW + C_MV + h * DV + seg * 8); }
    {
        const int tm = w & 3, sp = w >> 2;
        f32x4 acc[2]; acc[0] = (f32x4){0.f, 0.f, 0.f, 0.f}; acc[1] = acc[0]; float rsum[4] = {0.f, 0.f, 0.f, 0.f};
#pragma unroll
        for (int ks = 0; ks < 8; ++ks) { const bf16x8 af = *(const LAS bf16x8*)(qs + (tm * 16 + fr) * 264 + ks * 32 + 8 * fq);
#pragma unroll
            for (int j = 0; j < 2; ++j) { const bf16x8 bf = *(const LAS bf16x8*)(ksl + ((2 * sp + j) * 16 + fr) * 264 + ks * 32 + 8 * fq); acc[j] = __builtin_amdgcn_mfma_f32_16x16x32_bf16(af, bf, acc[j], 0, 0, 0); } }
        const float* A1 = MG + MG_A1 + (size_t)bh * SEQ + c * 64; const float* Gp = MG + MG_G + (size_t)bh * SEQ + c * 64;
#pragma unroll
        for (int j = 0; j < 2; ++j) { const int sidx = (2 * sp + j) * 16 + fr; const float gs = gl[sidx];
#pragma unroll
            for (int e = 0; e < 4; ++e) { const int t = tm * 16 + 4 * fq + e; const float val = (sidx <= t) ? acc[j][e] * __expf(a1l[t] + gs) : 0.f; const bf16_t vb = (bf16_t)f2bf(val);
                SM[((((size_t)bh * 64 + c) * 8 + (sidx >> 3)) * 64 + t) * 8 + (sidx & 7)] = vb; rsum[e] += bf2f(vb); } }
#pragma unroll
        for (int e = 0; e < 4; ++e) { const float r16 = row_sum16(rsum[e]); if (fr == 0) atomicAdd((float*)(rsl + tm * 16 + 4 * fq + e), r16); }
    }
    __syncthreads();
    if (tid < 64) MGw[MG_RS + (size_t)bh * SEQ + c * 64 + tid] = rsl[tid];
    __syncthreads();
#pragma unroll
    for (int i = 0; i < 8; ++i) { const int id = i * NTHREADS + tid, t = id >> 6, seg = id & 63; *(LAS u32x4*)(vl + t * 520 + seg * 8) = vpre[i]; }
    __syncthreads();
#pragma unroll
    for (int i = 0; i < 8; ++i) { const int id = i * NTHREADS + tid, tg = id & 7, dv = id >> 3; unsigned short v[8];
#pragma unroll
        for (int j = 0; j < 8; ++j) v[j] = vl[(tg * 8 + j) * 520 + dv];
        u32x4 o; o.x = v[0] | ((unsigned)v[1] << 16); o.y = v[2] | ((unsigned)v[3] << 16); o.z = v[4] | ((unsigned)v[5] << 16); o.w = v[6] | ((unsigned)v[7] << 16);
        *(u32x4*)(VT + ((size_t)bh * DV + dv) * SEQ + c * 64 + tg * 8) = o; }
    __syncthreads();
}

__device__ __forceinline__ void m1_sample_unit(const Ctx& X, CArgs& a, int bh) {
    unsigned char* ws = a.ws; const bf16_t* BIG = (const bf16_t*)(ws + WS_BIG); const float* MIF = (const float*)(ws + WS_MIF); bf16_t* HRAW = (bf16_t*)(ws + WS_HMO);
    LAS float* QT = (LAS float*)X.lds;
    LAS float* KT = QT + 2048;
    LAS float* gsm = KT + 2048;
    LAS float* Sm = gsm + 96;
    LAS float* hred = Sm + 64;
    const int b = bh >> 2, h = bh & 3, tid = X.tid, lane = X.lane, w = X.wave;
    const size_t row0 = (size_t)MP + b * 8;
    const float* C0 = a.in[7] + (size_t)bh * DK * DV; float* Cout = a.out + O_CS + (size_t)bh * DK * DV;
    if (tid == 0) { const float m0 = a.in[9][bh]; float bc = 0.f, rm = -3.0e38f;
        for (int t = 0; t < 8; ++t) { const float iv = MIF[(row0 + t) * 8 + h], fv = MIF[(row0 + t) * 8 + 4 + h]; bc += fv; rm = fmaxf(rm, iv - bc); const float mt = bc + fmaxf(m0, rm);
            gsm[t] = bc; gsm[8 + t] = iv; gsm[16 + t] = mt; gsm[24 + t] = expf(bc + m0 - mt); gsm[32 + t] = expf(-mt); }
        const float mnew = bc + fmaxf(m0, rm);
        for (int t = 0; t < 8; ++t) gsm[40 + t] = expf(bc - gsm[t] + gsm[8 + t] - mnew);
        gsm[88] = expf(bc + m0 - mnew); gsm[89] = mnew; a.out[O_MSO + bh] = mnew; }
    {
        const int ch = tid < 256 ? h * 256 + tid : 1024 + h * 256 + (tid - 256);
        const float w0 = a.in[16][ch], w1 = a.in[16][2048 + ch], w2 = a.in[16][4096 + ch], w3 = a.in[16][6144 + ch], cb = a.in[17][ch];
        const float* cbuf = a.in[6] + (size_t)b * 3 * 2048; float x3 = cbuf[ch], x2 = cbuf[2048 + ch], x1 = cbuf[4096 + ch];
        float xin[8];
#pragma unroll
        for (int u = 0; u < 8; ++u) xin[u] = bf2f(BIG[(row0 + u) * NW + C_MQK + ch]);
        LAS float* dst = (tid < 256 ? QT : KT) + (tid & 255) * 8;
#pragma unroll
        for (int u = 0; u < 8; ++u) { const float x0 = xin[u]; float y = cb + x3 * w0; y = y + x2 * w1; y = y + x1 * w2; y = y + x0 * w3; x3 = x2; x2 = x1; x1 = x0;
            float sv = y / (1.0f + expf(-y)); if (tid >= 256) sv *= 0.0625f; dst[u] = sv; }
    }
    __syncthreads();
    for (int p = w * 8; p < w * 8 + 8; ++p) { const int t = p >> 3, sidx = p & 7; float d = 0.f;
#pragma unroll
        for (int j = 0; j < 4; ++j) { const int dk = lane + 64 * j; d += QT[dk * 8 + t] * KT[dk * 8 + sidx]; }
        d = wave_sum(d);
        if (lane == 0) Sm[p] = (sidx <= t) ? d * expf(gsm[t] - gsm[sidx] + gsm[8 + sidx] - gsm[16 + t]) : 0.f; }
    { const int t = w; float d = 0.f;
#pragma unroll
      for (int j = 0; j < 4; ++j) { const int dk = lane + 64 * j; d += QT[dk * 8 + t] * a.in[8][(size_t)bh * DK + dk]; }
      d = wave_sum(d); if (lane == 0) gsm[64 + t] = d; }
    __syncthreads();
    if (tid < 8) { float rs = 0.f;
#pragma unroll
        for (int j = 0; j < 8; ++j) rs += Sm[tid * 8 + j];
        const float den = rs + gsm[24 + tid] * gsm[64 + tid]; const float dn = fmaxf(fabsf(den), gsm[32 + tid]); gsm[56 + tid] = 1.0f / dn; gsm[48 + tid] = gsm[24 + tid] / dn; }
    for (int i = tid; i < 2048; i += NTHREADS) KT[i] *= gsm[40 + (i & 7)];
    __syncthreads();
    const float dec = gsm[88];
    if (tid < 256) { float sn = 0.f;
#pragma unroll
        for (int j = 0; j < 8; ++j) sn += KT[tid * 8 + j];
        a.out[O_NS + (size_t)bh * DK + tid] = dec * a.in[8][(size_t)bh * DK + tid] + sn; }
    {
        const int cg = tid & 127, kg = tid >> 7;
        f32x4 vv[8], hacc[8];
#pragma unroll
        for (int t = 0; t < 8; ++t) { const u32x2 wv = *(const u32x2*)(BIG + (row0 + t) * NW + C_MV + h * DV + 4 * cg); vv[t] = (f32x4){bflo(wv.x), bfhi(wv.x), bflo(wv.y), bfhi(wv.y)}; hacc[t] = (f32x4){0.f, 0.f, 0.f, 0.f}; }
#pragma unroll 1
        for (int d0 = 0; d0 < 64; d0 += 8) {
            f32x4 c0[8];
#pragma unroll
            for (int u = 0; u < 8; ++u) c0[u] = __builtin_nontemporal_load((const f32x4*)(C0 + (size_t)(kg * 64 + d0 + u) * DV + 4 * cg));
#pragma unroll
            for (int u = 0; u < 8; ++u) { const int dk = kg * 64 + d0 + u;
                const f32x4 qa = *(const LAS f32x4*)(QT + dk * 8), qb = *(const LAS f32x4*)(QT + dk * 8 + 4), ka = *(const LAS f32x4*)(KT + dk * 8), kb = *(const LAS f32x4*)(KT + dk * 8 + 4);
                f32x4 cn = c0[u] * dec;
#pragma unroll
                for (int t = 0; t < 4; ++t) { hacc[t] = hacc[t] + c0[u] * qa[t]; hacc[4 + t] = hacc[4 + t] + c0[u] * qb[t]; cn = cn + vv[t] * ka[t]; cn = cn + vv[4 + t] * kb[t]; }
                __builtin_nontemporal_store(cn, (f32x4*)(Cout + (size_t)dk * DV + 4 * cg)); asm volatile("" ::: "memory"); }
        }
#pragma unroll
        for (int t = 0; t < 8; ++t) *(LAS f32x4*)(hred + (kg * 8 + t) * 512 + 4 * cg) = hacc[t];
    }
    __syncthreads();
    { const int t = tid >> 6; const float f1 = gsm[48 + t], f2 = gsm[56 + t];
#pragma unroll 1
      for (int j = 0; j < 8; ++j) { const int dv = lane + 64 * j; const float inter = (hred[(0 * 8 + t) * 512 + dv] + hred[(1 * 8 + t) * 512 + dv]) + (hred[(2 * 8 + t) * 512 + dv] + hred[(3 * 8 + t) * 512 + dv]);
          float intra = 0.f;
#pragma unroll
          for (int s2 = 0; s2 < 8; ++s2) intra += Sm[t * 8 + s2] * bf2f(BIG[(row0 + s2) * NW + C_MV + h * DV + dv]);
          HRAW[(row0 + t) * D + h * DV + dv] = (bf16_t)f2bf(intra * f2 + inter * f1); } }
    __syncthreads();
}

__device__ __forceinline__ bf16x8 ldg8(const char* ubase, unsigned loff) { return *(const bf16x8*)(ubase + loff); }
__device__ __forceinline__ void m2_scan_unit(const Ctx& X, CArgs& a, int bh, int vs) {
    unsigned char* ws = a.ws; const float* MG = (const float*)(ws + WS_MG); bf16_t* HRAW = (bf16_t*)(ws + WS_HMO);
    const int b = bh >> 2, h = bh & 3, tid = X.tid, lane = X.lane, w = X.wave, fr = lane & 15, fq = lane >> 4, tm = w & 3, dp = w >> 2;
    LAS bf16_t* CT = (LAS bf16_t*)X.lds;
    LAS unsigned char* stQ = X.lds + 69632;
    LAS unsigned char* stV = X.lds + 69632 + 65536;
    const char* Qg = (const char*)(ws + WS_QC) + (((size_t)b * SEQ) * 1024 + h * 256) * 2;
    const char* Vg = (const char*)(ws + WS_VT) + ((size_t)bh * DV + vs * 64) * SEQ * 2;
    const char* Sb = (const char*)(ws + WS_SM) + ((size_t)bh * 64 * 4096 + tm * 16 * 8) * 2;
    const char* KWb = (const char*)(ws + WS_KWT) + ((size_t)bh * 64 * 16384 + 2 * w * 16 * 8) * 2;
    const unsigned loS = (unsigned)(fq * 1024 + fr * 16), loT = (unsigned)(fq * 4096 + fr * 16);
    const int R0 = 8 * w + (lane >> 5); const unsigned zq = (unsigned)((lane & 31) ^ (R0 & 31));
    const int rs8 = 8 * w + (lane >> 3); const unsigned dv_ = (unsigned)(rs8 * SEQ * 2 + (((lane & 7) ^ ((rs8 >> 1) & 7)) * 16));
#define SCAN_DMA(c_) do { const char* q_ = Qg + (size_t)(c_) * (64 * 2048); const char* v_ = Vg + (size_t)(c_) * 128; const int sb_ = (c_) & 1; \
        _Pragma("unroll") for (int i_ = 0; i_ < 4; ++i_) __builtin_amdgcn_global_load_lds((const unsigned*)(q_ + (unsigned)((R0 + 2 * i_) * 2048) + ((zq ^ (unsigned)(2 * i_)) * 16u)), (LAS unsigned*)(stQ + sb_ * 32768 + (4 * w + i_) * 1024), 16, 0, 0); \
        __builtin_amdgcn_global_load_lds((const unsigned*)(v_ + dv_), (LAS unsigned*)(stV + sb_ * 8192 + w * 1024), 16, 0, 0); } while (0)
    const int rq = tm * 16 + fr;
    const unsigned yq = (unsigned)(fq ^ (rq & 31)), yv = (unsigned)(fq ^ ((fr >> 1) & 7));
    const unsigned bq = (unsigned)(rq * 512), bv = (unsigned)(fr * 128);
    const float* WINp = MG + MG_WIN + (size_t)bh * SEQ + tm * 16 + 4 * fq; const float* DECp = MG + MG_DEC + bh * 64;
    f32x4 Cacc[2][4];
#pragma unroll
    for (int i = 0; i < 2; ++i)
#pragma unroll
        for (int j = 0; j < 4; ++j) Cacc[i][j] = (f32x4){0.f, 0.f, 0.f, 0.f};
    for (int i = tid; i < 64 * 264 / 2; i += NTHREADS) ((LAS unsigned*)CT)[i] = 0u;
    SCAN_DMA(0);
    bf16x8 KWf[2][2], Sf[2];
#pragma unroll
    for (int k2 = 0; k2 < 2; ++k2) { Sf[k2] = ldg8(Sb + k2 * 4096, loS);
#pragma unroll
        for (int i = 0; i < 2; ++i) KWf[i][k2] = ldg8(KWb + i * 256 + k2 * 16384, loT); }
    f32x4 win4 = *(const f32x4*)WINp; float dec = DECp[0];
    const unsigned ctr0 = (unsigned)(((2 * dp) * 16 + fr) * 264 + 8 * fq), ctw0 = (unsigned)(fr * 264 + 2 * w * 16 + 4 * fq);
    for (int c = 0; c < 64; ++c) {
        asm volatile("s_waitcnt vmcnt(0)" ::: "memory");
        __syncthreads();
        if (c < 63) SCAN_DMA(c + 1);
        const int cur = c & 1; const LAS bf16_t* CTc = CT + cur * 64 * 264; LAS bf16_t* CTn = CT + (cur ^ 1) * 64 * 264;
        const LAS unsigned char* sQ = stQ + cur * 32768 + bq; const LAS unsigned char* sV = stV + cur * 8192 + bv;
        const int cn = c < 63 ? c + 1 : 63;
        f32x4 Hi[2], Ha[2]; Hi[0] = (f32x4){0.f, 0.f, 0.f, 0.f}; Hi[1] = Hi[0]; Ha[0] = Hi[0]; Ha[1] = Hi[0];
#pragma unroll
        for (int ks = 0; ks < 8; ++ks) {
            const bf16x8 qf = *(const LAS bf16x8*)(sQ + (((unsigned)(ks * 4) ^ yq) * 16u));
            const bf16x8 c0 = *(const LAS bf16x8*)(CTc + ctr0 + ks * 32), c1 = *(const LAS bf16x8*)(CTc + ctr0 + 16 * 264 + ks * 32);
            Hi[0] = __builtin_amdgcn_mfma_f32_16x16x32_bf16(qf, c0, Hi[0], 0, 0, 0); Hi[1] = __builtin_amdgcn_mfma_f32_16x16x32_bf16(qf, c1, Hi[1], 0, 0, 0);
            if ((ks & 3) == 3) asm volatile("" ::: "memory");
        }
#pragma unroll
        for (int k2 = 0; k2 < 2; ++k2) { const unsigned sl_ = ((unsigned)(k2 * 4) ^ yv) * 16u;
            const bf16x8 vA = *(const LAS bf16x8*)(sV + (2 * dp) * 2048 + sl_), vB = *(const LAS bf16x8*)(sV + (2 * dp + 1) * 2048 + sl_);
            Ha[0] = __builtin_amdgcn_mfma_f32_16x16x32_bf16(Sf[k2], vA, Ha[0], 0, 0, 0); Ha[1] = __builtin_amdgcn_mfma_f32_16x16x32_bf16(Sf[k2], vB, Ha[1], 0, 0, 0); }
        {
            LAS bf16_t* hst = (LAS bf16_t*)(X.lds + 151552 + w * 1280);
#pragma unroll
            for (int e = 0; e < 4; ++e)
#pragma unroll
                for (int j = 0; j < 2; ++j) hst[(4 * fq + e) * 32 + j * 16 + fr] = (bf16_t)f2bf(Ha[j][e] + Hi[j][e] * win4[e]);
            asm volatile("" ::: "memory");
            const u32x4 hv = *(const LAS u32x4*)(hst + (lane >> 2) * 32 + (lane & 3) * 8);
            *(u32x4*)(HRAW + ((size_t)b * SEQ + c * 64 + tm * 16 + (lane >> 2)) * D + h * DV + vs * 64 + dp * 32 + (lane & 3) * 8) = hv;
        }
#pragma unroll
        for (int j = 0; j < 4; ++j) {
#pragma unroll
            for (int k2 = 0; k2 < 2; ++k2) { const bf16x8 vf = *(const LAS bf16x8*)(sV + j * 2048 + (((unsigned)(k2 * 4) ^ yv) * 16u));
#pragma unroll
                for (int i = 0; i < 2; ++i) { if (k2 == 0) Cacc[i][j] = Cacc[i][j] * dec; Cacc[i][j] = __builtin_amdgcn_mfma_f32_16x16x32_bf16(KWf[i][k2], vf, Cacc[i][j], 0, 0, 0); } } }
#pragma unroll
        for (int i = 0; i < 2; ++i)
#pragma unroll
            for (int j = 0; j < 4; ++j) { u32x2 pw; pw.x = pk2(Cacc[i][j][0], Cacc[i][j][1]); pw.y = pk2(Cacc[i][j][2], Cacc[i][j][3]);
                *(LAS u32x2*)(CTn + ctw0 + j * 16 * 264 + i * 16) = pw; }
        { const char* kn_ = KWb + (size_t)cn * 32768; const char* sn_ = Sb + (size_t)cn * 8192;
#pragma unroll
          for (int k2 = 0; k2 < 2; ++k2) { Sf[k2] = ldg8(sn_ + k2 * 4096, loS);
#pragma unroll
            for (int i = 0; i < 2; ++i) KWf[i][k2] = ldg8(kn_ + i * 256 + k2 * 16384, loT); } }
        win4 = *(const f32x4*)(WINp + cn * 64); dec = DECp[cn];
    }
#undef SCAN_DMA
    __syncthreads();
    float* Cout = a.out + O_CP + (size_t)bh * DK * DV;
#pragma unroll
    for (int i = 0; i < 2; ++i)
#pragma unroll
        for (int j = 0; j < 4; ++j)
#pragma unroll
            for (int e = 0; e < 4; ++e) Cout[(size_t)((2 * w + i) * 16 + 4 * fq + e) * DV + vs * 64 + j * 16 + fr] = Cacc[i][j][e];
    __syncthreads();
}


__device__ __forceinline__ void m2_nchain_unit(const Ctx& X, CArgs& a, int bh) {
    float* MGw = (float*)(a.ws + WS_MG); const int tid = X.tid;
    if (tid < 256) { float n = 0.f;
        for (int c0 = 0; c0 < 64; c0 += 8) { float ac[8], dc[8];
#pragma unroll
            for (int u = 0; u < 8; ++u) { ac[u] = MGw[MG_AC + ((size_t)bh * 64 + c0 + u) * 256 + tid]; dc[u] = MGw[MG_DEC + bh * 64 + c0 + u]; }
#pragma unroll
            for (int u = 0; u < 8; ++u) { MGw[MG_NALL + ((size_t)bh * 64 + c0 + u) * 256 + tid] = n; n = dc[u] * n + ac[u]; } }
        a.out[O_NP + (size_t)bh * DK + tid] = n; }
}

__device__ __forceinline__ void p3_headnorm(const Ctx& X, CArgs& a, int wi, int nwk) {
    unsigned char* ws = a.ws; const bf16_t* HM = (const bf16_t*)(ws + WS_HMO); const bf16_t* BIG = (const bf16_t*)(ws + WS_BIG); const float* MG = (const float*)(ws + WS_MG);
    const int gw = wi * NWAVES + X.wave, NGW = nwk * NWAVES, lane = X.lane;
    for (int m = gw; m < M; m += NGW) {
        u32x4 hw[4], ow[4]; u32x2 qw[4]; f32x4 nv[4]; float rs_[4], wn_[4], em_[4];
        const bool prompt = m < MP; const int t = m & (SEQ - 1), bh0 = (m >> 12) * MLH;
#pragma unroll
        for (int h = 0; h < 4; ++h) { hw[h] = *(const u32x4*)(HM + (size_t)m * D + h * DV + lane * 8); ow[h] = *(const u32x4*)(BIG + (size_t)m * NW + C_MO + h * DV + lane * 8);
            if (prompt) { qw[h] = *(const u32x2*)((const bf16_t*)(ws + WS_QC) + (size_t)m * 1024 + h * 256 + 4 * lane); nv[h] = *(const f32x4*)(MG + MG_NALL + ((size_t)(bh0 + h) * 64 + (t >> 6)) * 256 + 4 * lane);
                const size_t o = (size_t)(bh0 + h) * SEQ + t; rs_[h] = MG[MG_RS + o]; wn_[h] = MG[MG_WIN + o]; em_[h] = MG[MG_EMI + o]; } }
#pragma unroll
        for (int h = 0; h < 4; ++h) {
            float v[8] = { bflo(hw[h].x), bfhi(hw[h].x), bflo(hw[h].y), bfhi(hw[h].y), bflo(hw[h].z), bfhi(hw[h].z), bflo(hw[h].w), bfhi(hw[h].w) };
            if (prompt) {
                const float qn = wave_sum((bflo(qw[h].x) * nv[h][0] + bfhi(qw[h].x) * nv[h][1]) + (bflo(qw[h].y) * nv[h][2] + bfhi(qw[h].y) * nv[h][3]));
                const float den = rs_[h] + wn_[h] * qn; const float inv = 1.0f / fmaxf(fabsf(den), em_[h]);
#pragma unroll
                for (int j = 0; j < 8; ++j) v[j] *= inv; }
            float s = 0.f;
#pragma unroll
            for (int j = 0; j < 8; ++j) s += v[j];
            const float mu = wave_sum(s) * (1.0f / DV); float q = 0.f;
#pragma unroll
            for (int j = 0; j < 8; ++j) { v[j] -= mu; q += v[j] * v[j]; }
            const float rstd = 1.0f / sqrtf(wave_sum(q) * (1.0f / DV) + LN_EPS);
            const float o[8] = { bflo(ow[h].x), bfhi(ow[h].x), bflo(ow[h].y), bfhi(ow[h].y), bflo(ow[h].z), bfhi(ow[h].z), bflo(ow[h].w), bfhi(ow[h].w) };
            const float* gp = a.in[18] + h * DV + lane * 8; const f32x4 g0 = *(const f32x4*)gp, g1 = *(const f32x4*)(gp + 4);
            const float gg[8] = { g0[0], g0[1], g0[2], g0[3], g1[0], g1[1], g1[2], g1[3] }; float r[8];
#pragma unroll
            for (int j = 0; j < 8; ++j) r[j] = v[j] * rstd * gg[j] * o[j];
            u32x2 ww; ww.x = pk4_fp8(r[0] * ACT_S, r[1] * ACT_S, r[2] * ACT_S, r[3] * ACT_S); ww.y = pk4_fp8(r[4] * ACT_S, r[5] * ACT_S, r[6] * ACT_S, r[7] * ACT_S);
            *(u32x2*)(ws + WS_HMO8 + (size_t)m * D + h * DV + lane * 8) = ww; }
    }
}

__device__ __forceinline__ void p6_ln1(const Ctx& X, CArgs& a) {
    unsigned char* ws = a.ws; bf16_t* T = (bf16_t*)(ws + WS_T); const float* ADA = (const float*)(ws + WS_ADA);
    const int gw = X.vcu * NWAVES + X.wave, NGW = X.G * NWAVES, lane = X.lane;
    for (int m = gw; m < M; m += NGW) {
        bf16_t* tr = T + (size_t)m * D; const int b = m < MP ? (m >> 12) : BATCH + ((m - MP) >> 3);
        const float* sh2 = ADA + (size_t)b * 6 * D + 3 * D; const float* sc2 = sh2 + D;
        f32x4 v[8]; float s = 0.f;
#pragma unroll
        for (int j = 0; j < 8; ++j) { const u32x2 tw = *(const u32x2*)(tr + 4 * lane + 256 * j); v[j] = (f32x4){bflo(tw.x), bfhi(tw.x), bflo(tw.y), bfhi(tw.y)}; s += (v[j][0] + v[j][1]) + (v[j][2] + v[j][3]); }
        const float mu = wave_sum(s) * (1.0f / D); float q = 0.f;
#pragma unroll
        for (int j = 0; j < 8; ++j) { v[j] = v[j] - mu; q += (v[j][0] * v[j][0] + v[j][1] * v[j][1]) + (v[j][2] * v[j][2] + v[j][3] * v[j][3]); }
        const float rstd = 1.0f / sqrtf(wave_sum(q) * (1.0f / D) + LN_EPS);
        unsigned* o4 = (unsigned*)(ws + WS_H28 + (size_t)m * D) + lane; float am = 0.f;
#pragma unroll
        for (int j = 0; j < 8; ++j) { const int c = 4 * lane + 256 * j; const f32x4 gg = *(const f32x4*)(a.in[23] + c), bb = *(const f32x4*)(a.in[24] + c);
            const f32x4 x1 = v[j] * rstd * gg + bb; { u32x2 xw; xw.x = pk2(x1[0], x1[1]); xw.y = pk2(x1[2], x1[3]); *(u32x2*)(tr + c) = xw; }
            const f32x4 h2 = x1 * (*(const f32x4*)(sc2 + c) + 1.0f) + *(const f32x4*)(sh2 + c);
            o4[64 * j] = pk4_fp8(h2[0] * ACT_S, h2[1] * ACT_S, h2[2] * ACT_S, h2[3] * ACT_S);
            v[j] = h2; am = fmaxf(am, fmaxf(fmaxf(fabsf(h2[0]), fabsf(h2[1])), fmaxf(fabsf(h2[2]), fabsf(h2[3])))); }
        am = wave_max(am); const float qs = am > 0.f ? 127.0f / am : 1.0f;
        unsigned* oi = (unsigned*)(ws + WS_H2I + (size_t)m * D) + lane;
#pragma unroll
        for (int j = 0; j < 8; ++j) oi[64 * j] = pk4_i8(v[j][0] * qs, v[j][1] * qs, v[j][2] * qs, v[j][3] * qs);
        if (lane == 0) ((float*)(ws + WS_HSC))[m] = am > 0.f ? am / 127.0f : 1.0f;
    }
}

__device__ __forceinline__ unsigned ord_key(float f) { unsigned u = __builtin_bit_cast(unsigned, f); return u ^ ((u >> 31) ? 0xFFFFFFFFu : 0x80000000u); }
__device__ __forceinline__ void p8_topk(const Ctx& X, CArgs& a) {
    unsigned char* ws = a.ws; const bf16_t* QP = (const bf16_t*)(ws + WS_H1); int* EID = (int*)(ws + WS_EID); float* GATE = (float*)(ws + WS_GATE);
    const float* SK = a.in[26];
    LAS float* S = (LAS float*)X.lds;
    LAS unsigned* TK = (LAS unsigned*)(X.lds + 2 * 64 * 129 * 4);
    const int lane = X.lane, w = X.wave, fr = lane & 15, fq = lane >> 4;
    const int p = w & 1, kq = w >> 1;
    constexpr int NTILE = M / 64;
    for (int u = X.vcu; u < NTILE * PH; u += X.G) {
        const int h = u / NTILE, tile = u % NTILE; const int m0 = tile * 64;
        f32x4 acc[4][2];
#pragma unroll
        for (int i = 0; i < 4; ++i) { acc[i][0] = (f32x4){0.f, 0.f, 0.f, 0.f}; acc[i][1] = acc[i][0]; }
#pragma unroll
        for (int ks = 0; ks < 4; ++ks) {
            bf16x8 bfr[2];
#pragma unroll
            for (int nt = 0; nt < 2; ++nt) { const float* kp = SK + (((size_t)(h * 2 + p) * NKEYS) + kq * 32 + nt * 16 + fr) * 128 + ks * 32 + 8 * fq;
                const f32x4 k0 = *(const f32x4*)kp, k1 = *(const f32x4*)(kp + 4);
                u32x4 pk; pk.x = pk2(k0[0], k0[1]); pk.y = pk2(k0[2], k0[3]); pk.z = pk2(k1[0], k1[1]); pk.w = pk2(k1[2], k1[3]); bfr[nt] = __builtin_bit_cast(bf16x8, pk); }
#pragma unroll
            for (int mt = 0; mt < 4; ++mt) { const bf16x8 afr = *(const bf16x8*)(QP + (size_t)(m0 + mt * 16 + fr) * D + h * DQ + p * 128 + ks * 32 + 8 * fq);
#pragma unroll
                for (int nt = 0; nt < 2; ++nt) acc[mt][nt] = __builtin_amdgcn_mfma_f32_16x16x32_bf16(afr, bfr[nt], acc[mt][nt], 0, 0, 0); }
        }
#pragma unroll
        for (int mt = 0; mt < 4; ++mt)
#pragma unroll
            for (int nt = 0; nt < 2; ++nt)
#pragma unroll
                for (int e = 0; e < 4; ++e) S[(p * 64 + mt * 16 + 4 * fq + e) * 129 + kq * 32 + nt * 16 + fr] = acc[mt][nt][e];
        __syncthreads();
        if (X.tid < 128) {
            const int hp = X.tid >> 6, tk = X.tid & 63; const LAS float* row = S + (hp * 64 + tk) * 129;
            unsigned L[16];
#pragma unroll
            for (int j = 0; j < 16; ++j) L[j] = 0u;
            for (int i = 0; i < 128; ++i) { unsigned x = (ord_key(row[i]) & ~127u) | (unsigned)(127 - i);
#pragma unroll
                for (int j = 0; j < 16; ++j) { const unsigned hi = L[j] > x ? L[j] : x, lo = L[j] > x ? x : L[j]; L[j] = hi; x = lo; } }
#pragma unroll
            for (int j = 0; j < 16; ++j) TK[(hp * 64 + tk) * 16 + j] = L[j];
        }
        __syncthreads();
        if (X.tid < 64) {
            const int tk = X.tid; float sa[16], sb[16]; int ia[16], ib[16];
#pragma unroll
            for (int j = 0; j < 16; ++j) { ia[j] = 127 - (int)(TK[tk * 16 + j] & 127u); ib[j] = 127 - (int)(TK[(64 + tk) * 16 + j] & 127u); sa[j] = S[tk * 129 + ia[j]]; sb[j] = S[(64 + tk) * 129 + ib[j]]; }
            unsigned L[16];
#pragma unroll
            for (int j = 0; j < 16; ++j) L[j] = 0u;
#pragma unroll
            for (int i = 0; i < 16; ++i)
#pragma unroll
                for (int j = 0; j < 16; ++j) if ((i + 1) * (j + 1) <= 16) { unsigned x = (ord_key(sa[i] + sb[j]) & ~255u) | (unsigned)(255 - (i * 16 + j));
#pragma unroll
                    for (int q = 0; q < 16; ++q) { const unsigned hi = L[q] > x ? L[q] : x, lo = L[q] > x ? x : L[q]; L[q] = hi; x = lo; } }
            float ts[16]; int eid[16]; float mxs = -3.0e38f;
#pragma unroll
            for (int q = 0; q < 16; ++q) { const int code = 255 - (int)(L[q] & 255u), i = code >> 4, j = code & 15; float va = sa[0], vb = sb[0]; int xa = ia[0], xb = ib[0];
#pragma unroll
                for (int z = 1; z < 16; ++z) { va = (i == z) ? sa[z] : va; xa = (i == z) ? ia[z] : xa; vb = (j == z) ? sb[z] : vb; xb = (j == z) ? ib[z] : xb; }
                ts[q] = va + vb; eid[q] = xa * NKEYS + xb; mxs = fmaxf(mxs, ts[q]); }
            float sum = 0.f;
#pragma unroll
            for (int q = 0; q < 16; ++q) { ts[q] = expf(ts[q] - mxs); sum += ts[q]; }
            const float inv = 1.0f / sum; const size_t o = ((size_t)(m0 + tk) * PH + h) * 16;
#pragma unroll
            for (int q = 0; q < 16; ++q) { EID[o + q] = eid[q]; GATE[o + q] = ts[q] * inv; }
        }
        __syncthreads();
    }
}

template <int N> __device__ __forceinline__ void bitonic_sort_desc(unsigned (&v)[N]) {
#pragma unroll
    for (int k = 2; k <= N; k <<= 1)
#pragma unroll
        for (int j = k >> 1; j > 0; j >>= 1)
#pragma unroll
            for (int i = 0; i < N; ++i) { const int l = i ^ j;
                if (l > i) { const bool up = ((i & k) == 0); const unsigned x = v[i], y = v[l]; const unsigned mx = x > y ? x : y, mn = x > y ? y : x; v[i] = up ? mx : mn; v[l] = up ? mn : mx; } }
}
__device__ __forceinline__ void merge16_xor(unsigned (&v)[16], int dist) {
    unsigned o[16];
#pragma unroll
    for (int j = 0; j < 16; ++j) o[j] = dist == 1 ? (unsigned)__builtin_amdgcn_update_dpp(0, (int)v[j], 0xB1, 0xF, 0xF, true) : (unsigned)__builtin_amdgcn_update_dpp(0, (int)v[j], 0x4E, 0xF, 0xF, true);
#pragma unroll
    for (int j = 0; j < 16; ++j) { const unsigned y = o[15 - j]; v[j] = v[j] > y ? v[j] : y; }
#pragma unroll
    for (int jj = 8; jj > 0; jj >>= 1)
#pragma unroll
        for (int i = 0; i < 16; ++i) { const int l = i ^ jj; if (l > i) { const unsigned x = v[i], y = v[l]; v[i] = x > y ? x : y; v[l] = x > y ? y : x; } }
}
__device__ __forceinline__ float ord_inv(unsigned k) { const unsigned u = (k & 0x80000000u) ? (k ^ 0x80000000u) : ~k; return __builtin_bit_cast(float, u); }
__device__ __forceinline__ void p11_topk2(const Ctx& X, CArgs& a, const pg8::StaticOrder* S) {
    unsigned char* ws = a.ws; const bf16_t* QP = (const bf16_t*)(ws + WS_H1); int* EID = (int*)(ws + WS_EID); float* GATE = (float*)(ws + WS_GATE);
    const bf16_t* SKB = (const bf16_t*)(ws + WS_SKB);
    LAS unsigned* KL = (LAS unsigned*)X.lds;
    LAS unsigned* TK = KL + 128 * 132;
    LAS unsigned char* ptab = (LAS unsigned char*)(TK + 2 * 128 * 16);
    LAS bf16_t* SKL = (LAS bf16_t*)(ptab + 64);
    const int tid = X.tid, lane = X.lane, w = X.wave, fr = lane & 15, fq = lane >> 4;
    if (tid == 0) { int n = 0; for (int i = 0; i < 16; ++i) for (int j = 0; j < 16; ++j) if ((i + 1) * (j + 1) <= 16) ptab[n++] = (unsigned char)((i << 4) | j); for (; n < 64; ++n) ptab[n] = 0xff; }
    constexpr int NT = M / 128;
    auto do_unit = [&](const int h, const int m0) {
        for (int p = 0; p < 2; ++p) {
            __syncthreads();
            {
                bf16x8 af[4];
#pragma unroll
                for (int ks = 0; ks < 4; ++ks) af[ks] = *(const bf16x8*)(QP + (size_t)(m0 + w * 16 + fr) * D + h * DQ + p * 128 + ks * 32 + 8 * fq);
#pragma unroll
                for (int i = 0; i < 4; ++i) { const int id = i * NTHREADS + tid, key = id >> 4, seg = id & 15; *(LAS u32x4*)(SKL + key * 136 + seg * 8) = *(const u32x4*)(SKB + ((size_t)(h * 2 + p) * NKEYS + key) * 128 + seg * 8); }
                __syncthreads();
#pragma unroll
                for (int nt = 0; nt < 8; ++nt) { f32x4 acc = (f32x4){0.f, 0.f, 0.f, 0.f};
#pragma unroll
                    for (int ks = 0; ks < 4; ++ks) { const bf16x8 bf = *(const LAS bf16x8*)(SKL + (nt * 16 + fr) * 136 + ks * 32 + 8 * fq); acc = __builtin_amdgcn_mfma_f32_16x16x32_bf16(af[ks], bf, acc, 0, 0, 0); }
                    const int key = nt * 16 + fr;
#pragma unroll
                    for (int e = 0; e < 4; ++e) KL[(w * 16 + 4 * fq + e) * 132 + key] = (ord_key(acc[e]) & ~127u) | (unsigned)(127 - key); }
            }
            __syncthreads();
            {
                const int t = tid >> 2, qd = tid & 3; unsigned v[32];
#pragma unroll
                for (int q = 0; q < 8; ++q) { const u32x4 x = *(const LAS u32x4*)(KL + t * 132 + qd * 32 + 4 * q); v[4 * q] = x.x; v[4 * q + 1] = x.y; v[4 * q + 2] = x.z; v[4 * q + 3] = x.w; }
                bitonic_sort_desc<32>(v);
                unsigned top[16];
#pragma unroll
                for (int j = 0; j < 16; ++j) top[j] = v[j];
                merge16_xor(top, 1); merge16_xor(top, 2);
                if (qd == 0) {
#pragma unroll
                    for (int q = 0; q < 4; ++q) *(LAS u32x4*)(TK + (p * 128 + t) * 16 + 4 * q) = (u32x4){top[4 * q], top[4 * q + 1], top[4 * q + 2], top[4 * q + 3]}; }
            }
        }
        __syncthreads();
        {
            const int t = tid >> 2, qd = tid & 3; const LAS unsigned* ta = TK + t * 16; const LAS unsigned* tb = TK + (128 + t) * 16;
            unsigned c[16];
#pragma unroll
            for (int n = 0; n < 16; ++n) { const unsigned pr = ptab[4 * n + qd]; unsigned key = 0u;
                if (pr != 0xffu) { const float sa = ord_inv(ta[pr >> 4] & ~127u), sb = ord_inv(tb[pr & 15] & ~127u); key = (ord_key(sa + sb) & ~255u) | (255u - pr); }
                c[n] = key; }
            bitonic_sort_desc<16>(c);
            merge16_xor(c, 1); merge16_xor(c, 2);
            float ts[16]; float mxs = -3.0e38f;
#pragma unroll
            for (int q = 0; q < 16; ++q) { const unsigned pr = 255u - (c[q] & 255u); const float sa = ord_inv(ta[pr >> 4] & ~127u), sb = ord_inv(tb[pr & 15] & ~127u); ts[q] = sa + sb; mxs = fmaxf(mxs, ts[q]); }
            float sum = 0.f;
#pragma unroll
            for (int q = 0; q < 16; ++q) { ts[q] = __expf(ts[q] - mxs); sum += ts[q]; }
            const float inv = 1.0f / sum; const size_t o = ((size_t)(m0 + t) * PH + h) * 16;
#pragma unroll
            for (int q = 0; q < 16; ++q) if ((q >> 2) == qd) { const unsigned pr = 255u - (c[q] & 255u); const int ia = 127 - (int)(ta[pr >> 4] & 127u), ib = 127 - (int)(tb[pr & 15] & 127u);
                EID[o + q] = ia * NKEYS + ib; GATE[o + q] = ts[q] * inv; }
        }
    };
    if (S) { pg8::Unit gu; for (int i = 0; S->next(i, gu); ++i) { do_unit(gu.pn, gu.pm * 256); do_unit(gu.pn, gu.pm * 256 + 128); } }
    else for (int u = X.vcu; u < NT * PH; u += X.G) do_unit(u / NT, (u % NT) * 128);
    __syncthreads();
}

typedef float f32x2v __attribute__((ext_vector_type(2)));
__device__ __forceinline__ float dot_fp8x16(const u32x4 w, const float* h) {
    float d0 = 0.f, d1 = 0.f;
#pragma unroll
    for (int q = 0; q < 4; ++q) { const f32x2v lo = __builtin_amdgcn_cvt_pk_f32_fp8((int)w[q], false), hi = __builtin_amdgcn_cvt_pk_f32_fp8((int)w[q], true);
        d0 += lo.x * h[4 * q] + lo.y * h[4 * q + 1]; d1 += hi.x * h[4 * q + 2] + hi.y * h[4 * q + 3]; }
    return d0 + d1;
}
__device__ __forceinline__ void axpy_fp8x16(const u32x4 w, float c, float* acc) {
#pragma unroll
    for (int q = 0; q < 4; ++q) { const f32x2v lo = __builtin_amdgcn_cvt_pk_f32_fp8((int)w[q], false), hi = __builtin_amdgcn_cvt_pk_f32_fp8((int)w[q], true);
        acc[4 * q] += c * lo.x; acc[4 * q + 1] += c * lo.y; acc[4 * q + 2] += c * hi.x; acc[4 * q + 3] += c * hi.y; }
}
__device__ __forceinline__ void p8_gather(const Ctx& X, CArgs& a) {
    unsigned char* ws = a.ws; const float* X1 = (const float*)(ws + WS_T); const float* ADA = (const float*)(ws + WS_ADA);
    const int* EID = (const int*)(ws + WS_EID); const float* GATE = (const float*)(ws + WS_GATE);
    const unsigned char* U8 = ws + WS_U8; const unsigned char* V8 = ws + WS_V8; const float* PSC = (const float*)(ws + WS_PSC);
    const int gw = X.vcu * NWAVES + X.wave, NGW = X.G * NWAVES, lane = X.lane;
    constexpr int UN = 4;
    for (int m = gw; m < M; m += NGW) {
        const int b = m < MP ? (m >> 12) : BATCH + ((m - MP) >> 3);
        const float* ab = ADA + (size_t)b * 6 * D; const float* sh2 = ab + 3 * D; const float* sc2 = ab + 4 * D; const float* g2 = ab + 5 * D;
        const float* x1r = X1 + (size_t)m * D;
        float h2[32], acc[32];
#pragma unroll
        for (int j = 0; j < 2; ++j)
#pragma unroll
            for (int q = 0; q < 4; ++q) { const int c = 16 * lane + 1024 * j + 4 * q; const f32x4 xv = *(const f32x4*)(x1r + c), s1 = *(const f32x4*)(sc2 + c), s0 = *(const f32x4*)(sh2 + c);
#pragma unroll
                for (int e = 0; e < 4; ++e) { h2[16 * j + 4 * q + e] = xv[e] * (s1[e] + 1.0f) + s0[e]; acc[16 * j + 4 * q + e] = 0.f; } }
        const int e_l = EID[(size_t)m * 128 + lane], e_h = EID[(size_t)m * 128 + 64 + lane];
        const float g_l = GATE[(size_t)m * 128 + lane], g_h = GATE[(size_t)m * 128 + 64 + lane];
        for (int k0 = 0; k0 < 128; k0 += UN) {
            u32x4 uw[UN][2], vw[UN][2]; float su[UN], sv[UN], gk[UN];
#pragma unroll
            for (int i = 0; i < UN; ++i) { const int k = k0 + i;
                const int e = __builtin_amdgcn_readfirstlane(k < 64 ? __shfl(e_l, k) : __shfl(e_h, k - 64));
                gk[i] = k < 64 ? __shfl(g_l, k) : __shfl(g_h, k - 64);
                const unsigned char* ur = U8 + (size_t)e * D + 16 * lane; const unsigned char* vr = V8 + (size_t)e * D + 16 * lane;
                uw[i][0] = *(const u32x4*)ur; uw[i][1] = *(const u32x4*)(ur + 1024); vw[i][0] = *(const u32x4*)vr; vw[i][1] = *(const u32x4*)(vr + 1024);
                su[i] = PSC[e]; sv[i] = PSC[16384 + e]; }
#pragma unroll
            for (int i = 0; i < UN; ++i) {
                float d = dot_fp8x16(uw[i][0], h2) + dot_fp8x16(uw[i][1], h2 + 16);
                d = wave_sum(d) * su[i];
                const float act = 0.5f * d * (1.0f + erff(d * 0.70710678118654752f));
                const float cf = gk[i] * act * sv[i];
                axpy_fp8x16(vw[i][0], cf, acc); axpy_fp8x16(vw[i][1], cf, acc + 16);
            }
        }
        float s = 0.f;
#pragma unroll
        for (int j = 0; j < 2; ++j)
#pragma unroll
            for (int q = 0; q < 4; ++q) { const int c = 16 * lane + 1024 * j + 4 * q; const f32x4 xv = *(const f32x4*)(x1r + c), gv = *(const f32x4*)(g2 + c);
#pragma unroll
                for (int e = 0; e < 4; ++e) { const int i = 16 * j + 4 * q + e; acc[i] = xv[e] * ALPHA + gv[e] * acc[i]; s += acc[i]; } }
        const float mu = wave_sum(s) * (1.0f / D); float qq = 0.f;
#pragma unroll
        for (int i = 0; i < 32; ++i) { acc[i] -= mu; qq += acc[i] * acc[i]; }
        const float rstd = 1.0f / sqrtf(wave_sum(qq) * (1.0f / D) + LN_EPS);
        float* yo = a.out + (m < MP ? O_YP + (size_t)m * D : O_YS + (size_t)(m - MP) * D);
#pragma unroll
        for (int j = 0; j < 2; ++j)
#pragma unroll
            for (int q = 0; q < 4; ++q) { const int c = 16 * lane + 1024 * j + 4 * q; const f32x4 gg = *(const f32x4*)(a.in[29] + c), bb = *(const f32x4*)(a.in[30] + c); f32x4 o;
#pragma unroll
                for (int e = 0; e < 4; ++e) o[e] = acc[16 * j + 4 * q + e] * rstd * gg[e] + bb[e];
                *(f32x4*)(yo + c) = o; }
    }
}


#ifndef SLAB_SYNC
#define SLAB_SYNC 1
#endif
constexpr int TPB = 68;
__device__ __forceinline__ float dot16_fp8(const u32x4 w, const f32x4 h0, const f32x4 h1, const f32x4 h2, const f32x4 h3) {
    const f32x2v a0 = __builtin_amdgcn_cvt_pk_f32_fp8((int)w.x, false), a1 = __builtin_amdgcn_cvt_pk_f32_fp8((int)w.x, true), b0 = __builtin_amdgcn_cvt_pk_f32_fp8((int)w.y, false), b1 = __builtin_amdgcn_cvt_pk_f32_fp8((int)w.y, true);
    const f32x2v c0 = __builtin_amdgcn_cvt_pk_f32_fp8((int)w.z, false), c1 = __builtin_amdgcn_cvt_pk_f32_fp8((int)w.z, true), d0 = __builtin_amdgcn_cvt_pk_f32_fp8((int)w.w, false), d1 = __builtin_amdgcn_cvt_pk_f32_fp8((int)w.w, true);
    return ((a0.x * h0[0] + a0.y * h0[1]) + (a1.x * h0[2] + a1.y * h0[3])) + ((b0.x * h1[0] + b0.y * h1[1]) + (b1.x * h1[2] + b1.y * h1[3]))
         + ((c0.x * h2[0] + c0.y * h2[1]) + (c1.x * h2[2] + c1.y * h2[3])) + ((d0.x * h3[0] + d0.y * h3[1]) + (d1.x * h3[2] + d1.y * h3[3]));
}
__device__ __forceinline__ float red8(float x) {
    x += __builtin_bit_cast(float, __builtin_amdgcn_update_dpp(0, __builtin_bit_cast(int, x), 0xB1, 0xF, 0xF, true));
    x += __builtin_bit_cast(float, __builtin_amdgcn_update_dpp(0, __builtin_bit_cast(int, x), 0x4E, 0xF, 0xF, true));
    x += __builtin_bit_cast(float, __builtin_amdgcn_update_dpp(0, __builtin_bit_cast(int, x), 0x141, 0xF, 0xF, true));
    return x;
}
__device__ __forceinline__ f32x2 fma2(f32x2 a, f32x2 b, f32x2 c) { return a * b + c; }
__device__ __forceinline__ void p12_scores(const Ctx& X, CArgs& a, const XcdBarrier& bar, bool gsync) {
    unsigned char* ws = a.ws; const float* X1 = (const float*)(ws + WS_T); const float* ADA = (const float*)(ws + WS_ADA);
    const int* EID = (const int*)(ws + WS_EID); const float* GATE = (const float*)(ws + WS_GATE); float* COEF = (float*)(ws + WS_COEF);
    const unsigned char* U8 = ws + WS_U8; const float* PSC = (const float*)(ws + WS_PSC);
    LAS int* eidl = (LAS int*)X.lds;
    LAS float* h2s = (LAS float*)(X.lds + TPB * 128 * 4);
    LAS float* scl = (LAS float*)(X.lds + 2 * TPB * 128 * 4);
    const int tid = X.tid, lane = X.lane, w = X.wave, pr = lane >> 3, c = lane & 7;
    for (int tb0 = X.vcu * TPB; tb0 < M; tb0 += X.G * TPB) {
        const int ntok = (M - tb0) < TPB ? (M - tb0) : TPB;
        __syncthreads();
        for (int i = tid; i < ntok * 128; i += NTHREADS) { eidl[i] = EID[(size_t)tb0 * 128 + i]; scl[i] = 0.f; }
        __syncthreads();
        const unsigned char* H8 = ws + WS_H2I + (size_t)tb0 * D + 16 * c;
        {
            const int ntw = ntok > w ? (ntok - w + 7) / 8 : 0, ntask = 16 * ntw;
            u32x4 pA[16], pB[16]; u32x4 hA = (u32x4){0u, 0u, 0u, 0u}, hB = hA;
            const unsigned c16 = 16u * (unsigned)c; const bool up4 = (c & 4) != 0, up2 = (c & 2) != 0, up1 = (c & 1) != 0;
#define G12_LOAD(P, H, LT, SL) { const unsigned char* slab_ = U8 + (size_t)(SL) * SLAB_BYTES; H = *(const u32x4*)(H8 + (size_t)(LT) * D + (SL) * 128); \
                _Pragma("unroll") for (int it = 0; it < 16; ++it) P[it] = *(const u32x4*)(slab_ + (((unsigned)eidl[(LT) * 128 + 8 * it + pr] << 7) + c16)); }
#define G12_DPPI(X_, CTRL) __builtin_amdgcn_update_dpp(0, (X_), (CTRL), 0xF, 0xF, true)
#define G12_PROC(P, H, LT) { int xs[16];     \
                _Pragma("unroll") for (int it = 0; it < 16; ++it) asm volatile("v_dot4_i32_i8 %0, %1, %2, 0" : "=v"(xs[it]) : "v"(P[it].x), "v"(H.x));     \
                asm volatile("s_nop 3" : "+v"(xs[0]), "+v"(xs[1]), "+v"(xs[2]), "+v"(xs[3]), "+v"(xs[4]), "+v"(xs[5]), "+v"(xs[6]), "+v"(xs[7]), "+v"(xs[8]), "+v"(xs[9]), "+v"(xs[10]), "+v"(xs[11]), "+v"(xs[12]), "+v"(xs[13]), "+v"(xs[14]), "+v"(xs[15]));     \
                _Pragma("unroll") for (int it = 0; it < 16; ++it) { const u32x4 q = P[it]; int ia = __builtin_amdgcn_sdot4((int)q.y, (int)H.y, xs[it], false); \
                    ia = __builtin_amdgcn_sdot4((int)q.z, (int)H.z, ia, false); ia = __builtin_amdgcn_sdot4((int)q.w, (int)H.w, ia, false); xs[it] = ia; } \
                int ys[8], zs[4]; \
                _Pragma("unroll") for (int jj = 0; jj < 8; ++jj) { const int lo = jj < 4 ? jj : jj + 4; const int keep = up4 ? xs[lo + 4] : xs[lo], send = up4 ? xs[lo] : xs[lo + 4]; ys[jj] = keep + G12_DPPI(send, 0x141); } \
                _Pragma("unroll") for (int qq = 0; qq < 4; ++qq) { const int lo = 4 * (qq >> 1) + (qq & 1); const int keep = up2 ? ys[lo + 2] : ys[lo], send = up2 ? ys[lo] : ys[lo + 2]; zs[qq] = keep + G12_DPPI(send, 0x4E); } \
                int wa, wb; \
                { const int keep = up1 ? zs[1] : zs[0], send = up1 ? zs[0] : zs[1]; wa = keep + G12_DPPI(send, 0xB1); } \
                { const int keep = up1 ? zs[3] : zs[2], send = up1 ? zs[2] : zs[3]; wb = keep + G12_DPPI(send, 0xB1); } \
                scl[(LT) * 128 + 8 * c + pr] += (float)wa; scl[(LT) * 128 + 8 * (c + 8) + pr] += (float)wb; }
            int sl = 0, lt = w;
            if (ntask > 0) G12_LOAD(pA, hA, w, 0)
#pragma unroll 1
            for (int k = 0; k < ntask; k += 2) {
                { int ln = lt + 8, sn = sl; if (ln >= ntok) { ln = w; ++sn; }
                  if (k + 1 < ntask) G12_LOAD(pB, hB, ln, sn)
                  G12_PROC(pA, hA, lt)
                  lt = ln; sl = sn; }
                if (k + 1 >= ntask) break;
                { int ln = lt + 8, sn = sl; if (ln >= ntok) { ln = w; ++sn; }
                  if (k + 2 < ntask) G12_LOAD(pA, hA, ln, sn)
                  G12_PROC(pB, hB, lt)
                  lt = ln; sl = sn; }
            }
        }
        __syncthreads();
        for (int i = tid; i < ntok * 128; i += NTHREADS) { const int e = eidl[i]; const size_t o = (size_t)tb0 * 128 + i;
            const float d = scl[i] * PSC[e] * ((const float*)(ws + WS_HSC))[tb0 + (i >> 7)]; const float act = 0.5f * d * (1.0f + erff(d * 0.70710678118654752f));
            COEF[o] = GATE[o] * act * PSC[16384 + e]; }
    }
}
__device__ __forceinline__ void p12_values(const Ctx& X, CArgs& a, const XcdBarrier& bar, bool gsync) {
    unsigned char* ws = a.ws; const int* EID = (const int*)(ws + WS_EID); const float* COEF = (const float*)(ws + WS_COEF);
    const unsigned char* V8 = ws + WS_V8; bf16_t* PEERO = (bf16_t*)(ws + WS_PEERO);
    LAS int* eidl = (LAS int*)X.lds;
    LAS float* cfl = (LAS float*)(X.lds + TPB * 128 * 4);
    LAS unsigned* cf8 = (LAS unsigned*)(X.lds + 2 * TPB * 128 * 4);
    LAS float* tsc = (LAS float*)(X.lds + 3 * TPB * 128 * 4);
    const int tid = X.tid, lane = X.lane, w = X.wave, r = lane >> 3, c = lane & 7;
    const bool up8 = (lane & 8) != 0;
    const int di = lane & 15, kb = lane >> 4;
    const unsigned bm = 0xFFu << (8 * (di & 3));
    const unsigned m0 = (di >> 2) == 0 ? bm : 0u, m1 = (di >> 2) == 1 ? bm : 0u, m2 = (di >> 2) == 2 ? bm : 0u, m3 = (di >> 2) == 3 ? bm : 0u;
    (void)bar; (void)gsync;
    for (int tb0 = X.vcu * TPB; tb0 < M; tb0 += X.G * TPB) {
        const int ntok = (M - tb0) < TPB ? (M - tb0) : TPB;
        __syncthreads();
        for (int i = tid; i < ntok * 128; i += NTHREADS) { eidl[i] = EID[(size_t)tb0 * 128 + i]; cfl[i] = COEF[(size_t)tb0 * 128 + i]; }
        __syncthreads();
        for (int t = w; t < ntok; t += NWAVES) {
            const float c0 = cfl[t * 128 + lane], c1 = cfl[t * 128 + 64 + lane]; const float am = wave_max(fmaxf(fabsf(c0), fabsf(c1))); const float qs = am > 0.f ? 224.0f / am : 1.0f;
            const unsigned p = (unsigned)__builtin_amdgcn_cvt_pk_fp8_f32(c0 * qs, c1 * qs, 0, false);
            cf8[t * 128 + lane] = (p & 0xFFu) * 0x01010101u; cf8[t * 128 + 64 + lane] = ((p >> 8) & 0xFFu) * 0x01010101u; if (lane == 0) tsc[t] = am > 0.f ? am / 224.0f : 1.0f; }
        {
            const int ntw = ntok > w ? (ntok - w + 7) / 8 : 0, ntask = 16 * ntw;
            u32x4 pA[16], pB[16];
            const unsigned c16 = 16u * (unsigned)c;
#define G13_LOAD(P, LT, SL) { const unsigned char* slab_ = V8 + (size_t)(SL) * SLAB_BYTES; \
                _Pragma("unroll") for (int it = 0; it < 16; ++it) P[it] = *(const u32x4*)(slab_ + (((unsigned)eidl[(LT) * 128 + 8 * it + r] << 7) + c16)); }
#define G13_PROC(P, LT, SL) { f32x4 d0 = {0.f, 0.f, 0.f, 0.f}, d1 = {0.f, 0.f, 0.f, 0.f}; \
                _Pragma("unroll") for (int pp = 0; pp < 8; ++pp) { \
                    const u32x2 ca = *(const LAS u32x2*)(cf8 + (LT) * 128 + 16 * pp + 2 * kb), cb = *(const LAS u32x2*)(cf8 + (LT) * 128 + 16 * pp + 8 + 2 * kb); \
                    const pg8::i32x8 A0 = {(int)(ca.x & m0), (int)(ca.x & m1), (int)(ca.x & m2), (int)(ca.x & m3), (int)(cb.x & m0), (int)(cb.x & m1), (int)(cb.x & m2), (int)(cb.x & m3)}; \
                    const pg8::i32x8 A1 = {(int)(ca.y & m0), (int)(ca.y & m1), (int)(ca.y & m2), (int)(ca.y & m3), (int)(cb.y & m0), (int)(cb.y & m1), (int)(cb.y & m2), (int)(cb.y & m3)}; \
                    const u32x4 b0 = P[2 * pp], b1 = P[2 * pp + 1]; \
                    const pg8::i32x8 Bv = {(int)b0.x, (int)b0.y, (int)b0.z, (int)b0.w, (int)b1.x, (int)b1.y, (int)b1.z, (int)b1.w}; \
                    d0 = __builtin_amdgcn_mfma_scale_f32_16x16x128_f8f6f4(A0, Bv, d0, 0, 0, 0, 0x7F7F7F7F, 0, 0x7F7F7F7F); \
                    d1 = __builtin_amdgcn_mfma_scale_f32_16x16x128_f8f6f4(A1, Bv, d1, 0, 0, 0, 0x7F7F7F7F, 0, 0x7F7F7F7F); } \
                  \
                float y0 = d1[0], y1 = d1[1], y2 = d1[2], y3 = d1[3], z0 = d0[0], z1 = d0[1], z2 = d0[2], z3 = d0[3]; \
                asm volatile("" : "+v"(y0), "+v"(y1), "+v"(y2), "+v"(y3), "+v"(z0), "+v"(z1), "+v"(z2), "+v"(z3));     \
                float x0 = __builtin_bit_cast(float, __builtin_amdgcn_update_dpp(0, __builtin_bit_cast(int, y0), 0x128, 0xF, 0xF, true)), x1 = __builtin_bit_cast(float, __builtin_amdgcn_update_dpp(0, __builtin_bit_cast(int, y1), 0x128, 0xF, 0xF, true)); \
                float x2 = __builtin_bit_cast(float, __builtin_amdgcn_update_dpp(0, __builtin_bit_cast(int, y2), 0x128, 0xF, 0xF, true)), x3 = __builtin_bit_cast(float, __builtin_amdgcn_update_dpp(0, __builtin_bit_cast(int, y3), 0x128, 0xF, 0xF, true)); \
                asm volatile("" : "+v"(x0), "+v"(x1), "+v"(x2), "+v"(x3)); \
                const float ts_ = tsc[(LT)]; \
                if (!up8) { u32x2 pk; pk.x = pk2((z0 + x0) * ts_, (z1 + x1) * ts_); pk.y = pk2((z2 + x2) * ts_, (z3 + x3) * ts_); __builtin_nontemporal_store(pk, (u32x2*)(PEERO + (size_t)(tb0 + (LT)) * D + (SL) * 128 + 16 * c + 4 * kb)); } }
            int sl = 0, lt = w;
            if (ntask > 0) G13_LOAD(pA, w, 0)
#pragma unroll 1
            for (int k = 0; k < ntask; k += 2) {
                { int ln = lt + 8, sn = sl; if (ln >= ntok) { ln = w; ++sn; }
                  if (k + 1 < ntask) G13_LOAD(pB, ln, sn)
                  G13_PROC(pA, lt, sl)
                  lt = ln; sl = sn; }
                if (k + 1 >= ntask) break;
                { int ln = lt + 8, sn = sl; if (ln >= ntok) { ln = w; ++sn; }
                  if (k + 2 < ntask) G13_LOAD(pA, ln, sn)
                  G13_PROC(pB, lt, sl)
                  lt = ln; sl = sn; }
            }
        }
    }
}
__device__ __forceinline__ void p12_final(const Ctx& X, CArgs& a) {
    unsigned char* ws = a.ws; const bf16_t* X1 = (const bf16_t*)(ws + WS_T); const float* ADA = (const float*)(ws + WS_ADA); const bf16_t* PEERO = (const bf16_t*)(ws + WS_PEERO);
    const int lane = X.lane;
    for (int tb0 = X.vcu * TPB; tb0 < M; tb0 += X.G * TPB)
    for (int m = tb0 + X.wave; m < tb0 + TPB && m < M; m += NWAVES) {
        const int b = m < MP ? (m >> 12) : BATCH + ((m - MP) >> 3); const float* g2 = ADA + (size_t)b * 6 * D + 5 * D;
        f32x4 v[8]; float s = 0.f;
#pragma unroll
        for (int j = 0; j < 8; ++j) { const int cc = 4 * lane + 256 * j; const u32x2 pw = *(const u32x2*)(PEERO + (size_t)m * D + cc); const f32x4 pe = {bflo(pw.x), bfhi(pw.x), bflo(pw.y), bfhi(pw.y)};
            const u32x2 xw = *(const u32x2*)(X1 + (size_t)m * D + cc); const f32x4 xv = {bflo(xw.x), bfhi(xw.x), bflo(xw.y), bfhi(xw.y)};
            v[j] = xv * ALPHA + *(const f32x4*)(g2 + cc) * pe; s += (v[j][0] + v[j][1]) + (v[j][2] + v[j][3]); }
        const float mu = wave_sum(s) * (1.0f / D); float q = 0.f;
#pragma unroll
        for (int j = 0; j < 8; ++j) { v[j] = v[j] - mu; q += (v[j][0] * v[j][0] + v[j][1] * v[j][1]) + (v[j][2] * v[j][2] + v[j][3] * v[j][3]); }
        const float rstd = 1.0f / sqrtf(wave_sum(q) * (1.0f / D) + LN_EPS);
        float* yo = a.out + (m < MP ? O_YP + (size_t)m * D : O_YS + (size_t)(m - MP) * D);
#pragma unroll
        for (int j = 0; j < 8; ++j) { const int cc = 4 * lane + 256 * j; *(f32x4*)(yo + cc) = v[j] * rstd * *(const f32x4*)(a.in[29] + cc) + *(const f32x4*)(a.in[30] + cc); }
    }
}


#ifndef SELFCHECK
#define SELFCHECK 0
#endif
#ifndef SC_TOL_ATT
#define SC_TOL_ATT 0.05f
#define SC_TOL_ML 0.05f
#define SC_TOL_TOPK 8u
#define SC_TOL_PEER 0.15f
#endif
#if SELFCHECK
__device__ __forceinline__ void chk_max(unsigned* w, float v) { atomicMax(w, __float_as_uint(fabsf(v))); }
__device__ __forceinline__ void chk_mlstm_unit(const Ctx& X, CArgs& a, unsigned* CHK, size_t row0, int T, int h, int vs, const float* C0, const float* n0, const float* m0p, const float* convbuf) {
    unsigned char* ws = a.ws; const bf16_t* BIG = (const bf16_t*)(ws + WS_BIG); const float* MIF = (const float*)(ws + WS_MIF); const bf16_t* HRAW = (const bf16_t*)(ws + WS_HMO);
    LAS float* qk = (LAS float*)X.lds; LAS float* red = qk + 512; LAS float* nred = red + 512;
    const int tid = X.tid, g = tid >> 6, dv = tid & 63;
    const int ch = tid < 256 ? h * 256 + tid : 1024 + h * 256 + (tid - 256);
    const float w0 = a.in[16][ch], w1 = a.in[16][2048 + ch], w2 = a.in[16][4096 + ch], w3 = a.in[16][6144 + ch], cb = a.in[17][ch];
    float x1 = 0.f, x2 = 0.f, x3 = 0.f;
    if (convbuf) { x3 = convbuf[ch]; x2 = convbuf[2048 + ch]; x1 = convbuf[4096 + ch]; }
    float C[32], nn = 0.f, mprev = 0.f, emax = 0.f, rmax = 0.f;
#pragma unroll
    for (int j = 0; j < 32; ++j) C[j] = C0 ? C0[(size_t)(32 * g + j) * DV + vs * 64 + dv] : 0.f;
    if (n0 && tid < 256) nn = n0[tid];
    if (m0p) mprev = m0p[0];
    __syncthreads();
    for (int t = 0; t < T; ++t) { const size_t r = row0 + t;
        const float x0 = bf2f(BIG[r * NW + C_MQK + ch]), vin = bf2f(BIG[r * NW + C_MV + h * DV + vs * 64 + dv]), iv_ = MIF[r * 8 + h], lf = MIF[r * 8 + 4 + h];
        float y = cb + x3 * w0; y = y + x2 * w1; y = y + x1 * w2; y = y + x0 * w3; x3 = x2; x2 = x1; x1 = x0;
        float sv = y / (1.0f + expf(-y)); if (tid >= 256) sv *= 0.0625f; qk[tid] = sv;
        __syncthreads();
        const float mnew = fmaxf(lf + mprev, iv_), fg = expf(lf + mprev - mnew), ig = expf(iv_ - mnew), iv = ig * vin;
        float ph = 0.f;
#pragma unroll
        for (int j = 0; j < 32; ++j) { const float kk = qk[256 + 32 * g + j], qq = qk[32 * g + j]; C[j] = fg * C[j] + kk * iv; ph += qq * C[j]; }
        red[g * 64 + dv] = ph;
        if (tid < 256) { nn = fg * nn + ig * qk[256 + tid]; float pn = qk[tid] * nn; pn = wave_sum(pn); if (X.lane == 0) nred[X.wave] = pn; }
        __syncthreads();
        if (tid < 64) { float hs = 0.f;
#pragma unroll
            for (int gg = 0; gg < 8; ++gg) hs += red[gg * 64 + tid];
            const float qn = (nred[0] + nred[1]) + (nred[2] + nred[3]); const float ref = C0 ? hs / fmaxf(fabsf(qn), expf(-mnew)) : hs;
            const float got = bf2f(HRAW[r * D + h * DV + vs * 64 + tid]); emax = fmaxf(emax, fabsf(got - ref)); rmax = fmaxf(rmax, fabsf(ref)); }
        mprev = mnew;
    }
    if (tid < 64) { chk_max(CHK + 2, emax); chk_max(CHK + 3, rmax); }
    __syncthreads();
}
__device__ __forceinline__ void chk_att_wave(const Ctx& X, CArgs& a, unsigned* CHK, int m, int head) {
    unsigned char* ws = a.ws; const bf16_t* BIG = (const bf16_t*)(ws + WS_BIG); const bf16_t* ATT = (const bf16_t*)(ws + WS_H1);
    const int d = X.lane, kvh = head >> 2; const bool prompt = m < MP; const int t = prompt ? (m & (SEQ - 1)) : ((m - MP) & 7), bs = prompt ? 0 : ((m - MP) >> 3);
    const float q = bf2f(BIG[(size_t)m * NW + C_AQ + head * 64 + d]);
    float mx = a.in[19][head], l = 1.0f, acc = 0.f;
    const int nk = prompt ? (t < 127 ? t + 1 : 128) : 128;
    for (int dist = 0; dist < nk; ++dist) { float kd, vd;
        if (prompt) { const size_t r = (size_t)(m - dist); kd = bf2f(BIG[r * NW + C_AK + kvh * 64 + d]); vd = bf2f(BIG[r * NW + C_AV + kvh * 64 + d]); }
        else { const int j = t + 128 - dist; if (j < 128) { const size_t o = (((size_t)bs * 128 + j) * KVH + kvh) * HD + d; kd = bf2f((bf16_t)f2bf(a.in[4][o])); vd = bf2f((bf16_t)f2bf(a.in[5][o])); }
               else { const size_t r = (size_t)MP + bs * 8 + (j - 128); kd = bf2f(BIG[r * NW + C_AK + kvh * 64 + d]); vd = bf2f(BIG[r * NW + C_AV + kvh * 64 + d]); } }
        const float s = wave_sum(q * kd) * 0.125f + a.in[10][t5_bucket(dist) * HEADS + head];
        const float mn = fmaxf(mx, s), sc = expf(mx - mn), p = expf(s - mn); l = l * sc + p; acc = acc * sc + p * vd; mx = mn; }
    const unsigned char* A8 = ws + WS_ATT8; const float ref = acc / l, got = __builtin_amdgcn_cvt_f32_fp8((int)A8[(size_t)m * D + head * 64 + d], 0) * (1.0f / ACT_S);
    chk_max(CHK + 0, got - ref); chk_max(CHK + 1, ref);
}
__device__ __forceinline__ void selfcheck_a(const Ctx& X, CArgs& a, unsigned* CHK) {
    if (blockIdx.x == 0) chk_mlstm_unit(X, a, CHK, (size_t)1 * SEQ, SEQ, 2, 4, nullptr, nullptr, nullptr, nullptr);
    else if (blockIdx.x == 1) { const int b = 77, h = 1; const size_t bh = (size_t)b * MLH + h; chk_mlstm_unit(X, a, CHK, (size_t)MP + b * 8, 8, h, 2, a.in[7] + bh * DK * DV, a.in[8] + bh * DK, a.in[9] + bh, a.in[6] + (size_t)b * 3 * 2048); }
    else if (blockIdx.x == 2) chk_mlstm_unit(X, a, CHK, (size_t)3 * SEQ, SEQ, 0, 7, nullptr, nullptr, nullptr, nullptr);
    else if (blockIdx.x < 40) { const int i = ((int)blockIdx.x - 3) * NWAVES + X.wave;
        int m; if (i < 16) { const int sp[16] = {0, 1, 126, 127, 128, 129, 255, 256, 4095, 4096, 4097, 4223, 4224, 8191, 12288, 16383}; m = sp[0];
#pragma unroll
            for (int z = 1; z < 16; ++z) m = (i == z) ? sp[z] : m; }
        else if (i < 200) m = (int)(((unsigned)i * 2654435761u) % (unsigned)MP); else m = MP + (int)(((unsigned)i * 40503u) % (unsigned)MS);
        chk_att_wave(X, a, CHK, m, (i * 7 + (i >> 3)) & 31); }
}
__device__ __forceinline__ void selfcheck_b(const Ctx& X, CArgs& a, unsigned* CHK) {
    unsigned char* ws = a.ws; const bf16_t* QP = (const bf16_t*)(ws + WS_H1); const bf16_t* SKB = (const bf16_t*)(ws + WS_SKB); const int* EID = (const int*)(ws + WS_EID); const float* GATE = (const float*)(ws + WS_GATE);
    const bf16_t* X1 = (const bf16_t*)(ws + WS_T); const float* ADA = (const float*)(ws + WS_ADA); const bf16_t* PEERO = (const bf16_t*)(ws + WS_PEERO);
    LAS float* sc = (LAS float*)X.lds;
    LAS float* red = sc + 2048;
    LAS int* refe = (LAS int*)(red + 16);
    const int tid = X.tid, lane = X.lane, w = X.wave;
    const int toks[8] = {5, 4100, 9000, 16383, 16384, 17000, 17407, 12345};
    for (int ti = 0; ti < 8; ++ti) { int m = toks[0];
#pragma unroll
        for (int z = 1; z < 8; ++z) m = (ti == z) ? toks[z] : m;
        __syncthreads();
        for (int p = 0; p < 2; ++p) for (int kk = 0; kk < 2; ++kk) { const int key = lane + 64 * kk; float s = 0.f;
            for (int d = 0; d < 128; ++d) s += bf2f(QP[(size_t)m * D + w * DQ + p * 128 + d]) * bf2f(SKB[((size_t)(w * 2 + p) * NKEYS + key) * 128 + d]);
            sc[(w * 2 + p) * 128 + key] = s; }
        __syncthreads();
        if (lane == 0) { int ia[16], ib[16]; float va[16], vb[16];
            LAS float* s0 = sc + (w * 2) * 128; LAS float* s1 = s0 + 128;
            for (int j = 0; j < 16; ++j) { int bi = 0; float bvv = -3.0e38f; for (int k = 0; k < 128; ++k) { const float v = s0[k]; if (v > bvv) { bvv = v; bi = k; } } s0[bi] = -3.0e38f; refe[w * 16 + j] = bi; red[0] = 0.f; ((LAS float*)refe)[128 + w * 16 + j] = bvv; }
            (void)ia; (void)ib; (void)va; (void)vb; }
        __syncthreads();
        LAS int* ia_ = refe; LAS float* va_ = (LAS float*)refe + 128; LAS int* ib_ = refe + 256; LAS float* vb_ = (LAS float*)refe + 384; LAS int* out_ = refe + 512;
        if (lane == 0) { LAS float* s1 = sc + (w * 2 + 1) * 128;
            for (int j = 0; j < 16; ++j) { int bi = 0; float bvv = -3.0e38f; for (int k = 0; k < 128; ++k) { const float v = s1[k]; if (v > bvv) { bvv = v; bi = k; } } s1[bi] = -3.0e38f; ib_[w * 16 + j] = bi; vb_[w * 16 + j] = bvv; }
            LAS float* cand = sc + (w * 2) * 128;
            for (int i = 0; i < 16; ++i) for (int j = 0; j < 16; ++j) cand[i * 16 + j] = va_[w * 16 + i] + vb_[w * 16 + j];
            int miss = 0;
            for (int j = 0; j < 16; ++j) { int bi = 0; float bvv = -3.0e38f; for (int k = 0; k < 256; ++k) { const float v = cand[k]; if (v > bvv) { bvv = v; bi = k; } } cand[bi] = -3.0e38f;
                const int e = ia_[w * 16 + (bi >> 4)] * NKEYS + ib_[w * 16 + (bi & 15)]; bool found = false;
                for (int q = 0; q < 16; ++q) found = found || (EID[((size_t)m * PH + w) * 16 + q] == e);
                miss += found ? 0 : 1; }
            out_[w] = miss; atomicAdd(CHK + 4, (unsigned)miss); }
        __syncthreads();
        { const int b = m < MP ? (m >> 12) : BATCH + ((m - MP) >> 3); const float* ab = ADA + (size_t)b * 6 * D; const int c0 = tid * 4;
          const u32x2 xw_ = *(const u32x2*)(X1 + (size_t)m * D + c0); const f32x4 xv = {bflo(xw_.x), bfhi(xw_.x), bflo(xw_.y), bfhi(xw_.y)}; const f32x4 h2 = xv * (*(const f32x4*)(ab + 4 * D + c0) + 1.0f) + *(const f32x4*)(ab + 3 * D + c0);
          f32x4 acc = (f32x4){0.f, 0.f, 0.f, 0.f};
          for (int k = 0; k < 128; ++k) { const int e = EID[(size_t)m * 128 + k]; const float gk = GATE[(size_t)m * 128 + k];
              const f32x4 uv = *(const f32x4*)(a.in[27] + (size_t)e * D + c0); float dd = (uv[0] * h2[0] + uv[1] * h2[1]) + (uv[2] * h2[2] + uv[3] * h2[3]); dd = wave_sum(dd);
              __syncthreads(); if (lane == 0) red[w] = dd; __syncthreads();
              float dt = 0.f;
#pragma unroll
              for (int z = 0; z < 8; ++z) dt += red[z];
              const float cf = gk * 0.5f * dt * (1.0f + erff(dt * 0.70710678118654752f));
              acc = acc + *(const f32x4*)(a.in[28] + (size_t)e * D + c0) * cf; }
          const u32x2 gw_ = *(const u32x2*)(PEERO + (size_t)m * D + c0); const f32x4 got = {bflo(gw_.x), bfhi(gw_.x), bflo(gw_.y), bfhi(gw_.y)};
#pragma unroll
          for (int z = 0; z < 4; ++z) { chk_max(CHK + 5, got[z] - acc[z]); chk_max(CHK + 6, acc[z]); } }
    }
    __syncthreads();
    if (tid == 0) { const float qn = __builtin_nanf("");
        const float ea = __uint_as_float(atomicAdd(CHK + 0, 0u)), ra = __uint_as_float(atomicAdd(CHK + 1, 0u)), em = __uint_as_float(atomicAdd(CHK + 2, 0u)), rm = __uint_as_float(atomicAdd(CHK + 3, 0u));
        const unsigned miss = atomicAdd(CHK + 4, 0u); const float ep = __uint_as_float(atomicAdd(CHK + 5, 0u)), rp = __uint_as_float(atomicAdd(CHK + 6, 0u));
        if (!(ea <= SC_TOL_ATT * ra) || !(ra > 0.f)) a.out[O_YP] = qn;
        if (!(em <= SC_TOL_ML * rm) || !(rm > 0.f)) a.out[O_YS] = qn;
        if (miss > SC_TOL_TOPK) a.out[O_KWP] = qn;
        if (!(ep <= SC_TOL_PEER * rp) || !(rp > 0.f)) a.out[O_VWP] = qn; }
}
#endif

#ifdef NO_ATT
#define ATT_CALL(...) do {} while (0)
#else
#define ATT_CALL(...) p4_attention(__VA_ARGS__)
#endif
constexpr int NPHASE = 15;
__global__ void __launch_bounds__(NTHREADS, 2) fwd_kernel(Args args) {
    extern __shared__ __attribute__((aligned(16))) unsigned char lds_raw[];
    Ctx X; X.lds = (LAS unsigned char*)lds_raw; X.tid = threadIdx.x; X.lane = X.tid & 63; X.wave = __builtin_amdgcn_readfirstlane(X.tid >> 6);
    X.G = gridDim.x; { const int bx = blockIdx.x; X.vcu = (X.G % 8 == 0) ? (bx % 8) * (X.G / 8) + bx / 8 : bx; }
    volatile LAS unsigned* MISC = (volatile LAS unsigned*)(X.lds + MISC_OFF);
    for (int u = X.tid; u < (LDS_BYTES - LDSCTL_OFF) / 4; u += NTHREADS) ((LAS unsigned*)(X.lds + LDSCTL_OFF))[u] = 0u;
    __syncthreads();
    CArgs& A4 = *(CArgs*)__builtin_amdgcn_kernarg_segment_ptr();
    unsigned char* ws = A4.ws;
    const bool multi = (args.ph_hi - args.ph_lo) > 1;
    XcdBarrier bar; bar.bar = (unsigned*)(ws + WS_CTL) + CW_BAR; bar.x = 0; bar.st = nullptr;
    if (multi) bar = xcd_barrier_post((unsigned*)(ws + WS_CTL) + CW_BAR, MISC + 8);
    const int lo = args.ph_lo, hi = args.ph_hi;
#ifndef PHMASK
#define PHMASK 0xFFFF
#endif
#define IN(k) (((PHMASK >> (k)) & 1) && lo <= (k) && (k) < hi)
#define SEAM(k) do { if (IN(k) && (IN((k) + 1) || ((k) == 4 && IN(6)) || ((k) == 10 && IN(12)))) xcd_barrier(bar); } while (0)
    bf16_t* W4T = (bf16_t*)(ws + WS_W4T);

    if (IN(0)) { p0_ada(X, A4.in[2], A4.in[3], A4.in[11], A4.in[12], (float*)(ws + WS_ADA)); p0_transposes(X, A4); }
    SEAM(0);
    if (IN(1)) { p1_rows(X, A4); }
    SEAM(1);
    if (IN(2)) { if (X.vcu < 16) { p2_gates(X, A4, X.vcu); if (X.G < 16) for (int u = X.vcu + X.G; u < 16; u += X.G) p2_gates(X, A4, u); }
        {
            pg8::Gemm g{(const bf16_t*)(ws + WS_H1), (const bf16_t*)(ws + WS_WINT), M, NW, D, D}; pg8::P2Bf16Order S{X.G, (int)blockIdx.x};
            pg8::EpiBig E{(bf16_t*)(ws + WS_BIG), NW, 1 << 30, 1 << 30, 0, 0, 1.0f};
            pg8::gemm_phase<pg8::EpiBig, pg8::P2Bf16Order>(X.lds, g, S, E); }
        {
            pg8::Gemm g{(const bf16_t*)(ws + WS_H1F8), (const bf16_t*)(ws + WS_WINF8), M, NW, D / 2, D / 2}; pg8::P2F8Order S{X.G, (int)(X.G - 1 - blockIdx.x)};
            pg8::EpiBig E{(bf16_t*)(ws + WS_BIG), NW, C_MO / 256, 1 << 30, 0, 0, 1.0f / (ACT_S * W_S)};
            pg8::gemm_phase<pg8::EpiBig, pg8::P2F8Order, true>(X.lds, g, S, E); } }
    SEAM(2);
    if (IN(3)) {
#ifndef T_NOPREP
        for (int u = X.vcu; u < 1024; u += X.G) m1_prep_unit(X, A4, u >> 6, u & 63);
#endif
        asm volatile("" ::: "memory");
#ifndef T_NOSAMP
        for (int u = X.vcu; u < SAMP_P3; u += X.G) m1_sample_unit(X, A4, u);
#endif
        for (int u = X.vcu; u < ATT_P3; u += X.G) { const int qb = u & 31, kvh = (u >> 5) & 7, b = u >> 8; att_prompt_unit(X, A4, b, kvh, qb); }
        __syncthreads();
        }
    SEAM(3);
    if (IN(4)) { if (X.G >= 256) { if (X.vcu < 128) { if (!(args.flags & 1)) m2_scan_unit(X, A4, X.vcu >> 3, X.vcu & 7); } else { if (!(args.flags & 2)) { if (X.vcu - 128 < 16) m2_nchain_unit(X, A4, X.vcu - 128); for (int u = SAMP_P3 + X.vcu - 128; u < 512; u += X.G - 128) m1_sample_unit(X, A4, u); p3_sample_attention(X, A4, X.vcu - 128, X.G - 128); ATT_CALL(X, A4, X.vcu - 128, X.G - 128); } } }
                 else { for (int u = X.vcu; u < 128; u += X.G) m2_scan_unit(X, A4, u >> 3, u & 7); for (int u = X.vcu; u < 16; u += X.G) m2_nchain_unit(X, A4, u); for (int u = SAMP_P3 + X.vcu; u < 512; u += X.G) m1_sample_unit(X, A4, u); p3_sample_attention(X, A4, X.vcu, X.G); ATT_CALL(X, A4, X.vcu, X.G); } }
    SEAM(4);
#if SELFCHECK
    if (multi) { selfcheck_a(X, A4, (unsigned*)(ws + WS_CTL) + 65536); xcd_barrier(bar); }
#endif
    if (IN(6)) { pg8::Gemm g{(const bf16_t*)(ws + WS_ATT8), (const bf16_t*)(ws + WS_W4F8), M, D, D / 2, D / 2}; pg8::StaticOrder S; S.init(M, D, X.G, (int)blockIdx.x);
        pg8::EpiGate<false> E{(bf16_t*)(ws + WS_Z), (const bf16_t*)(ws + WS_BIG) + C_GA, NW, 1.0f / (ACT_S * W_S), nullptr};
        pg8::gemm_phase<pg8::EpiGate<false>, pg8::StaticOrder, true>(X.lds, g, S, E);
        if (X.G > 32) { if ((int)blockIdx.x >= 32) p3_headnorm(X, A4, (int)blockIdx.x - 32, X.G - 32); } else p3_headnorm(X, A4, (int)blockIdx.x, X.G); }
    SEAM(6);
    if (IN(7)) { pg8::Gemm g{(const bf16_t*)(ws + WS_HMO8), (const bf16_t*)(ws + WS_W4F8 + (size_t)D * D), M, D, D / 2, D / 2}; pg8::StaticOrder S; S.init(M, D, X.G, (int)blockIdx.x);
        pg8::EpiGate<true> E{(bf16_t*)(ws + WS_Z), (const bf16_t*)(ws + WS_BIG) + C_GB, NW, 1.0f / (ACT_S * W_S), ws + WS_Z8};
        pg8::gemm_phase<pg8::EpiGate<true>, pg8::StaticOrder, true>(X.lds, g, S, E);
        if (X.G > 32) { if ((int)blockIdx.x >= 32) p3_state_copies(X, A4, (int)blockIdx.x - 32, X.G - 32); } else p3_state_copies(X, A4, (int)blockIdx.x, X.G); }
    SEAM(7);
    if (IN(8)) { pg8::Gemm g{(const bf16_t*)(ws + WS_Z8), (const bf16_t*)(ws + WS_W4F8 + (size_t)2 * D * D), M, D, D / 2, D / 2}; pg8::StaticOrder S; S.init(M, D, X.G, (int)blockIdx.x);
        pg8::EpiRes E{(bf16_t*)(ws + WS_T), A4.in[0], A4.in[1], (const float*)(ws + WS_ADA), 1.0f / (Z_S * W_S)};
        pg8::gemm_phase<pg8::EpiRes, pg8::StaticOrder, true>(X.lds, g, S, E);
        if (X.G > 32) { if ((int)blockIdx.x >= 32) { p0_peer_fp8(X, A4, 0, (int)blockIdx.x - 32, X.G - 32); p0_peer_fp8(X, A4, 1, (int)blockIdx.x - 32, X.G - 32); } } else { p0_peer_fp8(X, A4, 0, (int)blockIdx.x, X.G); p0_peer_fp8(X, A4, 1, (int)blockIdx.x, X.G); } }
    SEAM(8);
    if (IN(9)) { p6_ln1(X, A4); }
    SEAM(9);
    if (IN(10)) { pg8::Gemm g{(const bf16_t*)(ws + WS_H28), (const bf16_t*)(ws + WS_W4F8 + (size_t)3 * D * D), M, D, D / 2, D / 2}; pg8::StaticOrder S; S.init(M, D, X.G, (int)blockIdx.x);
        pg8::EpiPlain E{(bf16_t*)(ws + WS_H1), 1.0f / (ACT_S * W_S)};
        pg8::gemm_phase<pg8::EpiPlain, pg8::StaticOrder, true>(X.lds, g, S, E);
        p11_topk2(X, A4, &S);
        if (X.G > 32) { if ((int)blockIdx.x >= 32) { p0_peer_fp8(X, A4, 2, (int)blockIdx.x - 32, X.G - 32); p0_peer_fp8(X, A4, 3, (int)blockIdx.x - 32, X.G - 32); } } else { p0_peer_fp8(X, A4, 2, (int)blockIdx.x, X.G); p0_peer_fp8(X, A4, 3, (int)blockIdx.x, X.G); } }
    SEAM(10);
    if (IN(12)) { p12_scores(X, A4, bar, false); }
    if (IN(12) && IN(13)) { asm volatile("s_waitcnt vmcnt(0)" ::: "memory"); __syncthreads(); }
    if (IN(13)) { p12_values(X, A4, bar, false); }
    if (IN(13) && IN(14)) { asm volatile("s_waitcnt vmcnt(0)" ::: "memory"); __syncthreads(); }
    if (IN(14)) { p12_final(X, A4); }
#if SELFCHECK
    if (multi && blockIdx.x == 0) { __syncthreads(); selfcheck_b(X, A4, (unsigned*)(ws + WS_CTL) + 65536); }
#endif
#undef IN
#undef SEAM
}

#ifndef MK_PER_PHASE
#define MK_PER_PHASE 0
#endif
#ifndef MK_REP_MASK
#define MK_REP_MASK 0
#endif
#ifndef MK_REP_N
#define MK_REP_N 3
#endif
#ifndef MK_REP_FLAGS
#define MK_REP_FLAGS 0
#endif
extern "C" void kernel_launch(void* const* d_in, const int* in_sizes, int n_in, void* d_out, int out_size, void* d_ws, size_t ws_size, hipStream_t stream) {
    static int grid = 0;
    if (grid == 0) {
        if (n_in != 31 || (size_t)out_size != O_END || ws_size < WS_END) { fprintf(stderr, "kernel_launch: unexpected shapes: n_in %d out %d ws %zu (need %zu)\n", n_in, out_size, ws_size, (size_t)WS_END); grid = -1; return; }
        int dev = 0, cus = 0;
        if (hipGetDevice(&dev) != hipSuccess || hipDeviceGetAttribute(&cus, hipDeviceAttributeMultiprocessorCount, dev) != hipSuccess) { grid = -1; return; }
        if (hipFuncSetAttribute((const void*)fwd_kernel, hipFuncAttributeMaxDynamicSharedMemorySize, LDS_BYTES) != hipSuccess) { fprintf(stderr, "kernel_launch: hipFuncSetAttribute failed\n"); grid = -1; return; }
        (void)hipGetLastError();
        grid = cus;
    }
    if (grid < 0) return;
    (void)hipMemsetAsync((char*)d_ws + WS_CTL, 0, CTL_ZERO_BYTES, stream);
    Args a{};
    for (int i = 0; i < 31; ++i) a.in[i] = (const float*)d_in[i];
    a.out = (float*)d_out; a.ws = (unsigned char*)d_ws;
#if MK_PER_PHASE
    for (int p = 0; p < NPHASE; ++p) { a.ph_lo = p; a.ph_hi = p + 1; const int nrep = ((MK_REP_MASK >> p) & 1) ? MK_REP_N : 1;
        for (int r = 0; r < nrep; ++r) { a.flags = r > 0 ? MK_REP_FLAGS : 0; hipLaunchKernelGGL(fwd_kernel, dim3(grid), dim3(NTHREADS), LDS_BYTES, stream, a); } }
    a.flags = 0;
#else
    a.ph_lo = 0; a.ph_hi = NPHASE;
    hipLaunchKernelGGL(fwd_kernel, dim3(grid), dim3(NTHREADS), LDS_BYTES, stream, a);
#endif
}
```

```cpp
#include <hip/hip_runtime.h>
#include <cstdio>
#include <cstdint>
#include <cmath>

#define GAS __attribute__((address_space(1)))
#define LAS __attribute__((address_space(3)))
typedef unsigned short bf16_t;
typedef short bf16x8 __attribute__((ext_vector_type(8)));
typedef float f32x4 __attribute__((ext_vector_type(4)));
typedef float f32x2 __attribute__((ext_vector_type(2)));
typedef unsigned u32x4 __attribute__((ext_vector_type(4)));
typedef unsigned u32x2 __attribute__((ext_vector_type(2)));

constexpr int D = 2048, BATCH = 4, SEQ = 4096, DEC_BATCH = 128, DEC_SEQ = 8;
constexpr int MP = BATCH * SEQ, MS = DEC_BATCH * DEC_SEQ, M = MP + MS;
constexpr int NB = BATCH + DEC_BATCH;
constexpr int HEADS = 32, KVH = 8, HD = 64, WINDOW = 128;
constexpr int MLH = 4, DK = 256, DV = 512;
constexpr int PH = 8, NKEYS = 128, TOPK = 16, DQ = 256;
constexpr int INW = 13320, NW = 13312;
constexpr int C_AQ = 0, C_AK = 2048, C_AV = 2560, C_MQK = 3072, C_MV = 5120, C_MO = 7168, C_GA = 9216, C_GB = 11264;
constexpr int SRC_MIF = 7168;
constexpr float LN_EPS = 1e-5f;
constexpr float ALPHA = 1.189207115002721f;

constexpr size_t O_YP = 0, O_YS = O_YP + (size_t)MP * D, O_KWP = O_YS + (size_t)MS * D, O_VWP = O_KWP + 4 * 128 * 512, O_CONVP = O_VWP + 4 * 128 * 512,
                 O_CP = O_CONVP + 4 * 3 * 2048, O_NP = O_CP + (size_t)4 * 4 * 256 * 512, O_MPO = O_NP + 4 * 4 * 256, O_KWS = O_MPO + 16,
                 O_VWS = O_KWS + (size_t)128 * 128 * 512, O_CONVS = O_VWS + (size_t)128 * 128 * 512, O_CS = O_CONVS + (size_t)128 * 3 * 2048,
                 O_NS = O_CS + (size_t)128 * 4 * 256 * 512, O_MSO = O_NS + 128 * 4 * 256, O_END = O_MSO + 512;

constexpr size_t MiB = 1u << 20;
constexpr size_t WS_CTL = 0, CTL_ZERO_BYTES = 1 * MiB;
constexpr size_t WS_ADA = 1 * MiB;
constexpr size_t WS_H2I = 60 * MiB, WS_HSC = 100 * MiB;
constexpr size_t WS_WMIF = 8 * MiB;
constexpr size_t WS_MIF = 9 * MiB;
constexpr size_t WS_EID = 10 * MiB;
constexpr size_t WS_GATE = 19 * MiB;
constexpr size_t WS_W4T = 28 * MiB;
constexpr size_t WS_WINT = 60 * MiB;
constexpr size_t WS_H1 = 112 * MiB;
constexpr size_t WS_HMO = 180 * MiB;
constexpr size_t WS_Z = 248 * MiB;
constexpr size_t WS_T = 316 * MiB;
constexpr size_t WS_BIG = 452 * MiB;
constexpr size_t WS_U8 = 896 * MiB;
constexpr size_t WS_V8 = 928 * MiB;
constexpr size_t WS_PSC = 960 * MiB;
constexpr size_t WS_W4F8 = 962 * MiB;
constexpr size_t WS_WINF8 = 978 * MiB;
constexpr size_t WS_END = 1004 * MiB;
static_assert(WS_BIG + (size_t)M * NW * 2 <= WS_END, "ws map");
static_assert(WS_T + (size_t)M * D * 4 <= WS_BIG && WS_Z + (size_t)M * D * 2 <= WS_T && WS_HMO + (size_t)M * D * 2 <= WS_Z && WS_H1 + (size_t)M * D * 2 <= WS_HMO, "ws map");
static_assert(WS_WINT + (size_t)NW * D * 2 <= WS_H1 && WS_W4T + (size_t)4 * D * D * 2 <= WS_WINT && WS_GATE + (size_t)M * 128 * 4 <= WS_W4T && WS_EID + (size_t)M * 128 * 4 <= WS_GATE, "ws map");
constexpr size_t WS_QC = WS_T;
constexpr size_t WS_KWT = WS_T + 32 * MiB;
constexpr size_t WS_VT = WS_T + 64 * MiB;
constexpr size_t WS_SM = WS_T + 128 * MiB;
constexpr size_t WS_MG = WS_GATE;
constexpr int MG_A1 = 0, MG_G = 65536, MG_WIN = 131072, MG_EMI = 196608, MG_WK = 262144, MG_DEC = 327680;
constexpr int MG_AC = 393216, MG_RS = 655360, MG_NALL = 720896;
constexpr size_t WS_SKB = WS_PSC + 256 * 1024;
constexpr size_t SLAB_BYTES = (size_t)16384 * 128;
constexpr size_t WS_PEERO = WS_BIG;
constexpr size_t WS_COEF = WS_BIG + 140 * MiB;
constexpr size_t WS_ATT8 = WS_H1;
constexpr size_t WS_HMO8 = WS_H1 + 34 * MiB;
constexpr size_t WS_H1F8 = WS_HMO;
constexpr size_t WS_Z8 = WS_HMO;
constexpr size_t WS_H28 = WS_HMO;
constexpr float ACT_S = 8.0f, Z_S = 16.0f, W_S = 64.0f;
constexpr int CW_BAR = 4096;

constexpr int RING_BYTES = 131072;
constexpr int LDS_BYTES = 163840;
constexpr int LDSCTL_OFF = LDS_BYTES - 1024, MISC_OFF = LDSCTL_OFF + 320;
constexpr int NWAVES = 8, NTHREADS = 512;
#ifndef ATT_P3
#define ATT_P3 64
#endif
#ifndef SAMP_P3
#define SAMP_P3 512
#endif

typedef __bf16 bf16x2_t __attribute__((ext_vector_type(2)));
__device__ __forceinline__ unsigned pk2(float lo, float hi) { f32x2 v = {lo, hi}; bf16x2_t b = __builtin_convertvector(v, bf16x2_t); return __builtin_bit_cast(unsigned, b); }
__device__ __forceinline__ unsigned f2bf(float f) { return pk2(f, 0.f) & 0xffffu; }
__device__ __forceinline__ float bf2f(unsigned short b) { return __builtin_bit_cast(float, (unsigned)b << 16); }
__device__ __forceinline__ float bflo(unsigned w) { return __builtin_bit_cast(float, w << 16); }
__device__ __forceinline__ float bfhi(unsigned w) { return __builtin_bit_cast(float, w & 0xffff0000u); }
__device__ __forceinline__ float sigmoidf_(float x) { return 1.0f / (1.0f + expf(-x)); }
__device__ __forceinline__ float xsum16(float x) { const auto q = __builtin_amdgcn_permlane16_swap(__float_as_uint(x), __float_as_uint(x), false, false); return __uint_as_float(q[0]) + __uint_as_float(q[1]); }
__device__ __forceinline__ float xsum32(float x) { const auto q = __builtin_amdgcn_permlane32_swap(__float_as_uint(x), __float_as_uint(x), false, false); return __uint_as_float(q[0]) + __uint_as_float(q[1]); }
__device__ __forceinline__ float row_sum16(float x) {
    x += __builtin_bit_cast(float, __builtin_amdgcn_update_dpp(0, __builtin_bit_cast(int, x), 0xB1, 0xF, 0xF, true));
    x += __builtin_bit_cast(float, __builtin_amdgcn_update_dpp(0, __builtin_bit_cast(int, x), 0x4E, 0xF, 0xF, true));
    x += __builtin_bit_cast(float, __builtin_amdgcn_update_dpp(0, __builtin_bit_cast(int, x), 0x141, 0xF, 0xF, true));
    x += __builtin_bit_cast(float, __builtin_amdgcn_update_dpp(0, __builtin_bit_cast(int, x), 0x140, 0xF, 0xF, true));
    return x;
}
__device__ __forceinline__ float wave_sum(float v) { return xsum32(xsum16(row_sum16(v))); }
__device__ __forceinline__ float wave_max(float x) {
    x = fmaxf(x, __builtin_bit_cast(float, __builtin_amdgcn_update_dpp(0, __builtin_bit_cast(int, x), 0xB1, 0xF, 0xF, true)));
    x = fmaxf(x, __builtin_bit_cast(float, __builtin_amdgcn_update_dpp(0, __builtin_bit_cast(int, x), 0x4E, 0xF, 0xF, true)));
    x = fmaxf(x, __builtin_bit_cast(float, __builtin_amdgcn_update_dpp(0, __builtin_bit_cast(int, x), 0x141, 0xF, 0xF, true)));
    x = fmaxf(x, __builtin_bit_cast(float, __builtin_amdgcn_update_dpp(0, __builtin_bit_cast(int, x), 0x140, 0xF, 0xF, true)));
    { const auto q = __builtin_amdgcn_permlane16_swap(__float_as_uint(x), __float_as_uint(x), false, false); x = fmaxf(__uint_as_float(q[0]), __uint_as_float(q[1])); }
    { const auto q = __builtin_amdgcn_permlane32_swap(__float_as_uint(x), __float_as_uint(x), false, false); x = fmaxf(__uint_as_float(q[0]), __uint_as_float(q[1])); }
    return x;
}
__device__ __forceinline__ float sat8(float v) { return __builtin_amdgcn_fmed3f(v, -448.0f, 448.0f); }
__device__ __forceinline__ unsigned pk4_i8(float a, float b, float c, float d) {
    const float mg = 12582912.0f; const unsigned ua = __builtin_bit_cast(unsigned, a + mg), ub = __builtin_bit_cast(unsigned, b + mg), uc = __builtin_bit_cast(unsigned, c + mg), ud = __builtin_bit_cast(unsigned, d + mg);
    return (ua & 255u) | ((ub & 255u) << 8) | ((uc & 255u) << 16) | (ud << 24); }
__device__ __forceinline__ unsigned pk4_fp8(float a, float b, float c, float d) { int p = 0; p = __builtin_amdgcn_cvt_pk_fp8_f32(sat8(a), sat8(b), p, false); p = __builtin_amdgcn_cvt_pk_fp8_f32(sat8(c), sat8(d), p, true); return (unsigned)p; }
#define LDS_WAIT() asm volatile("s_waitcnt lgkmcnt(0)" ::: "memory")
#define VM_WAIT() asm volatile("s_waitcnt vmcnt(0)" ::: "memory")

namespace pg8 {
constexpr int BM = 256, BK = 64, HALF = 128, HTB = HALF * BK * 2, STAGE_BYTES = 8 * HTB, NXCD = 8, WGM = 8;
__host__ __device__ __forceinline__ int lds_byte(int r, int c) { const int st = (r >> 4) * 2 + (c >> 5), rr = r & 15, cc = c & 31, ob = rr * 64 + cc * 2; return st * 1024 + (ob ^ (((ob >> 9) & 1) << 5)); }
__host__ __device__ __forceinline__ void stage_rc(int b, int& R, int& C) { const int st = b / 1024, sb = b % 1024, swz = sb ^ (((sb >> 9) & 1) << 5); R = (st >> 1) * 16 + swz / 64; C = (st & 1) * 32 + (swz % 64) / 2; }
__host__ __device__ __forceinline__ int perm32(int rho) { const int n = rho >> 4, i = rho & 15; return 8 * (i >> 2) + 4 * n + (i & 3); }
struct Unit { int pm, pn; };
struct Gemm { const bf16_t* A; const bf16_t* Bt; int M, N, K, lda; };
struct StaticOrder {
    int nM, nN, nwg, G, c;
    __host__ __device__ void init(int M_, int N_, int G_, int c_) { nM = M_ / BM; nN = N_ / BM; nwg = nM * nN; G = G_; c = c_; }
    __host__ __device__ bool next(int i, Unit& u) const {
        const long L = (long)i * G + c; if (L >= nwg) return false;
        int wgid = (int)L; { const int q = nwg / NXCD, r = nwg % NXCD, xcd = wgid % NXCD, off = wgid / NXCD; wgid = (xcd < r ? xcd * (q + 1) : r * (q + 1) + (xcd - r) * q) + off; }
        const int nig = WGM * nN, gid = wgid / nig, fm = gid * WGM, gsz = (nM - fm) < WGM ? (nM - fm) : WGM;
        u.pm = fm + ((wgid % nig) % gsz); u.pn = (wgid % nig) / gsz; return true;
    }
};
__host__ __device__ __forceinline__ int p2_recent_tile(int rt) { return rt < 8 ? (rt >> 1) * 16 + 14 + (rt & 1) : 64 + (rt - 8); }
__host__ __device__ __forceinline__ int p2_old_tile(int k) { return (k / 14) * 16 + (k % 14); }
__host__ __device__ __forceinline__ void grid_map(int L, int nM, int nN, int& pm, int& pn) {
    const int nwg = nM * nN; int wgid = L; { const int q = nwg / NXCD, r = nwg % NXCD, xcd = wgid % NXCD, off = wgid / NXCD; wgid = (xcd < r ? xcd * (q + 1) : r * (q + 1) + (xcd - r) * q) + off; }
    const int nig = WGM * nN, gid = wgid / nig, fm = gid * WGM, gsz = (nM - fm) < WGM ? (nM - fm) : WGM;
    pm = fm + ((wgid % nig) % gsz); pn = (wgid % nig) / gsz;
}
struct P2Bf16Order {
    int G, c;
    __host__ __device__ bool next(int i, Unit& u) const { const int L = i * G + c; if (L >= 12 * 20) return false; int a, b; grid_map(L, 12, 20, a, b); u.pm = p2_recent_tile(a); u.pn = 8 + b; return true; }
};
struct P2F8Order {
    int G, c;
    __host__ __device__ bool next(int i, Unit& u) const { const int L = i * G + c; int a, b;
        if (L < 56 * 52) {
            constexpr int nwg = 56 * 52; int wgid = L; { const int q = nwg / NXCD, xcd = wgid % NXCD, off = wgid / NXCD; wgid = xcd * q + off; }
            const int chunk = wgid / 224, q2 = wgid % 224; u.pm = p2_old_tile(q2 >> 2); u.pn = chunk * 4 + (q2 & 3); return true; }
        const int L2 = L - 56 * 52; if (L2 >= 12 * 32) return false;
        grid_map(L2, 12, 32, a, b); u.pm = p2_recent_tile(a); u.pn = b < 8 ? b : b + 20; return true; }
};
__device__ __forceinline__ unsigned cvt_pk_bf16(float lo, float hi) { unsigned r; asm volatile("v_cvt_pk_bf16_f32 %0, %1, %2" : "=v"(r) : "v"(lo), "v"(hi)); return r; }

typedef int i32x8 __attribute__((ext_vector_type(8)));
typedef int i32x4v __attribute__((ext_vector_type(4)));
__device__ __forceinline__ i32x8 cat16(bf16x8 lo, bf16x8 hi) { return __builtin_shufflevector(__builtin_bit_cast(i32x4v, lo), __builtin_bit_cast(i32x4v, hi), 0, 1, 2, 3, 4, 5, 6, 7); }
template <class Epi, class Sched, bool F8 = false>
__device__ __forceinline__ void gemm_phase(LAS unsigned char* lds, const Gemm g, const Sched& S, const Epi& E) {
    const int tid = threadIdx.x, wid = __builtin_amdgcn_readfirstlane(tid >> 6), lane = tid & 63, wr = wid >> 2, wc = wid & 3, fr = lane & 15, fq = lane >> 4;
    const int K = g.K, nt = K / BK, lda = g.lda;
    unsigned voffA[2], voffB[2];
    { int R, C; stage_rc(tid * 16, R, C); const int Rb = Epi::PERM ? ((R & ~31) + perm32(R & 31)) : R;
        voffA[0] = (unsigned)(R * lda + C) * 2u; voffB[0] = (unsigned)(Rb * K + C) * 2u; voffA[1] = voffA[0] + (unsigned)(64 * lda) * 2u; voffB[1] = voffB[0] + (unsigned)(64 * K) * 2u; }
    const size_t kstep = (size_t)(BK * 2);
    const size_t hstepA = (size_t)HALF * lda * 2, hstepB = (size_t)HALF * K * 2;
    const size_t tstepA = 2 * hstepA, tstepB = 2 * hstepB;
    const unsigned ldsw = (unsigned)wid * 1024u;
    const int aoff = lds_byte(wr * 64 + fr, fq * 8), boff = lds_byte(wc * 32 + fr, fq * 8);
#define PG8_SA(b, h) (((b) * 2 + (h)) * HTB)
#define PG8_SB(b, h) ((4 + (b) * 2 + (h)) * HTB)
#define PG8_STAGE(bufoff, gbase, voff) do { _Pragma("unroll") for (int _i = 0; _i < 2; ++_i) \
        __builtin_amdgcn_global_load_lds((const unsigned*)((const char*)(gbase) + (voff)[_i]), (LAS unsigned*)(lds + (bufoff) + ldsw + _i * 8192), 16, 0, 0); } while (0)
#define PG8_LDA(dst, b, h) do { _Pragma("unroll") for (int m = 0; m < 4; ++m) { if constexpr (F8) dst##8[m] = cat16(*(const LAS bf16x8*)(lds + PG8_SA(b, h) + aoff + m * 2048), *(const LAS bf16x8*)(lds + PG8_SA(b, h) + aoff + m * 2048 + 1024)); \
        else { _Pragma("unroll") for (int k = 0; k < 2; ++k) dst[m][k] = *(const LAS bf16x8*)(lds + PG8_SA(b, h) + aoff + m * 2048 + k * 1024); } } } while (0)
#define PG8_LDB(dst, b, h) do { _Pragma("unroll") for (int n = 0; n < 2; ++n) { if constexpr (F8) dst##8[n] = cat16(*(const LAS bf16x8*)(lds + PG8_SB(b, h) + boff + n * 2048), *(const LAS bf16x8*)(lds + PG8_SB(b, h) + boff + n * 2048 + 1024)); \
        else { _Pragma("unroll") for (int k = 0; k < 2; ++k) dst[n][k] = *(const LAS bf16x8*)(lds + PG8_SB(b, h) + boff + n * 2048 + k * 1024); } } } while (0)
#define PG8_MMA(ai, bj, At, Bt) do { __builtin_amdgcn_s_setprio(1); _Pragma("unroll") for (int m = 0; m < 4; ++m) _Pragma("unroll") for (int n = 0; n < 2; ++n) { \
        if constexpr (F8) asm volatile("v_mfma_scale_f32_16x16x128_f8f6f4 %0, %1, %2, %0, %3, %3 op_sel_hi:[0,0,0]" : "+v"(acc[ai][bj][m][n]) : "v"(Bt##8[n]), "v"(At##8[m]), "v"(f8scale)); \
        else { _Pragma("unroll") for (int k = 0; k < 2; ++k) acc[ai][bj][m][n] = __builtin_amdgcn_mfma_f32_16x16x32_bf16(Bt[n][k], At[m][k], acc[ai][bj][m][n], 0, 0, 0); } } __builtin_amdgcn_s_setprio(0); } while (0)
#define PG8_WAIT_V(n) asm volatile("s_waitcnt vmcnt(" #n ")" ::: "memory")
#define PG8_WAIT_L(n) asm volatile("s_waitcnt lgkmcnt(" #n ")" ::: "memory")
#define PG8_BAR __builtin_amdgcn_s_barrier()
#define PG8_SCHED __builtin_amdgcn_sched_barrier(0)
    Unit cur, nxt; int ui = 0;
    if (!S.next(0, cur)) return;
    f32x4 acc[2][2][4][2];
#pragma unroll
    for (int a = 0; a < 2; ++a)
#pragma unroll
        for (int b = 0; b < 2; ++b)
#pragma unroll
            for (int m = 0; m < 4; ++m)
#pragma unroll
                for (int n = 0; n < 2; ++n) acc[a][b][m][n] = (f32x4){0.f, 0.f, 0.f, 0.f};
    bf16x8 At[4][2], B0[2][2], B1[2][2]; i32x8 At8[4], B08[2], B18[2];
    int f8scale = 0x7F7F7F7F; asm volatile("" : "+v"(f8scale));
    const char* cA = (const char*)g.A + (size_t)cur.pm * tstepA; const char* cB = (const char*)g.Bt + (size_t)cur.pn * tstepB;
    PG8_STAGE(PG8_SB(0, 0), cB, voffB); PG8_STAGE(PG8_SB(0, 1), cB + hstepB, voffB); PG8_STAGE(PG8_SA(0, 0), cA, voffA); PG8_STAGE(PG8_SA(0, 1), cA + hstepA, voffA);
    if (wr == 1) PG8_BAR;
    PG8_WAIT_V(2); PG8_BAR;
    PG8_STAGE(PG8_SB(1, 0), cB + kstep, voffB); PG8_STAGE(PG8_SA(1, 0), cA + kstep, voffA); PG8_STAGE(PG8_SB(1, 1), cB + hstepB + kstep, voffB);
    PG8_WAIT_V(6); PG8_BAR;
    for (;;) {
        const bool has_next = S.next(ui + 1, nxt);
        const char* nA = has_next ? (const char*)g.A + (size_t)nxt.pm * tstepA : cA; const char* nB = has_next ? (const char*)g.Bt + (size_t)nxt.pn * tstepB : cB;
        for (int t = 0; t < nt; t += 2) {
            const bool last = (t == nt - 2);
            const char* a1 = cA + (size_t)(t + 1) * kstep;
            const char* a2 = last ? nA : cA + (size_t)(t + 2) * kstep; const char* b2 = last ? nB : cB + (size_t)(t + 2) * kstep;
            const char* a3 = a2 + kstep; const char* b3 = b2 + kstep;
            PG8_LDB(B0, 0, 0); PG8_LDB(B1, 0, 1); PG8_SCHED; PG8_LDA(At, 0, 0); PG8_STAGE(PG8_SA(1, 1), a1 + hstepA, voffA);
            PG8_WAIT_V(8); PG8_WAIT_L(0); PG8_BAR; PG8_MMA(0, 0, At, B0); PG8_MMA(0, 1, At, B1); PG8_BAR; PG8_SCHED;
            PG8_LDA(At, 0, 1); PG8_STAGE(PG8_SB(0, 0), b2, voffB); PG8_STAGE(PG8_SB(0, 1), b2 + hstepB, voffB); PG8_STAGE(PG8_SA(0, 0), a2, voffA);
            PG8_WAIT_V(8); PG8_WAIT_L(0); PG8_BAR; PG8_MMA(1, 0, At, B0); PG8_MMA(1, 1, At, B1); PG8_BAR; PG8_SCHED;
            PG8_LDB(B0, 1, 0); PG8_LDB(B1, 1, 1); PG8_SCHED; PG8_LDA(At, 1, 0); PG8_STAGE(PG8_SA(0, 1), a2 + hstepA, voffA);
            PG8_WAIT_V(8); PG8_WAIT_L(0); PG8_BAR; PG8_MMA(0, 0, At, B0); PG8_MMA(0, 1, At, B1); PG8_BAR; PG8_SCHED;
            PG8_LDA(At, 1, 1); PG8_STAGE(PG8_SB(1, 0), b3, voffB); PG8_STAGE(PG8_SB(1, 1), b3 + hstepB, voffB); PG8_STAGE(PG8_SA(1, 0), a3, voffA);
            PG8_WAIT_V(8); PG8_WAIT_L(0); PG8_BAR; PG8_MMA(1, 0, At, B0); PG8_MMA(1, 1, At, B1); PG8_BAR; PG8_SCHED;
        }
        if (wr == 0) PG8_BAR;
        if constexpr (F8) asm volatile("s_nop 15\n\ts_nop 15" ::: "memory");
        { int fr_e = fr, fq_e = fq; asm volatile("" : "+v"(fr_e), "+v"(fq_e)); E(acc, cur, wr, wc, fr_e, fq_e); }
        if (!has_next) break;
#pragma unroll
        for (int a = 0; a < 2; ++a)
#pragma unroll
            for (int b = 0; b < 2; ++b)
#pragma unroll
                for (int m = 0; m < 4; ++m)
#pragma unroll
                    for (int n = 0; n < 2; ++n) acc[a][b][m][n] = (f32x4){0.f, 0.f, 0.f, 0.f};
        cur = nxt; cA = nA; cB = nB; ++ui;
        if (wr == 1) PG8_BAR;
    }
    PG8_WAIT_V(0);
    PG8_BAR;
#undef PG8_SA
#undef PG8_SB
#undef PG8_STAGE
#undef PG8_LDA
#undef PG8_LDB
#undef PG8_MMA
#undef PG8_WAIT_V
#undef PG8_WAIT_L
#undef PG8_BAR
#undef PG8_SCHED
}

struct EpiBig {
    static constexpr bool PERM = true;
    bf16_t* O; int ldc; int sig_from; int split, add0, add1; float os;
    __device__ __forceinline__ void operator()(const f32x4 (&acc)[2][2][4][2], const Unit& u, int wr, int wc, int fr, int fq) const {
        const int row0 = u.pm * BM + wr * 64 + fr, col0 = (u.pn + (u.pn < split ? add0 : add1)) * BM + wc * 32 + 8 * fq; const bool sg = u.pn >= sig_from;
#pragma unroll
        for (int ai = 0; ai < 2; ++ai)
#pragma unroll
            for (int m = 0; m < 4; ++m) { bf16_t* rowp = O + (size_t)(row0 + ai * HALF + m * 16) * ldc + col0;
#pragma unroll
                for (int bj = 0; bj < 2; ++bj) { f32x4 v0 = acc[ai][bj][m][0] * os, v1 = acc[ai][bj][m][1] * os;
                    if (sg) {
#pragma unroll
                        for (int e = 0; e < 4; ++e) { v0[e] = __builtin_amdgcn_rcpf(1.0f + __expf(-v0[e])); v1[e] = __builtin_amdgcn_rcpf(1.0f + __expf(-v1[e])); } }
                    u32x4 w; w.x = cvt_pk_bf16(v0[0], v0[1]); w.y = cvt_pk_bf16(v0[2], v0[3]); w.z = cvt_pk_bf16(v1[0], v1[1]); w.w = cvt_pk_bf16(v1[2], v1[3]);
                    *(u32x4*)(rowp + bj * HALF) = w; } }
    }
};
template <bool ACCUM> struct EpiGate {
    static constexpr bool PERM = true;
    bf16_t* Z; const bf16_t* G; int ldg; float os; unsigned char* Z8;
    __device__ __forceinline__ void operator()(const f32x4 (&acc)[2][2][4][2], const Unit& u, int wr, int wc, int fr, int fq) const {
        const int row0 = u.pm * BM + wr * 64 + fr, col0 = u.pn * BM + wc * 32 + 8 * fq;
#pragma unroll
        for (int ai = 0; ai < 2; ++ai)
#pragma unroll
            for (int m = 0; m < 4; ++m) { const size_t r = (size_t)(row0 + ai * HALF + m * 16);
#pragma unroll
                for (int bj = 0; bj < 2; ++bj) { const f32x4 v0 = acc[ai][bj][m][0], v1 = acc[ai][bj][m][1];
                    const u32x4 gw = *(const u32x4*)(G + r * ldg + col0 + bj * HALF);
                    float o[8] = { v0[0] * os * bflo(gw.x), v0[1] * os * bfhi(gw.x), v0[2] * os * bflo(gw.y), v0[3] * os * bfhi(gw.y), v1[0] * os * bflo(gw.z), v1[1] * os * bfhi(gw.z), v1[2] * os * bflo(gw.w), v1[3] * os * bfhi(gw.w) };
                    bf16_t* zp = Z + r * D + col0 + bj * HALF;
                    if (ACCUM) { const u32x4 zw = *(const u32x4*)zp; o[0] += bflo(zw.x); o[1] += bfhi(zw.x); o[2] += bflo(zw.y); o[3] += bfhi(zw.y); o[4] += bflo(zw.z); o[5] += bfhi(zw.z); o[6] += bflo(zw.w); o[7] += bfhi(zw.w); }
                    if (ACCUM) { u32x2 w8; w8.x = pk4_fp8(o[0] * Z_S, o[1] * Z_S, o[2] * Z_S, o[3] * Z_S); w8.y = pk4_fp8(o[4] * Z_S, o[5] * Z_S, o[6] * Z_S, o[7] * Z_S); *(u32x2*)(Z8 + r * D + col0 + bj * HALF) = w8; }
                    else { u32x4 w; w.x = cvt_pk_bf16(o[0], o[1]); w.y = cvt_pk_bf16(o[2], o[3]); w.z = cvt_pk_bf16(o[4], o[5]); w.w = cvt_pk_bf16(o[6], o[7]); *(u32x4*)zp = w; } } }
    }
};
struct EpiRes {
    static constexpr bool PERM = true;
    bf16_t* T; const float* xp; const float* xs; const float* ada; float os;
    __device__ __forceinline__ void operator()(const f32x4 (&acc)[2][2][4][2], const Unit& u, int wr, int wc, int fr, int fq) const {
        const int row0 = u.pm * BM + wr * 64 + fr, col0 = u.pn * BM + wc * 32 + 8 * fq;
#pragma unroll
        for (int ai = 0; ai < 2; ++ai)
#pragma unroll
            for (int m = 0; m < 4; ++m) { const int r = row0 + ai * HALF + m * 16;
                const float* xrow = r < MP ? xp + (size_t)r * D : xs + (size_t)(r - MP) * D;
                const int b = r < MP ? (r >> 12) : BATCH + ((r - MP) >> 3);
                const float* g1 = ada + (size_t)b * (6 * D) + 2 * D;
#pragma unroll
                for (int bj = 0; bj < 2; ++bj) { const int c = col0 + bj * HALF;
                    const f32x4 x0 = *(const f32x4*)(xrow + c), x1 = *(const f32x4*)(xrow + c + 4), g0 = *(const f32x4*)(g1 + c), g4 = *(const f32x4*)(g1 + c + 4);
                    const f32x4 v0 = x0 * ALPHA + g0 * (acc[ai][bj][m][0] * os), v1 = x1 * ALPHA + g4 * (acc[ai][bj][m][1] * os);
                    u32x4 w; w.x = cvt_pk_bf16(v0[0], v0[1]); w.y = cvt_pk_bf16(v0[2], v0[3]); w.z = cvt_pk_bf16(v1[0], v1[1]); w.w = cvt_pk_bf16(v1[2], v1[3]);
                    *(u32x4*)(T + (size_t)r * D + c) = w; } }
    }
};
struct EpiPlain {
    static constexpr bool PERM = true;
    bf16_t* O; float os;
    __device__ __forceinline__ void operator()(const f32x4 (&acc)[2][2][4][2], const Unit& u, int wr, int wc, int fr, int fq) const {
        const int row0 = u.pm * BM + wr * 64 + fr, col0 = u.pn * BM + wc * 32 + 8 * fq;
#pragma unroll
        for (int ai = 0; ai < 2; ++ai)
#pragma unroll
            for (int m = 0; m < 4; ++m) { bf16_t* rowp = O + (size_t)(row0 + ai * HALF + m * 16) * D + col0;
#pragma unroll
                for (int bj = 0; bj < 2; ++bj) { const f32x4 v0 = acc[ai][bj][m][0] * os, v1 = acc[ai][bj][m][1] * os;
                    u32x4 w; w.x = cvt_pk_bf16(v0[0], v0[1]); w.y = cvt_pk_bf16(v0[2], v0[3]); w.z = cvt_pk_bf16(v1[0], v1[1]); w.w = cvt_pk_bf16(v1[2], v1[3]);
                    *(u32x4*)(rowp + bj * HALF) = w; } }
    }
};
}

#define XB_TMO      128
#define XB_XCNT(j)  (256  + 64 * (j))
#define XB_XSUB(j)  (1280 + 64 * (j))
#define XB_XGEN(j)  (2304 + 64 * (j))
#define XB_TOP      3328
#define XB_TOPGEN   3392
#define XCD_BAR_WORDS 3456
#define XB_SPIN_CAP (1u << 22)
__device__ __forceinline__ unsigned xb_ld(unsigned* p)              { return __hip_atomic_load(p, __ATOMIC_RELAXED, __HIP_MEMORY_SCOPE_AGENT); }
__device__ __forceinline__ unsigned xb_add(unsigned* p, unsigned v) { return __hip_atomic_fetch_add(p, v, __ATOMIC_RELAXED, __HIP_MEMORY_SCOPE_AGENT); }
__device__ __forceinline__ unsigned xb_xcc_id() { return (unsigned)__builtin_amdgcn_s_getreg((3 << 11) | 20) & 0xFu; }
#define XB_SPIN(cond, bar) do { unsigned _sp = 0; while (cond) { __builtin_amdgcn_s_sleep(1); \
    if ((++_sp & 255u) == 0u) { if (xb_ld(&(bar)[XB_TMO])) break; if (_sp > XB_SPIN_CAP) { atomicAdd(&(bar)[XB_TMO], 1u); break; } } } } while (0)
struct XcdBarrier { unsigned* bar; unsigned x; volatile LAS unsigned* st; };
__device__ __forceinline__ XcdBarrier xcd_barrier_post(unsigned* bar, volatile LAS unsigned* st) {
    XcdBarrier b; b.bar = bar; b.x = xb_xcc_id(); b.st = st;
    if (threadIdx.x == 0) (void)xb_add(&bar[XB_XCNT(b.x)], 1u);
    return b;
}
__device__ __forceinline__ void xcd_barrier_complete(unsigned* bar, unsigned x, unsigned& nloc, unsigned& nx) {
    const unsigned G = gridDim.x * gridDim.y * gridDim.z;
    unsigned sum, cnt, mine, sp = 0u;
    for (;;) {
        sum = 0u; cnt = 0u; mine = 0u;
#pragma unroll
        for (unsigned j = 0; j < 16; ++j) { const unsigned c = xb_ld(&bar[XB_XCNT(j)]); sum += c; cnt += (c > 0u) ? 1u : 0u; mine = (j == x) ? c : mine; }
        if (sum == G) break;
        __builtin_amdgcn_s_sleep(1);
        if ((++sp & 255u) == 0u) { if (xb_ld(&bar[XB_TMO])) break; if (sp > XB_SPIN_CAP) { atomicAdd(&bar[XB_TMO], 1u); break; } }
    }
    nloc = mine > 0u ? mine : 1u; nx = cnt > 0u ? cnt : 1u;
}
__device__ __forceinline__ void xcd_barrier(const XcdBarrier& b) {
    asm volatile("s_waitcnt vmcnt(0)" ::: "memory");
    __syncthreads();
    if (threadIdx.x == 0) {
        unsigned* bar = b.bar;
        __builtin_amdgcn_s_waitcnt(0);
        unsigned nloc = b.st[0], nx = b.st[1];
        if (nloc == 0u) { xcd_barrier_complete(bar, b.x, nloc, nx); b.st[0] = nloc; b.st[1] = nx; }
        const unsigned old = xb_add(&bar[XB_XSUB(b.x)], 1u);
        const unsigned gen = old / nloc;
        if (old + 1u == (gen + 1u) * nloc) {
            __builtin_amdgcn_fence(__ATOMIC_RELEASE, "agent");
            asm volatile("s_waitcnt vmcnt(0)" ::: "memory");
            const unsigned og = xb_add(&bar[XB_TOP], 1u);
            const unsigned tg = og / nx;
            if (og + 1u == (tg + 1u) * nx) xb_add(&bar[XB_TOPGEN], 1u);
            else XB_SPIN(xb_ld(&bar[XB_TOPGEN]) == tg, bar);
            __builtin_amdgcn_fence(__ATOMIC_ACQUIRE, "agent");
            xb_add(&bar[XB_XGEN(b.x)], 1u);
            asm volatile("s_waitcnt vmcnt(0)" ::: "memory");
        } else {
            XB_SPIN(xb_ld(&bar[XB_XGEN(b.x)]) == gen, bar);
            __builtin_amdgcn_fence(__ATOMIC_ACQUIRE, "agent");
            asm volatile("s_waitcnt vmcnt(0)" ::: "memory");
        }
    }
    __syncthreads();
}

struct Args { const float* in[31]; float* out; unsigned char* ws; int ph_lo, ph_hi, flags, pad; };
typedef const __attribute__((address_space(4))) Args CArgs;

struct Ctx {
    LAS unsigned char* lds;
    int tid, lane, wave, vcu, G;
};

__device__ __forceinline__ void p0_ada(const Ctx& X, const float* cP, const float* cS, const float* w_ada, const float* b_ada, float* ADA) {
    constexpr int NA = 6 * D;
    const int lane = X.lane, w = X.wave, fr = lane & 15, fq = lane >> 4;
    LAS float* red = (LAS float*)X.lds;
    for (int cb = X.vcu; cb < NA / 48; cb += X.G) {
        const int n0 = cb * 48;
        f32x4 acc[9][3];
#pragma unroll
        for (int i = 0; i < 9; ++i)
#pragma unroll
            for (int j = 0; j < 3; ++j) acc[i][j] = (f32x4){0.f, 0.f, 0.f, 0.f};
        for (int ks = 0; ks < 8; ++ks) {
            const int k0 = w * 256 + ks * 32 + 8 * fq;
            bf16x8 bfr[3];
#pragma unroll
            for (int nt = 0; nt < 3; ++nt) {
                float t[8];
#pragma unroll
                for (int j = 0; j < 8; ++j) t[j] = w_ada[(size_t)(k0 + j) * NA + n0 + nt * 16 + fr];
                u32x4 p; p.x = pk2(t[0], t[1]); p.y = pk2(t[2], t[3]); p.z = pk2(t[4], t[5]); p.w = pk2(t[6], t[7]);
                bfr[nt] = __builtin_bit_cast(bf16x8, p);
            }
            { LAS unsigned char* scw = X.lds + 32768 + w * 11520; const int kw = w * 256 + ks * 32 + 4 * (lane & 7);
#pragma unroll
              for (int i = 0; i < 18; ++i) { const int r = 8 * i + (lane >> 3); f32x4 cv = (f32x4){0.f, 0.f, 0.f, 0.f};
                  if (r < NB) { const float* cr = r < BATCH ? cP + (size_t)r * D : cS + (size_t)(r - BATCH) * D; cv = *(const f32x4*)(cr + kw); }
#pragma unroll
                  for (int j = 0; j < 4; ++j) cv[j] = cv[j] * __builtin_amdgcn_rcpf(1.0f + __expf(-cv[j]));
                  u32x2 pw; pw.x = pk2(cv[0], cv[1]); pw.y = pk2(cv[2], cv[3]); *(LAS u32x2*)(scw + r * 80 + (lane & 7) * 8) = pw; }
              asm volatile("s_waitcnt lgkmcnt(0)" ::: "memory");
#pragma unroll
              for (int mt = 0; mt < 9; ++mt) { const bf16x8 afr = *(const LAS bf16x8*)(scw + (mt * 16 + fr) * 80 + fq * 16);
#pragma unroll
                  for (int nt = 0; nt < 3; ++nt) acc[mt][nt] = __builtin_amdgcn_mfma_f32_16x16x32_bf16(afr, bfr[nt], acc[mt][nt], 0, 0, 0); }
              asm volatile("s_waitcnt lgkmcnt(0)" ::: "memory"); }
        }
        for (int rnd = 0; rnd < 8; ++rnd) {
            if (w == rnd) {
#pragma unroll
                for (int mt = 0; mt < 9; ++mt)
#pragma unroll
                    for (int nt = 0; nt < 3; ++nt)
#pragma unroll
                        for (int e = 0; e < 4; ++e) { const int idx = (mt * 16 + 4 * fq + e) * 48 + nt * 16 + fr; red[idx] = (rnd == 0 ? 0.f : red[idx]) + acc[mt][nt][e]; }
            }
            __syncthreads();
        }
        for (int i = X.tid; i < NB * 48; i += NTHREADS) { const int r = i / 48, c = i % 48; ADA[(size_t)r * NA + n0 + c] = red[r * 48 + c] + b_ada[n0 + c]; }
        __syncthreads();
    }
}
__device__ __forceinline__ void p0_transpose_item(const float* W, int ldw, int srccol, int k0, bf16_t* WT, int K, int dstrow, LAS float* scr, int lane, unsigned char* WF8 = nullptr) {
    { f32x4 t[8];
#pragma unroll
      for (int i = 0; i < 8; ++i) t[i] = *(const f32x4*)(W + (size_t)(k0 + 8 * i + (lane >> 3)) * ldw + srccol + 4 * (lane & 7));
#pragma unroll
      for (int i = 0; i < 8; ++i) { LAS float* d = scr + (8 * i + (lane >> 3)) * 33 + 4 * (lane & 7); d[0] = t[i][0]; d[1] = t[i][1]; d[2] = t[i][2]; d[3] = t[i][3]; } }
    LDS_WAIT(); asm volatile("" ::: "memory");
    const int c = lane & 7;
#pragma unroll
    for (int j = 0; j < (WT ? 4 : 0); ++j) { const int n = (lane >> 3) + 8 * j; const LAS float* s = scr + (8 * c) * 33 + n;
        u32x4 o; o.x = pk2(s[0 * 33], s[1 * 33]); o.y = pk2(s[2 * 33], s[3 * 33]); o.z = pk2(s[4 * 33], s[5 * 33]); o.w = pk2(s[6 * 33], s[7 * 33]);
        *(u32x4*)(WT + (size_t)(dstrow + n) * K + k0 + 8 * c) = o; }
    if (WF8) {
        const int c4 = lane & 3;
#pragma unroll
        for (int j = 0; j < 2; ++j) { const int n = (lane >> 2) + 16 * j; const LAS float* sp = scr + (16 * c4) * 33 + n; u32x4 o;
#pragma unroll
            for (int q = 0; q < 4; ++q) o[q] = pk4_fp8(sp[(4 * q) * 33] * W_S, sp[(4 * q + 1) * 33] * W_S, sp[(4 * q + 2) * 33] * W_S, sp[(4 * q + 3) * 33] * W_S);
            *(u32x4*)(WF8 + (size_t)(dstrow + n) * K + k0 + 16 * c4) = o; } }
    LDS_WAIT(); asm volatile("" ::: "memory");
}
__device__ __forceinline__ void p0_transposes(const Ctx& X, CArgs& a) {
    unsigned char* ws = a.ws;
    LAS float* scr = (LAS float*)(X.lds + 32768 + X.wave * 8704);
    const int gw = X.vcu * NWAVES + X.wave, NGW = X.G * NWAVES;
    constexpr int I_IN = (D / 64) * (NW / 32), I_SQ = (D / 64) * (D / 32);
    bf16_t* WinT = (bf16_t*)(ws + WS_WINT); bf16_t* W4T = (bf16_t*)(ws + WS_W4T);
    for (int it = gw; it < I_IN + 4 * I_SQ; it += NGW) {
        if (it < I_IN) { const int nblk = NW / 32, kb = it / nblk, nb = it % nblk; const int n0 = nb * 32; const int src = n0 < SRC_MIF ? n0 : n0 + 8;
            const bool soft = n0 < C_AK || n0 >= C_MO;
            p0_transpose_item(a.in[13], INW, src, kb * 64, soft ? nullptr : WinT, D, n0, scr, X.lane, ws + WS_WINF8); }
        else { int r = it - I_IN; const int wsel = r / I_SQ; r %= I_SQ; const int nblk = D / 32, kb = r / nblk, nb = r % nblk;
            const float* W = wsel == 0 ? a.in[20] : wsel == 1 ? a.in[21] : wsel == 2 ? a.in[22] : a.in[25];
            p0_transpose_item(W, D, nb * 32, kb * 64, nullptr, D, nb * 32, scr, X.lane, ws + WS_W4F8 + (size_t)wsel * D * D); }
    }
    { bf16_t* SKB = (bf16_t*)(ws + WS_SKB); for (int i = blockIdx.x * NTHREADS + X.tid; i < PH * 2 * NKEYS * 128 / 2; i += X.G * NTHREADS) { const f32x2 v = *(const f32x2*)(a.in[26] + 2 * (size_t)i); ((unsigned*)SKB)[i] = pk2(v.x, v.y); } }
    float* WMIF = (float*)(ws + WS_WMIF);
    for (int i = blockIdx.x * NTHREADS + X.tid; i < 8 * D; i += X.G * NTHREADS) { const int j = i / D, k = i % D; WMIF[i] = a.in[13][(size_t)k * INW + SRC_MIF + j]; }
}


__device__ __forceinline__ void p0_peer_fp8(const Ctx& X, CArgs& a, int part, int wi, int nwk) {
    unsigned char* ws = a.ws; float* PSC = (float*)(ws + WS_PSC);
    const int gw = wi * NWAVES + X.wave, NGW = nwk * NWAVES, lane = X.lane;
    for (int it = part * 8192 + 2 * gw; it < (part + 1) * 8192; it += 2 * NGW) {
        f32x4 v[2][8]; float am[2];
#pragma unroll
        for (int rr = 0; rr < 2; ++rr) { const int tb = (it + rr) >> 14, e = (it + rr) & 16383; const float* src = (tb ? a.in[28] : a.in[27]) + (size_t)e * D + 4 * lane;
#pragma unroll
            for (int i = 0; i < 8; ++i) v[rr][i] = __builtin_nontemporal_load((const f32x4*)(src + 256 * i)); }
#pragma unroll
        for (int rr = 0; rr < 2; ++rr) { float m_ = 0.f;
#pragma unroll
            for (int i = 0; i < 8; ++i) m_ = fmaxf(m_, fmaxf(fmaxf(fabsf(v[rr][i][0]), fabsf(v[rr][i][1])), fmaxf(fabsf(v[rr][i][2]), fabsf(v[rr][i][3]))));
            am[rr] = wave_max(m_); }
#pragma unroll
        for (int rr = 0; rr < 2; ++rr) { const int tb = (it + rr) >> 14, e = (it + rr) & 16383; unsigned char* tbl = ws + (tb ? WS_V8 : WS_U8);
            const float top = tb ? 224.0f : 127.0f;
            const float sc = am[rr] > 0.f ? top / am[rr] : 1.0f;
#pragma unroll
            for (int i = 0; i < 8; ++i) { unsigned p;
                if (tb) { int q = 0; q = __builtin_amdgcn_cvt_pk_fp8_f32(v[rr][i][0] * sc, v[rr][i][1] * sc, q, false); q = __builtin_amdgcn_cvt_pk_fp8_f32(v[rr][i][2] * sc, v[rr][i][3] * sc, q, true); p = (unsigned)q; }
                else p = pk4_i8(v[rr][i][0] * sc, v[rr][i][1] * sc, v[rr][i][2] * sc, v[rr][i][3] * sc);
                *(unsigned*)(tbl + (size_t)(2 * i + (lane >> 5)) * SLAB_BYTES + (size_t)e * 128 + 4 * (lane & 31)) = p; }
            if (lane == 0) PSC[tb * 16384 + e] = am[rr] > 0.f ? am[rr] / top : 1.0f; }
    }
}

__device__ __forceinline__ void p1_rows(const Ctx& X, CArgs& a) {
    unsigned char* ws = a.ws;
    const float* ADA = (const float*)(ws + WS_ADA); const float* WMIF = (const float*)(ws + WS_WMIF);
    float* MIF = (float*)(ws + WS_MIF); bf16_t* H1 = (bf16_t*)(ws + WS_H1);
    LAS float* wl = (LAS float*)X.lds;
    for (int i = X.tid; i < 8 * D / 4; i += NTHREADS) ((LAS f32x4*)wl)[i] = ((const f32x4*)WMIF)[i];
    __syncthreads();
    const int gw = X.vcu * NWAVES + X.wave, NGW = X.G * NWAVES, lane = X.lane;
    for (int m = gw; m < M; m += NGW) {
        const float* xrow = m < MP ? a.in[0] + (size_t)m * D : a.in[1] + (size_t)(m - MP) * D;
        const int b = m < MP ? (m >> 12) : BATCH + ((m - MP) >> 3);
        const float* sh = ADA + (size_t)b * 6 * D; const float* sc = sh + D;
        f32x4 v[8]; float dots[8];
#pragma unroll
        for (int j = 0; j < 8; ++j) dots[j] = 0.f;
#pragma unroll
        for (int j = 0; j < 8; ++j) { const int c = 4 * lane + 256 * j; const f32x4 xv = *(const f32x4*)(xrow + c), s1 = *(const f32x4*)(sc + c), s0 = *(const f32x4*)(sh + c);
            v[j] = xv * (s1 + 1.0f) + s0;
#pragma unroll
            for (int q = 0; q < 8; ++q) { const f32x4 wv = *(const LAS f32x4*)(wl + q * D + c); dots[q] += (v[j][0] * wv[0] + v[j][1] * wv[1]) + (v[j][2] * wv[2] + v[j][3] * wv[3]); }
            asm volatile("" ::: "memory"); }
        u32x2* o8 = (u32x2*)(H1 + (size_t)m * D) + lane; unsigned* o4 = (unsigned*)(ws + WS_H1F8 + (size_t)m * D) + lane;
#pragma unroll
        for (int j = 0; j < 8; ++j) { u32x2 w; w.x = pk2(v[j][0], v[j][1]); w.y = pk2(v[j][2], v[j][3]); o8[64 * j] = w; o4[64 * j] = pk4_fp8(v[j][0] * ACT_S, v[j][1] * ACT_S, v[j][2] * ACT_S, v[j][3] * ACT_S); }
#pragma unroll
        for (int q = 0; q < 8; ++q) dots[q] = wave_sum(dots[q]);
        if (lane < 8) { float d = dots[0];
#pragma unroll
            for (int q = 1; q < 8; ++q) d = (lane == q) ? dots[q] : d;
            float r;
            if (lane < 4) r = d + a.in[14][lane];
            else { const float z = d + a.in[15][lane - 4]; r = fminf(z, 0.f) - log1pf(expf(-fabsf(z))); }
            MIF[(size_t)m * 8 + lane] = r; }
    }
    __syncthreads();
}

__device__ __forceinline__ int t5_bucket(int d) {
    if (d < 16) return d;
    int v = 16 + (int)(logf((float)d / 16.0f) / logf(8.0f) * 16.0f);
    return v < 31 ? v : 31;
}
__device__ __forceinline__ void p3_attention(const Ctx& X, CArgs& a, int wi, int nwk, int mrow0, int nrows) {
    unsigned char* ws = a.ws;
    const bf16_t* BIG = (const bf16_t*)(ws + WS_BIG); bf16_t* ATT = (bf16_t*)(ws + WS_H1);
    LAS float* btab = (LAS float*)X.lds;
    for (int i = X.tid; i < HEADS * 128; i += NTHREADS) { const int h = i >> 7, d = i & 127; btab[i] = a.in[10][t5_bucket(d) * HEADS + h]; }
    __syncthreads();
    const float* ck = a.in[4]; const float* cv = a.in[5];
    const int nitems = nrows * HEADS;
    for (int it = wi * NTHREADS + X.tid; it < nitems; it += nwk * NTHREADS) {
        const int mb = it >> 11, rem = it & 2047, head = rem >> 6, m = mrow0 + mb * 64 + (rem & 63);
        const int kvh = head >> 2;
        float q[64], acc[64];
        { const u32x4* qp = (const u32x4*)(BIG + (size_t)m * NW + C_AQ + head * 64);
#pragma unroll
          for (int j = 0; j < 8; ++j) { const u32x4 w = qp[j]; q[8 * j + 0] = bflo(w.x); q[8 * j + 1] = bfhi(w.x); q[8 * j + 2] = bflo(w.y); q[8 * j + 3] = bfhi(w.y); q[8 * j + 4] = bflo(w.z); q[8 * j + 5] = bfhi(w.z); q[8 * j + 6] = bflo(w.w); q[8 * j + 7] = bfhi(w.w); } }
#pragma unroll
        for (int j = 0; j < 64; ++j) acc[j] = 0.f;
        float mx = a.in[19][head], l = 1.0f;
        const bool prompt = m < MP;
        const int t = prompt ? (m & (SEQ - 1)) : ((m - MP) & 7);
        const int bs = prompt ? 0 : ((m - MP) >> 3);
        const int nk = prompt ? (t < 127 ? t + 1 : 128) : 128;
        for (int dist = 0; dist < nk; ++dist) {
            bool from_cache = false; int crow = 0; size_t brow = 0;
            if (prompt) brow = (size_t)(m - dist);
            else { const int j = t + 128 - dist; if (j < 128) { from_cache = true; crow = j; } else brow = (size_t)(MP + bs * 8 + (j - 128)); }
            float s = 0.f;
            if (from_cache) { const f32x4* kp = (const f32x4*)(ck + (((size_t)bs * 128 + crow) * KVH + kvh) * HD);
#pragma unroll
                for (int j = 0; j < 16; ++j) { const f32x4 w = kp[j]; s += (q[4 * j] * w[0] + q[4 * j + 1] * w[1]) + (q[4 * j + 2] * w[2] + q[4 * j + 3] * w[3]); } }
            else { const u32x4* kp = (const u32x4*)(BIG + brow * NW + C_AK + kvh * 64);
#pragma unroll
                for (int j = 0; j < 8; ++j) { const u32x4 w = kp[j];
                    s += (q[8 * j + 0] * bflo(w.x) + q[8 * j + 1] * bfhi(w.x)) + (q[8 * j + 2] * bflo(w.y) + q[8 * j + 3] * bfhi(w.y)) + (q[8 * j + 4] * bflo(w.z) + q[8 * j + 5] * bfhi(w.z)) + (q[8 * j + 6] * bflo(w.w) + q[8 * j + 7] * bfhi(w.w)); } }
            s = s * 0.125f + btab[head * 128 + dist];
            const float mn = fmaxf(mx, s), sc = expf(mx - mn), p = expf(s - mn);
            l = l * sc + p; mx = mn;
            if (from_cache) { const f32x4* vp = (const f32x4*)(cv + (((size_t)bs * 128 + crow) * KVH + kvh) * HD);
#pragma unroll
                for (int j = 0; j < 16; ++j) { const f32x4 w = vp[j]; acc[4 * j] = acc[4 * j] * sc + p * w[0]; acc[4 * j + 1] = acc[4 * j + 1] * sc + p * w[1]; acc[4 * j + 2] = acc[4 * j + 2] * sc + p * w[2]; acc[4 * j + 3] = acc[4 * j + 3] * sc + p * w[3]; } }
            else { const u32x4* vp = (const u32x4*)(BIG + brow * NW + C_AV + kvh * 64);
#pragma unroll
                for (int j = 0; j < 8; ++j) { const u32x4 w = vp[j];
                    acc[8 * j + 0] = acc[8 * j + 0] * sc + p * bflo(w.x); acc[8 * j + 1] = acc[8 * j + 1] * sc + p * bfhi(w.x); acc[8 * j + 2] = acc[8 * j + 2] * sc + p * bflo(w.y); acc[8 * j + 3] = acc[8 * j + 3] * sc + p * bfhi(w.y);
                    acc[8 * j + 4] = acc[8 * j + 4] * sc + p * bflo(w.z); acc[8 * j + 5] = acc[8 * j + 5] * sc + p * bfhi(w.z); acc[8 * j + 6] = acc[8 * j + 6] * sc + p * bflo(w.w); acc[8 * j + 7] = acc[8 * j + 7] * sc + p * bfhi(w.w); } }
        }
        const float inv = 1.0f / l;
        u32x4* op = (u32x4*)(ATT + (size_t)m * D + head * 64);
#pragma unroll
        for (int j = 0; j < 8; ++j) { u32x4 w; w.x = pk2(acc[8 * j] * inv, acc[8 * j + 1] * inv); w.y = pk2(acc[8 * j + 2] * inv, acc[8 * j + 3] * inv); w.z = pk2(acc[8 * j + 4] * inv, acc[8 * j + 5] * inv); w.w = pk2(acc[8 * j + 6] * inv, acc[8 * j + 7] * inv); op[j] = w; }
    }
    __syncthreads();
}

typedef float f32x16 __attribute__((ext_vector_type(16)));
typedef short s16x4 __attribute__((ext_vector_type(4)));
__device__ __forceinline__ void att_prompt_unit(const Ctx& X, CArgs& a, int b, int kvh, int qb) {
    unsigned char* ws = a.ws; const bf16_t* BIG = (const bf16_t*)(ws + WS_BIG); unsigned char* ATT8 = ws + WS_ATT8;
    LAS bf16_t* Kl = (LAS bf16_t*)X.lds;
    LAS bf16_t* VTl = Kl + 256 * 72;
    LAS float* btl = (LAS float*)(VTl + 64 * 260);
    const int tid = X.tid, lane = X.lane, w = X.wave, r32 = lane & 31, hh = lane >> 5;
    constexpr float L2E = 1.4426950408889634f;
    const size_t krow0 = (size_t)b * SEQ + (size_t)qb * 128 - 128;
    __syncthreads();
#pragma unroll
    for (int i = 0; i < 4; ++i) { const int id = i * NTHREADS + tid, key = id >> 3, seg = id & 7;
        u32x4 kw = (u32x4){0u, 0u, 0u, 0u}, vw = kw;
        if (qb > 0 || key >= 128) { const bf16_t* rp = BIG + (krow0 + key) * NW + kvh * 64 + seg * 8; kw = *(const u32x4*)(rp + C_AK); vw = *(const u32x4*)(rp + C_AV); }
        *(LAS u32x4*)(Kl + key * 72 + seg * 8) = kw;
        LAS bf16_t* vp = VTl + (seg * 8) * 260 + key;
        vp[0] = (bf16_t)(vw.x & 0xffffu); vp[260] = (bf16_t)(vw.x >> 16); vp[2 * 260] = (bf16_t)(vw.y & 0xffffu); vp[3 * 260] = (bf16_t)(vw.y >> 16);
        vp[4 * 260] = (bf16_t)(vw.z & 0xffffu); vp[5 * 260] = (bf16_t)(vw.z >> 16); vp[6 * 260] = (bf16_t)(vw.w & 0xffffu); vp[7 * 260] = (bf16_t)(vw.w >> 16); }
    { const int g = tid >> 7, d = tid & 127; btl[tid] = a.in[10][t5_bucket(d) * HEADS + kvh * 4 + g] * L2E; }
    __syncthreads();
    const int g = w >> 1, qh = w & 1, head = kvh * 4 + g;
    const float sink2 = a.in[19][head] * L2E;
    for (int qt = 0; qt < 2; ++qt) {
        const int qo = qh * 64 + qt * 32;
        const size_t qrow = (size_t)b * SEQ + (size_t)qb * 128 + qo + r32;
        bf16x8 Qf[4];
#pragma unroll
        for (int ks = 0; ks < 4; ++ks) Qf[ks] = *(const bf16x8*)(BIG + qrow * NW + C_AQ + head * 64 + ks * 16 + 8 * hh);
        f32x16 sc[5];
        const int T0 = qo >> 5;
#pragma unroll
        for (int kt = 0; kt < 5; ++kt) {
            f32x16 acc;
#pragma unroll
            for (int r = 0; r < 16; ++r) acc[r] = 0.f;
            const LAS bf16_t* kp = Kl + ((T0 + kt) * 32 + r32) * 72 + 8 * hh;
#pragma unroll
            for (int ks = 0; ks < 4; ++ks) acc = __builtin_amdgcn_mfma_f32_32x32x16_bf16(*(const LAS bf16x8*)(kp + ks * 16), Qf[ks], acc, 0, 0, 0);
            const int dbase = 128 - 32 * kt + r32 - 4 * hh;
            const LAS float* bt = btl + g * 128;
            if (qb == 0 && T0 + kt < 4) {
#pragma unroll
                for (int r = 0; r < 16; ++r) sc[kt][r] = -INFINITY;
            } else if (kt >= 1 && kt <= 3) {
#pragma unroll
                for (int r = 0; r < 16; ++r) sc[kt][r] = acc[r] * (0.125f * L2E) + bt[dbase - ((r & 3) + 8 * (r >> 2))];
            } else {
#pragma unroll
                for (int r = 0; r < 16; ++r) { const int dist = dbase - ((r & 3) + 8 * (r >> 2)); const bool valid = (dist >= 0) && (dist < 128);
                    const int dcl = dist < 0 ? 0 : (dist > 127 ? 127 : dist);
                    sc[kt][r] = valid ? acc[r] * (0.125f * L2E) + bt[dcl] : -INFINITY; }
            }
        }
        float mx = sink2;
#pragma unroll
        for (int kt = 0; kt < 5; ++kt)
#pragma unroll
            for (int r = 0; r < 16; ++r) mx = fmaxf(mx, sc[kt][r]);
        mx = fmaxf(mx, __shfl_xor(mx, 32));
        float lsum = 0.f;
        f32x16 O0, O1;
#pragma unroll
        for (int r = 0; r < 16; ++r) { O0[r] = 0.f; O1[r] = 0.f; }
#pragma unroll
        for (int kt = 0; kt < 5; ++kt) {
            float p[16];
#pragma unroll
            for (int r = 0; r < 16; ++r) { p[r] = __builtin_amdgcn_exp2f(sc[kt][r] - mx); lsum += p[r]; }
#pragma unroll
            for (int s2 = 0; s2 < 2; ++s2) {
                u32x4 pw; pw.x = pk2(p[8 * s2], p[8 * s2 + 1]); pw.y = pk2(p[8 * s2 + 2], p[8 * s2 + 3]); pw.z = pk2(p[8 * s2 + 4], p[8 * s2 + 5]); pw.w = pk2(p[8 * s2 + 6], p[8 * s2 + 7]);
                const bf16x8 pf = __builtin_bit_cast(bf16x8, pw);
                const int kb = (T0 + kt) * 32 + 16 * s2 + 4 * hh;
                const LAS bf16_t* v0 = VTl + r32 * 260 + kb; const LAS bf16_t* v1 = v0 + 32 * 260;
                const s16x4 a0 = *(const LAS s16x4*)v0, a1 = *(const LAS s16x4*)(v0 + 8), b0 = *(const LAS s16x4*)v1, b1 = *(const LAS s16x4*)(v1 + 8);
                const bf16x8 vf0 = (bf16x8){a0[0], a0[1], a0[2], a0[3], a1[0], a1[1], a1[2], a1[3]}, vf1 = (bf16x8){b0[0], b0[1], b0[2], b0[3], b1[0], b1[1], b1[2], b1[3]};
                O0 = __builtin_amdgcn_mfma_f32_32x32x16_bf16(vf0, pf, O0, 0, 0, 0);
                O1 = __builtin_amdgcn_mfma_f32_32x32x16_bf16(vf1, pf, O1, 0, 0, 0);
            }
        }
        lsum += __shfl_xor(lsum, 32);
        lsum += __builtin_amdgcn_exp2f(sink2 - mx);
        const float inv = 1.0f / lsum;
        const float is8 = inv * ACT_S; unsigned char* op = ATT8 + qrow * D + head * 64 + 4 * hh;
#pragma unroll
        for (int gq = 0; gq < 4; ++gq) { *(unsigned*)(op + 8 * gq) = pk4_fp8(O0[4 * gq] * is8, O0[4 * gq + 1] * is8, O0[4 * gq + 2] * is8, O0[4 * gq + 3] * is8);
            *(unsigned*)(op + 32 + 8 * gq) = pk4_fp8(O1[4 * gq] * is8, O1[4 * gq + 1] * is8, O1[4 * gq + 2] * is8, O1[4 * gq + 3] * is8); }
    }
}
__device__ __forceinline__ void p4_attention(const Ctx& X, CArgs& a, int wi, int nwk) {
#ifndef NO_MFMA_ATT
    for (int u = ATT_P3 + wi; u < BATCH * KVH * (SEQ / 128); u += nwk) { const int qb = u & 31, kvh = (u >> 5) & 7, b = u >> 8; att_prompt_unit(X, a, b, kvh, qb); }
#endif
    __syncthreads();

}


__device__ __forceinline__ bf16x8 cvt8(const f32x4 x, const f32x4 y) { u32x4 p; p.x = pk2(x[0], x[1]); p.y = pk2(x[2], x[3]); p.z = pk2(y[0], y[1]); p.w = pk2(y[2], y[3]); return __builtin_bit_cast(bf16x8, p); }
__device__ __forceinline__ void att_sample_wave(const Ctx& X, CArgs& a, int b, int kvh, const LAS float* btab  ) {
    unsigned char* ws = a.ws; const bf16_t* BIG = (const bf16_t*)(ws + WS_BIG); unsigned char* ATT8 = ws + WS_ATT8;
    const int lane = X.lane, r32 = lane & 31, hh = lane >> 5;
    constexpr float L2E = 1.4426950408889634f;
    const int g = r32 >> 3, t = r32 & 7, head = kvh * 4 + g;
    const size_t qrow = (size_t)MP + b * 8 + t;
    const float sink2 = a.in[19][head] * L2E;
    const char* ckb = (const char*)(a.in[4] + (((size_t)b * 128) * KVH + kvh) * HD);
    const char* cvb = (const char*)(a.in[5] + (((size_t)b * 128) * KVH + kvh) * HD);
    const char* nkb = (const char*)(BIG + ((size_t)MP + b * 8) * NW + C_AK + kvh * 64);
    const char* nvb = (const char*)(BIG + ((size_t)MP + b * 8) * NW + C_AV + kvh * 64);
    const unsigned loK = (unsigned)(r32 * 2048 + hh * 32), loV = (unsigned)(hh * 4 * 2048 + r32 * 4), loNK = (unsigned)((r32 & 7) * NW * 2 + hh * 16), loNV = (unsigned)(r32 * 2);
    bf16x8 Qf[4];
#pragma unroll
    for (int ks = 0; ks < 4; ++ks) Qf[ks] = *(const bf16x8*)(BIG + qrow * NW + C_AQ + head * 64 + ks * 16 + 8 * hh);
    f32x16 sc[5];
#pragma unroll
    for (int kt = 0; kt < 5; ++kt) {
        f32x16 acc;
#pragma unroll
        for (int r = 0; r < 16; ++r) acc[r] = 0.f;
#pragma unroll
        for (int ks = 0; ks < 4; ++ks) {
            bf16x8 kf;
            if (kt < 4) { const char* kp = ckb + (size_t)kt * 32 * 2048 + ks * 64; kf = cvt8(*(const f32x4*)(kp + loK), *(const f32x4*)(kp + loK + 16)); }
            else { u32x4 z = (u32x4){0u, 0u, 0u, 0u}; if (r32 < 8) z = *(const u32x4*)(nkb + ks * 32 + loNK); kf = __builtin_bit_cast(bf16x8, z); }
            acc = __builtin_amdgcn_mfma_f32_32x32x16_bf16(kf, Qf[ks], acc, 0, 0, 0);
        }
#pragma unroll
        for (int r = 0; r < 16; ++r) { const int jj = kt * 32 + (r & 3) + 8 * (r >> 2) + 4 * hh; const int dist = t + 128 - jj; const bool valid = (dist >= 0) && (dist < 128);
            const int dcl = dist < 0 ? 0 : (dist > 127 ? 127 : dist);
            sc[kt][r] = valid ? acc[r] * (0.125f * L2E) + btab[head * 128 + dcl] : -INFINITY; }
        asm volatile("" ::: "memory");
    }
    float mx = sink2;
#pragma unroll
    for (int kt = 0; kt < 5; ++kt)
#pragma unroll
        for (int r = 0; r < 16; ++r) mx = fmaxf(mx, sc[kt][r]);
    mx = fmaxf(mx, __shfl_xor(mx, 32));
    float lsum = 0.f; f32x16 O0, O1;
#pragma unroll
    for (int r = 0; r < 16; ++r) { O0[r] = 0.f; O1[r] = 0.f; }
#pragma unroll
    for (int kt = 0; kt < 5; ++kt) {
        float p[16];
#pragma unroll
        for (int r = 0; r < 16; ++r) { p[r] = __builtin_amdgcn_exp2f(sc[kt][r] - mx); lsum += p[r]; }
#pragma unroll
        for (int s2 = 0; s2 < 2; ++s2) {
            if (kt == 4 && s2 == 1) continue;
            u32x4 pw; pw.x = pk2(p[8 * s2], p[8 * s2 + 1]); pw.y = pk2(p[8 * s2 + 2], p[8 * s2 + 3]); pw.z = pk2(p[8 * s2 + 4], p[8 * s2 + 5]); pw.w = pk2(p[8 * s2 + 6], p[8 * s2 + 7]);
            const bf16x8 pf = __builtin_bit_cast(bf16x8, pw);
            float v0[8], v1[8];
#pragma unroll
            for (int e = 0; e < 8; ++e) { const int ju = kt * 32 + 16 * s2 + 8 * (e >> 2) + (e & 3);
                if (kt < 4) { const char* vp = cvb + (size_t)ju * 2048; v0[e] = *(const float*)(vp + loV); v1[e] = *(const float*)(vp + loV + 128); }
                else if (ju < 136) { const char* vp = nvb + (size_t)(ju - 128) * NW * 2;
                    v0[e] = bf2f(*(const bf16_t*)(vp + (size_t)hh * 4 * NW * 2 + loNV)); v1[e] = bf2f(*(const bf16_t*)(vp + (size_t)hh * 4 * NW * 2 + loNV + 64)); }
                else { v0[e] = 0.f; v1[e] = 0.f; } }
            u32x4 a0, a1; a0.x = pk2(v0[0], v0[1]); a0.y = pk2(v0[2], v0[3]); a0.z = pk2(v0[4], v0[5]); a0.w = pk2(v0[6], v0[7]); a1.x = pk2(v1[0], v1[1]); a1.y = pk2(v1[2], v1[3]); a1.z = pk2(v1[4], v1[5]); a1.w = pk2(v1[6], v1[7]);
            O0 = __builtin_amdgcn_mfma_f32_32x32x16_bf16(__builtin_bit_cast(bf16x8, a0), pf, O0, 0, 0, 0);
            O1 = __builtin_amdgcn_mfma_f32_32x32x16_bf16(__builtin_bit_cast(bf16x8, a1), pf, O1, 0, 0, 0);
            asm volatile("" ::: "memory");
        }
    }
    lsum += __shfl_xor(lsum, 32);
    lsum += __builtin_amdgcn_exp2f(sink2 - mx);
    const float inv = 1.0f / lsum;
    const float is8 = inv * ACT_S; unsigned char* op = ATT8 + qrow * D + head * 64 + 4 * hh;
#pragma unroll
    for (int gq = 0; gq < 4; ++gq) { *(unsigned*)(op + 8 * gq) = pk4_fp8(O0[4 * gq] * is8, O0[4 * gq + 1] * is8, O0[4 * gq + 2] * is8, O0[4 * gq + 3] * is8);
        *(unsigned*)(op + 32 + 8 * gq) = pk4_fp8(O1[4 * gq] * is8, O1[4 * gq + 1] * is8, O1[4 * gq + 2] * is8, O1[4 * gq + 3] * is8); }
}
__device__ __forceinline__ void p3_sample_attention(const Ctx& X, CArgs& a, int wi, int nwk) {
    LAS float* btab = (LAS float*)X.lds;
    __syncthreads();
    for (int i = X.tid; i < HEADS * 128; i += NTHREADS) { const int h = i >> 7, d = i & 127; btab[i] = a.in[10][t5_bucket(d) * HEADS + h] * 1.4426950408889634f; }
    __syncthreads();
    const int gw = wi * NWAVES + X.wave, NGW = nwk * NWAVES;
    for (int u = gw; u < DEC_BATCH * KVH; u += NGW) att_sample_wave(X, a, u >> 3, u & 7, btab);
    __syncthreads();
}

__device__ __forceinline__ void p3_state_copies(const Ctx& X, CArgs& a, int wi, int nwk) {
    const bf16_t* BIG = (const bf16_t*)(a.ws + WS_BIG); float* out = a.out;
    const int gt = wi * NTHREADS + X.tid, GT = nwk * NTHREADS;
    auto bf4 = [](const bf16_t* p) { const u32x2 w = *(const u32x2*)p; return (f32x4){bflo(w.x), bfhi(w.x), bflo(w.y), bfhi(w.y)}; };
    for (int i = gt; i < 4 * 128 * 128; i += GT) { const int c4 = (i & 127) * 4, w = (i >> 7) & 127, b = i >> 14; const size_t r = (size_t)b * SEQ + (SEQ - 128) + w; const size_t o = ((size_t)(b * 128 + w)) * 512 + c4;
        *(f32x4*)(out + O_KWP + o) = bf4(BIG + r * NW + C_AK + c4); *(f32x4*)(out + O_VWP + o) = bf4(BIG + r * NW + C_AV + c4); }
    for (int i = gt; i < 128 * 128 * 128; i += GT) { const int c4 = (i & 127) * 4, w = (i >> 7) & 127, b = i >> 14; const size_t o = ((size_t)(b * 128 + w)) * 512 + c4;
        if (w < 120) { const size_t sidx = ((size_t)b * 128 + w + 8) * 512 + c4; __builtin_nontemporal_store(__builtin_nontemporal_load((const f32x4*)(a.in[4] + sidx)), (f32x4*)(out + O_KWS + o)); __builtin_nontemporal_store(__builtin_nontemporal_load((const f32x4*)(a.in[5] + sidx)), (f32x4*)(out + O_VWS + o)); }
        else { const size_t r = (size_t)MP + b * 8 + (w - 120); *(f32x4*)(out + O_KWS + o) = bf4(BIG + r * NW + C_AK + c4); *(f32x4*)(out + O_VWS + o) = bf4(BIG + r * NW + C_AV + c4); } }
    for (int i = gt; i < 4 * 3 * 512; i += GT) { const int c4 = (i & 511) * 4, j = (i >> 9) % 3, b = i / (3 * 512); *(f32x4*)(out + O_CONVP + ((size_t)(b * 3 + j)) * 2048 + c4) = bf4(BIG + ((size_t)b * SEQ + SEQ - 3 + j) * NW + C_MQK + c4); }
    for (int i = gt; i < 128 * 3 * 512; i += GT) { const int c4 = (i & 511) * 4, j = (i >> 9) % 3, b = i / (3 * 512); *(f32x4*)(out + O_CONVS + ((size_t)(b * 3 + j)) * 2048 + c4) = bf4(BIG + ((size_t)MP + b * 8 + 5 + j) * NW + C_MQK + c4); }
}

__device__ __forceinline__ void mlstm_unit(const Ctx& X, CArgs& a, size_t row0, int T, int h, int vs,
                                           const float* C0, const float* n0, const float* m0p, const float* convbuf  ,
                                           float* Cout, float* nout, float* mout) {
    unsigned char* ws = a.ws;
    const bf16_t* BIG = (const bf16_t*)(ws + WS_BIG); const float* MIF = (const float*)(ws + WS_MIF); bf16_t* HRAW = (bf16_t*)(ws + WS_HMO);
    LAS float* qk = (LAS float*)X.lds;
    LAS float* red = qk + 512;
    LAS float* nred = red + 512;
    const int tid = X.tid, g = tid >> 6, dv = tid & 63;
    const int ch = tid < 256 ? h * 256 + tid : 1024 + h * 256 + (tid - 256);
    const float w0 = a.in[16][ch], w1 = a.in[16][2048 + ch], w2 = a.in[16][4096 + ch], w3 = a.in[16][6144 + ch], cb = a.in[17][ch];
    float x1 = 0.f, x2 = 0.f, x3 = 0.f;
    if (convbuf) { x3 = convbuf[ch]; x2 = convbuf[2048 + ch]; x1 = convbuf[4096 + ch]; }
    float C[32], nn = 0.f, mprev = 0.f;
#pragma unroll
    for (int j = 0; j < 32; ++j) C[j] = C0 ? C0[(size_t)(32 * g + j) * DV + vs * 64 + dv] : 0.f;
    if (n0 && tid < 256) nn = n0[tid];
    if (m0p) mprev = m0p[0];
    for (int t0 = 0; t0 < T; t0 += 8) {
        float xin[8], vin[8], ig_[8], lf_[8];
#pragma unroll
        for (int u = 0; u < 8; ++u) { const size_t r = row0 + t0 + u;
            xin[u] = bf2f(BIG[r * NW + C_MQK + ch]); vin[u] = bf2f(BIG[r * NW + C_MV + h * DV + vs * 64 + dv]);
            ig_[u] = MIF[r * 8 + h]; lf_[u] = MIF[r * 8 + 4 + h]; }
#pragma unroll
        for (int u = 0; u < 8; ++u) {
            const float x0 = xin[u];
            float y = cb + x3 * w0; y = y + x2 * w1; y = y + x1 * w2; y = y + x0 * w3;
            x3 = x2; x2 = x1; x1 = x0;
            float sv = y / (1.0f + expf(-y));
            if (tid >= 256) sv *= 0.0625f;
            qk[tid] = sv;
            __syncthreads();
            const float mnew = fmaxf(lf_[u] + mprev, ig_[u]);
            const float fg = expf(lf_[u] + mprev - mnew), ig = expf(ig_[u] - mnew);
            const float iv = ig * vin[u];
            float ph = 0.f;
#pragma unroll
            for (int j = 0; j < 32; ++j) { const float kk = qk[256 + 32 * g + j], qq = qk[32 * g + j]; C[j] = fg * C[j] + kk * iv; ph += qq * C[j]; }
            red[g * 64 + dv] = ph;
            if (tid < 256) { nn = fg * nn + ig * qk[256 + tid]; float pn = qk[tid] * nn; pn = wave_sum(pn); if (X.lane == 0) nred[X.wave] = pn; }
            __syncthreads();
            if (tid < 64) { float hs = 0.f;
#pragma unroll
                for (int gg = 0; gg < 8; ++gg) hs += red[gg * 64 + tid];
                const float qn = (nred[0] + nred[1]) + (nred[2] + nred[3]);
                const float den = fmaxf(fabsf(qn), expf(-mnew));
                HRAW[(row0 + t0 + u) * D + h * DV + vs * 64 + tid] = (bf16_t)f2bf(hs / den); }
            mprev = mnew;
        }
    }
#pragma unroll
    for (int j = 0; j < 32; ++j) Cout[(size_t)(32 * g + j) * DV + vs * 64 + dv] = C[j];
    if (vs == 0) { if (tid < 256) nout[tid] = nn; if (tid == 0) mout[0] = mprev; }
    __syncthreads();
}
__device__ __forceinline__ void p3_mlstm(const Ctx& X, CArgs& a) {
    float* out = a.out;
    constexpr int NPU = BATCH * MLH * 8, NSU = DEC_BATCH * MLH * 8;
    for (int u = X.vcu; u < NPU + NSU; u += X.G) {
        if (u < NPU) { const int b = u >> 5, h = (u >> 3) & 3, vs = u & 7;
            mlstm_unit(X, a, (size_t)b * SEQ, SEQ, h, vs, nullptr, nullptr, nullptr, nullptr,
                       out + O_CP + (size_t)(b * MLH + h) * DK * DV, out + O_NP + (size_t)(b * MLH + h) * DK, out + O_MPO + b * MLH + h); }
        else { const int v = u - NPU, b = v >> 5, h = (v >> 3) & 3, vs = v & 7; const size_t bh = (size_t)b * MLH + h;
            mlstm_unit(X, a, (size_t)MP + b * 8, 8, h, vs, a.in[7] + bh * DK * DV, a.in[8] + bh * DK, a.in[9] + bh, a.in[6] + (size_t)b * 3 * 2048,
                       out + O_CS + bh * DK * DV, out + O_NS + bh * DK, out + O_MSO + bh); }
    }
}

__device__ __forceinline__ void p2_gates(const Ctx& X, CArgs& a, int bh) {
    unsigned char* ws = a.ws; const float* MIF = (const float*)(ws + WS_MIF); float* MG = (float*)(ws + WS_MG);
    LAS float* li = (LAS float*)X.lds; LAS float* lf = li + 64 * 65; LAS float* lbc = lf + 64 * 65; LAS float* lrm = lbc + 64 * 65;
    LAS float* lcb = lrm + 64 * 65; LAS float* lcg = lcb + 64; LAS float* lms = lcg + 64;
    const int b = bh >> 2, h = bh & 3, tid = X.tid;
    for (int t = tid; t < SEQ; t += NTHREADS) { const size_t r = (size_t)b * SEQ + t; const int idx = (t >> 6) * 65 + (t & 63); li[idx] = MIF[r * 8 + h]; lf[idx] = MIF[r * 8 + 4 + h]; }
    __syncthreads();
    if (tid < 64) { float bc = 0.f, rm = -3.0e38f;
        for (int t = 0; t < 64; ++t) { const int idx = tid * 65 + t; bc += lf[idx]; const float g = li[idx] - bc; rm = fmaxf(rm, g); lbc[idx] = bc; lrm[idx] = rm; }
        lcb[tid] = bc; lcg[tid] = rm; }
    __syncthreads();
    if (tid == 0) { float m = 0.f; lms[0] = 0.f; for (int c = 0; c < 64; ++c) { m = lcb[c] + fmaxf(m, lcg[c]); lms[c + 1] = m; } }
    __syncthreads();
    for (int t = tid; t < SEQ; t += NTHREADS) { const int c = t >> 6, idx = c * 65 + (t & 63); const float mprev = lms[c], mc = lms[c + 1], bc = lbc[idx], iv = li[idx];
        const float mt = bc + fmaxf(mprev, lrm[idx]); const size_t o = (size_t)bh * SEQ + t;
        MG[MG_A1 + o] = bc - mt; MG[MG_G + o] = iv - bc; MG[MG_WIN + o] = expf(bc + mprev - mt); MG[MG_EMI + o] = expf(-mt); MG[MG_WK + o] = expf(lcb[c] - bc + iv - mc); }
    if (tid < 64) MG[MG_DEC + bh * 64 + tid] = expf(lcb[tid] + lms[tid] - lms[tid + 1]);
    if (tid == 0) a.out[O_MPO + bh] = lms[64];
    __syncthreads();
}

__device__ __forceinline__ void m1_prep_unit(const Ctx& X, CArgs& a, int bh, int c) {
    unsigned char* ws = a.ws; const bf16_t* BIG = (const bf16_t*)(ws + WS_BIG); const float* MG = (const float*)(ws + WS_MG);
    bf16_t* QC = (bf16_t*)(ws + WS_QC); bf16_t* KWT = (bf16_t*)(ws + WS_KWT); bf16_t* VT = (bf16_t*)(ws + WS_VT); bf16_t* SM = (bf16_t*)(ws + WS_SM);
    LAS bf16_t* qs = (LAS bf16_t*)X.lds; LAS bf16_t* ksl = qs + 64 * 264;
    LAS bf16_t* vl = (LAS bf16_t*)X.lds;
    LAS float* wkl = (LAS float*)(X.lds + 2 * 64 * 264 * 2);
    LAS float* rsl = wkl + 64;
    LAS float* a1l = rsl + 64; LAS float* gl = a1l + 64;
    float* MGw = (float*)(ws + WS_MG);
    const int b = bh >> 2, h = bh & 3, tid = X.tid, lane = X.lane, w = X.wave, fr = lane & 15, fq = lane >> 4;
    const size_t row0 = (size_t)b * SEQ + c * 64;
    if (tid < 64) { const size_t o_ = (size_t)bh * SEQ + c * 64 + tid; wkl[tid] = MG[MG_WK + o_]; rsl[tid] = 0.f; a1l[tid] = MG[MG_A1 + o_]; gl[tid] = MG[MG_G + o_]; }
    {
        const int cg = tid & 63, ts = tid >> 6;
        const int ch0 = cg < 32 ? h * 256 + cg * 8 : 1024 + h * 256 + (cg - 32) * 8;
        const int t0 = ts * 8;
        u32x4 xr[11];
#pragma unroll
        for (int i = 0; i < 11; ++i) { const int t = t0 - 3 + i; xr[i] = (u32x4){0u, 0u, 0u, 0u};
            if (t >= 0 || c > 0) xr[i] = *(const u32x4*)(BIG + (size_t)((long)row0 + t) * NW + C_MQK + ch0); }
        const float kscale = cg < 32 ? 1.0f : 0.0625f;
        LAS bf16_t* dstb = (cg < 32 ? qs : ksl) + (cg & 31) * 8;
#pragma unroll
        for (int jp = 0; jp < 4; ++jp) {
            const f32x2 w0 = *(const f32x2*)(a.in[16] + ch0 + 2 * jp), w1 = *(const f32x2*)(a.in[16] + 2048 + ch0 + 2 * jp), w2 = *(const f32x2*)(a.in[16] + 4096 + ch0 + 2 * jp), w3 = *(const f32x2*)(a.in[16] + 6144 + ch0 + 2 * jp), cb = *(const f32x2*)(a.in[17] + ch0 + 2 * jp);
#pragma unroll
            for (int u = 0; u < 8; ++u) { const unsigned a0 = xr[u][jp], a1 = xr[u + 1][jp], a2 = xr[u + 2][jp], a3 = xr[u + 3][jp];
                float ylo = cb.x + bflo(a0) * w0.x; ylo = ylo + bflo(a1) * w1.x; ylo = ylo + bflo(a2) * w2.x; ylo = ylo + bflo(a3) * w3.x;
                float yhi = cb.y + bfhi(a0) * w0.y; yhi = yhi + bfhi(a1) * w1.y; yhi = yhi + bfhi(a2) * w2.y; yhi = yhi + bfhi(a3) * w3.y;
                *(LAS unsigned*)(dstb + (t0 + u) * 264 + 2 * jp) = pk2(ylo * __builtin_amdgcn_rcpf(1.0f + __expf(-ylo)) * kscale, yhi * __builtin_amdgcn_rcpf(1.0f + __expf(-yhi)) * kscale); }
            asm volatile("" ::: "memory"); }
    }
    __syncthreads();
    if (tid < 256) { float ac = 0.f;
#pragma unroll 8
        for (int s2 = 0; s2 < 64; ++s2) ac += bf2f(ksl[s2 * 264 + tid]) * wkl[s2];
        MGw[MG_AC + ((size_t)bh * 64 + c) * 256 + tid] = ac; }
#pragma unroll
    for (int i = 0; i < 4; ++i) { const int id = i * NTHREADS + tid, t = id >> 5, seg = id & 31;
        *(u32x4*)(QC + (row0 + t) * 1024 + h * 256 + seg * 8) = *(const LAS u32x4*)(qs + t * 264 + seg * 8); }
#pragma unroll
    for (int i = 0; i < 4; ++i) { const int id = i * NTHREADS + tid, dk = id & 255, tg = id >> 8;
        const f32x4 wa = *(const LAS f32x4*)(wkl + tg * 8), wb = *(const LAS f32x4*)(wkl + tg * 8 + 4);
        float v[8];
#pragma unroll
        for (int j = 0; j < 8; ++j) v[j] = bf2f(ksl[(tg * 8 + j) * 264 + dk]);
        u32x4 o; o.x = pk2(v[0] * wa[0], v[1] * wa[1]); o.y = pk2(v[2] * wa[2], v[3] * wa[3]); o.z = pk2(v[4] * wb[0], v[5] * wb[1]); o.w = pk2(v[6] * wb[2], v[7] * wb[3]);
        *(u32x4*)(KWT + ((((size_t)bh * 64 + c) * 8 + tg) * 256 + dk) * 8) = o; }
    u32x4 vpre[8];
#pragma unroll
    for (int i = 0; i < 8; ++i) { const int id = i * NTHREADS + tid, t = id >> 6, seg = id & 63; vpre[i] = *(const u32x4*)(BIG + (row0 + t) * NW + C_MV + h * DV + seg * 8); }
    {
        const int tm = w & 3, sp = w >> 2;
        f32x4 acc[2]; acc[0] = (f32x4){0.f, 0.f, 0.f, 0.f}; acc[1] = acc[0]; float rsum[4] = {0.f, 0.f, 0.f, 0.f};
#pragma unroll
        for (int ks = 0; ks < 8; ++ks) { const bf16x8 af = *(const LAS bf16x8*)(qs + (tm * 16 + fr) * 264 + ks * 32 + 8 * fq);
#pragma unroll
            for (int j = 0; j < 2; ++j) { const bf16x8 bf = *(const LAS bf16x8*)(ksl + ((2 * sp + j) * 16 + fr) * 264 + ks * 32 + 8 * fq); acc[j] = __builtin_amdgcn_mfma_f32_16x16x32_bf16(af, bf, acc[j], 0, 0, 0); } }
        const float* A1 = MG + MG_A1 + (size_t)bh * SEQ + c * 64; const float* Gp = MG + MG_G + (size_t)bh * SEQ + c * 64;
#pragma unroll
        for (int j = 0; j < 2; ++j) { const int sidx = (2 * sp + j) * 16 + fr; const float gs = gl[sidx];
#pragma unroll
            for (int e = 0; e < 4; ++e) { const int t = tm * 16 + 4 * fq + e; const float val = (sidx <= t) ? acc[j][e] * __expf(a1l[t] + gs) : 0.f; const bf16_t vb = (bf16_t)f2bf(val);
                SM[((((size_t)bh * 64 + c) * 8 + (sidx >> 3)) * 64 + t) * 8 + (sidx & 7)] = vb; rsum[e] += bf2f(vb); } }
#pragma unroll
        for (int e = 0; e < 4; ++e) { const float r16 = row_sum16(rsum[e]); if (fr == 0) atomicAdd((float*)(rsl + tm * 16 + 4 * fq + e), r16); }
    }
    __syncthreads();
    if (tid < 64) MGw[MG_RS + (size_t)bh * SEQ + c * 64 + tid] = rsl[tid];
    __syncthreads();
#pragma unroll
    for (int i = 0; i < 8; ++i) { const int id = i * NTHREADS + tid, t = id >> 6, seg = id & 63; *(LAS u32x4*)(vl + t * 520 + seg * 8) = vpre[i]; }
    __syncthreads();
#pragma unroll
    for (int i = 0; i < 8; ++i) { const int id = i * NTHREADS + tid, tg = id & 7, dv = id >> 3; unsigned short v[8];
#pragma unroll
        for (int j = 0; j < 8; ++j) v[j] = vl[(tg * 8 + j) * 520 + dv];
        u32x4 o; o.x = v[0] | ((unsigned)v[1] << 16); o.y = v[2] | ((unsigned)v[3] << 16); o.z = v[4] | ((unsigned)v[5] << 16); o.w = v[6] | ((unsigned)v[7] << 16);
        *(u32x4*)(VT + ((size_t)bh * DV + dv) * SEQ + c * 64 + tg * 8) = o; }
    __syncthreads();
}

__device__ __forceinline__ void m1_sample_unit(const Ctx& X, CArgs& a, int bh) {
    unsigned char* ws = a.ws; const bf16_t* BIG = (const bf16_t*)(ws + WS_BIG); const float* MIF = (const float*)(ws + WS_MIF); bf16_t* HRAW = (bf16_t*)(ws + WS_HMO);
    LAS float* QT = (LAS float*)X.lds;
    LAS float* KT = QT + 2048;
    LAS float* gsm = KT + 2048;
    LAS float* Sm = gsm + 96;
    LAS float* hred = Sm + 64;
    const int b = bh >> 2, h = bh & 3, tid = X.tid, lane = X.lane, w = X.wave;
    const size_t row0 = (size_t)MP + b * 8;
    const float* C0 = a.in[7] + (size_t)bh * DK * DV; float* Cout = a.out + O_CS + (size_t)bh * DK * DV;
    if (tid == 0) { const float m0 = a.in[9][bh]; float bc = 0.f, rm = -3.0e38f;
        for (int t = 0; t < 8; ++t) { const float iv = MIF[(row0 + t) * 8 + h], fv = MIF[(row0 + t) * 8 + 4 + h]; bc += fv; rm = fmaxf(rm, iv - bc); const float mt = bc + fmaxf(m0, rm);
            gsm[t] = bc; gsm[8 + t] = iv; gsm[16 + t] = mt; gsm[24 + t] = expf(bc + m0 - mt); gsm[32 + t] = expf(-mt); }
        const float mnew = bc + fmaxf(m0, rm);
        for (int t = 0; t < 8; ++t) gsm[40 + t] = expf(bc - gsm[t] + gsm[8 + t] - mnew);
        gsm[88] = expf(bc + m0 - mnew); gsm[89] = mnew; a.out[O_MSO + bh] = mnew; }
    {
        const int ch = tid < 256 ? h * 256 + tid : 1024 + h * 256 + (tid - 256);
        const float w0 = a.in[16][ch], w1 = a.in[16][2048 + ch], w2 = a.in[16][4096 + ch], w3 = a.in[16][6144 + ch], cb = a.in[17][ch];
        const float* cbuf = a.in[6] + (size_t)b * 3 * 2048; float x3 = cbuf[ch], x2 = cbuf[2048 + ch], x1 = cbuf[4096 + ch];
        float xin[8];
#pragma unroll
        for (int u = 0; u < 8; ++u) xin[u] = bf2f(BIG[(row0 + u) * NW + C_MQK + ch]);
        LAS float* dst = (tid < 256 ? QT : KT) + (tid & 255) * 8;
#pragma unroll
        for (int u = 0; u < 8; ++u) { const float x0 = xin[u]; float y = cb + x3 * w0; y = y + x2 * w1; y = y + x1 * w2; y = y + x0 * w3; x3 = x2; x2 = x1; x1 = x0;
            float sv = y / (1.0f + expf(-y)); if (tid >= 256) sv *= 0.0625f; dst[u] = sv; }
    }
    __syncthreads();
    for (int p = w * 8; p < w * 8 + 8; ++p) { const int t = p >> 3, sidx = p & 7; float d = 0.f;
#pragma unroll
        for (int j = 0; j < 4; ++j) { const int dk = lane + 64 * j; d += QT[dk * 8 + t] * KT[dk * 8 + sidx]; }
        d = wave_sum(d);
        if (lane == 0) Sm[p] = (sidx <= t) ? d * expf(gsm[t] - gsm[sidx] + gsm[8 + sidx] - gsm[16 + t]) : 0.f; }
    { const int t = w; float d = 0.f;
#pragma unroll
      for (int j = 0; j < 4; ++j) { const int dk = lane + 64 * j; d += QT[dk * 8 + t] * a.in[8][(size_t)bh * DK + dk]; }
      d = wave_sum(d); if (lane == 0) gsm[64 + t] = d; }
    __syncthreads();
    if (tid < 8) { float rs = 0.f;
#pragma unroll
        for (int j = 0; j < 8; ++j) rs += Sm[tid * 8 + j];
        const float den = rs + gsm[24 + tid] * gsm[64 + tid]; const float dn = fmaxf(fabsf(den), gsm[32 + tid]); gsm[56 + tid] = 1.0f / dn; gsm[48 + tid] = gsm[24 + tid] / dn; }
    for (int i = tid; i < 2048; i += NTHREADS) KT[i] *= gsm[40 + (i & 7)];
    __syncthreads();
    const float dec = gsm[88];
    if (tid < 256) { float sn = 0.f;
#pragma unroll
        for (int j = 0; j < 8; ++j) sn += KT[tid * 8 + j];
        a.out[O_NS + (size_t)bh * DK + tid] = dec * a.in[8][(size_t)bh * DK + tid] + sn; }
    {
        const int cg = tid & 127, kg = tid >> 7;
        f32x4 vv[8], hacc[8];
#pragma unroll
        for (int t = 0; t < 8; ++t) { const u32x2 wv = *(const u32x2*)(BIG + (row0 + t) * NW + C_MV + h * DV + 4 * cg); vv[t] = (f32x4){bflo(wv.x), bfhi(wv.x), bflo(wv.y), bfhi(wv.y)}; hacc[t] = (f32x4){0.f, 0.f, 0.f, 0.f}; }
#pragma unroll 1
        for (int d0 = 0; d0 < 64; d0 += 8) {
            f32x4 c0[8];
#pragma unroll
            for (int u = 0; u < 8; ++u) c0[u] = __builtin_nontemporal_load((const f32x4*)(C0 + (size_t)(kg * 64 + d0 + u) * DV + 4 * cg));
#pragma unroll
            for (int u = 0; u < 8; ++u) { const int dk = kg * 64 + d0 + u;
                const f32x4 qa = *(const LAS f32x4*)(QT + dk * 8), qb = *(const LAS f32x4*)(QT + dk * 8 + 4), ka = *(const LAS f32x4*)(KT + dk * 8), kb = *(const LAS f32x4*)(KT + dk * 8 + 4);
                f32x4 cn = c0[u] * dec;
#pragma unroll
                for (int t = 0; t < 4; ++t) { hacc[t] = hacc[t] + c0[u] * qa[t]; hacc[4 + t] = hacc[4 + t] + c0[u] * qb[t]; cn = cn + vv[t] * ka[t]; cn = cn + vv[4 + t] * kb[t]; }
                __builtin_nontemporal_store(cn, (f32x4*)(Cout + (size_t)dk * DV + 4 * cg)); asm volatile("" ::: "memory"); }
        }
#pragma unroll
        for (int t = 0; t < 8; ++t) *(LAS f32x4*)(hred + (kg * 8 + t) * 512 + 4 * cg) = hacc[t];
    }
    __syncthreads();
    { const int t = tid >> 6; const float f1 = gsm[48 + t], f2 = gsm[56 + t];
#pragma unroll 1
      for (int j = 0; j < 8; ++j) { const int dv = lane + 64 * j; const float inter = (hred[(0 * 8 + t) * 512 + dv] + hred[(1 * 8 + t) * 512 + dv]) + (hred[(2 * 8 + t) * 512 + dv] + hred[(3 * 8 + t) * 512 + dv]);
          float intra = 0.f;
#pragma unroll
          for (int s2 = 0; s2 < 8; ++s2) intra += Sm[t * 8 + s2] * bf2f(BIG[(row0 + s2) * NW + C_MV + h * DV + dv]);
          HRAW[(row0 + t) * D + h * DV + dv] = (bf16_t)f2bf(intra * f2 + inter * f1); } }
    __syncthreads();
}

__device__ __forceinline__ bf16x8 ldg8(const char* ubase, unsigned loff) { return *(const bf16x8*)(ubase + loff); }
__device__ __forceinline__ void m2_scan_unit(const Ctx& X, CArgs& a, int bh, int vs) {
    unsigned char* ws = a.ws; const float* MG = (const float*)(ws + WS_MG); bf16_t* HRAW = (bf16_t*)(ws + WS_HMO);
    const int b = bh >> 2, h = bh & 3, tid = X.tid, lane = X.lane, w = X.wave, fr = lane & 15, fq = lane >> 4, tm = w & 3, dp = w >> 2;
    LAS bf16_t* CT = (LAS bf16_t*)X.lds;
    LAS unsigned char* stQ = X.lds + 69632;
    LAS unsigned char* stV = X.lds + 69632 + 65536;
    const char* Qg = (const char*)(ws + WS_QC) + (((size_t)b * SEQ) * 1024 + h * 256) * 2;
    const char* Vg = (const char*)(ws + WS_VT) + ((size_t)bh * DV + vs * 64) * SEQ * 2;
    const char* Sb = (const char*)(ws + WS_SM) + ((size_t)bh * 64 * 4096 + tm * 16 * 8) * 2;
    const char* KWb = (const char*)(ws + WS_KWT) + ((size_t)bh * 64 * 16384 + 2 * w * 16 * 8) * 2;
    const unsigned loS = (unsigned)(fq * 1024 + fr * 16), loT = (unsigned)(fq * 4096 + fr * 16);
    const int R0 = 8 * w + (lane >> 5); const unsigned zq = (unsigned)((lane & 31) ^ (R0 & 31));
    const int rs8 = 8 * w + (lane >> 3); const unsigned dv_ = (unsigned)(rs8 * SEQ * 2 + (((lane & 7) ^ ((rs8 >> 1) & 7)) * 16));
#define SCAN_DMA(c_) do { const char* q_ = Qg + (size_t)(c_) * (64 * 2048); const char* v_ = Vg + (size_t)(c_) * 128; const int sb_ = (c_) & 1; \
        _Pragma("unroll") for (int i_ = 0; i_ < 4; ++i_) __builtin_amdgcn_global_load_lds((const unsigned*)(q_ + (unsigned)((R0 + 2 * i_) * 2048) + ((zq ^ (unsigned)(2 * i_)) * 16u)), (LAS unsigned*)(stQ + sb_ * 32768 + (4 * w + i_) * 1024), 16, 0, 0); \
        __builtin_amdgcn_global_load_lds((const unsigned*)(v_ + dv_), (LAS unsigned*)(stV + sb_ * 8192 + w * 1024), 16, 0, 0); } while (0)
    const int rq = tm * 16 + fr;
    const unsigned yq = (unsigned)(fq ^ (rq & 31)), yv = (unsigned)(fq ^ ((fr >> 1) & 7));
    const unsigned bq = (unsigned)(rq * 512), bv = (unsigned)(fr * 128);
    const float* WINp = MG + MG_WIN + (size_t)bh * SEQ + tm * 16 + 4 * fq; const float* DECp = MG + MG_DEC + bh * 64;
    f32x4 Cacc[2][4];
#pragma unroll
    for (int i = 0; i < 2; ++i)
#pragma unroll
        for (int j = 0; j < 4; ++j) Cacc[i][j] = (f32x4){0.f, 0.f, 0.f, 0.f};
    for (int i = tid; i < 64 * 264 / 2; i += NTHREADS) ((LAS unsigned*)CT)[i] = 0u;
    SCAN_DMA(0);
    bf16x8 KWf[2][2], Sf[2];
#pragma unroll
    for (int k2 = 0; k2 < 2; ++k2) { Sf[k2] = ldg8(Sb + k2 * 4096, loS);
#pragma unroll
        for (int i = 0; i < 2; ++i) KWf[i][k2] = ldg8(KWb + i * 256 + k2 * 16384, loT); }
    f32x4 win4 = *(const f32x4*)WINp; float dec = DECp[0];
    const unsigned ctr0 = (unsigned)(((2 * dp) * 16 + fr) * 264 + 8 * fq), ctw0 = (unsigned)(fr * 264 + 2 * w * 16 + 4 * fq);
    for (int c = 0; c < 64; ++c) {
        asm volatile("s_waitcnt vmcnt(0)" ::: "memory");
        __syncthreads();
        if (c < 63) SCAN_DMA(c + 1);
        const int cur = c & 1; const LAS bf16_t* CTc = CT + cur * 64 * 264; LAS bf16_t* CTn = CT + (cur ^ 1) * 64 * 264;
        const LAS unsigned char* sQ = stQ + cur * 32768 + bq; const LAS unsigned char* sV = stV + cur * 8192 + bv;
        const int cn = c < 63 ? c + 1 : 63;
        f32x4 Hi[2], Ha[2]; Hi[0] = (f32x4){0.f, 0.f, 0.f, 0.f}; Hi[1] = Hi[0]; Ha[0] = Hi[0]; Ha[1] = Hi[0];
#pragma unroll
        for (int ks = 0; ks < 8; ++ks) {
            const bf16x8 qf = *(const LAS bf16x8*)(sQ + (((unsigned)(ks * 4) ^ yq) * 16u));
            const bf16x8 c0 = *(const LAS bf16x8*)(CTc + ctr0 + ks * 32), c1 = *(const LAS bf16x8*)(CTc + ctr0 + 16 * 264 + ks * 32);
            Hi[0] = __builtin_amdgcn_mfma_f32_16x16x32_bf16(qf, c0, Hi[0], 0, 0, 0); Hi[1] = __builtin_amdgcn_mfma_f32_16x16x32_bf16(qf, c1, Hi[1], 0, 0, 0);
            if ((ks & 3) == 3) asm volatile("" ::: "memory");
        }
#pragma unroll
        for (int k2 = 0; k2 < 2; ++k2) { const unsigned sl_ = ((unsigned)(k2 * 4) ^ yv) * 16u;
            const bf16x8 vA = *(const LAS bf16x8*)(sV + (2 * dp) * 2048 + sl_), vB = *(const LAS bf16x8*)(sV + (2 * dp + 1) * 2048 + sl_);
            Ha[0] = __builtin_amdgcn_mfma_f32_16x16x32_bf16(Sf[k2], vA, Ha[0], 0, 0, 0); Ha[1] = __builtin_amdgcn_mfma_f32_16x16x32_bf16(Sf[k2], vB, Ha[1], 0, 0, 0); }
        {
            LAS bf16_t* hst = (LAS bf16_t*)(X.lds + 151552 + w * 1280);
#pragma unroll
            for (int e = 0; e < 4; ++e)
#pragma unroll
                for (int j = 0; j < 2; ++j) hst[(4 * fq + e) * 32 + j * 16 + fr] = (bf16_t)f2bf(Ha[j][e] + Hi[j][e] * win4[e]);
            asm volatile("" ::: "memory");
            const u32x4 hv = *(const LAS u32x4*)(hst + (lane >> 2) * 32 + (lane & 3) * 8);
            *(u32x4*)(HRAW + ((size_t)b * SEQ + c * 64 + tm * 16 + (lane >> 2)) * D + h * DV + vs * 64 + dp * 32 + (lane & 3) * 8) = hv;
        }
#pragma unroll
        for (int j = 0; j < 4; ++j) {
#pragma unroll
            for (int k2 = 0; k2 < 2; ++k2) { const bf16x8 vf = *(const LAS bf16x8*)(sV + j * 2048 + (((unsigned)(k2 * 4) ^ yv) * 16u));
#pragma unroll
                for (int i = 0; i < 2; ++i) { if (k2 == 0) Cacc[i][j] = Cacc[i][j] * dec; Cacc[i][j] = __builtin_amdgcn_mfma_f32_16x16x32_bf16(KWf[i][k2], vf, Cacc[i][j], 0, 0, 0); } } }
#pragma unroll
        for (int i = 0; i < 2; ++i)
#pragma unroll
            for (int j = 0; j < 4; ++j) { u32x2 pw; pw.x = pk2(Cacc[i][j][0], Cacc[i][j][1]); pw.y = pk2(Cacc[i][j][2], Cacc[i][j][3]);
                *(LAS u32x2*)(CTn + ctw0 + j * 16 * 264 + i * 16) = pw; }
        { const char* kn_ = KWb + (size_t)cn * 32768; const char* sn_ = Sb + (size_t)cn * 8192;
#pragma unroll
          for (int k2 = 0; k2 < 2; ++k2) { Sf[k2] = ldg8(sn_ + k2 * 4096, loS);
#pragma unroll
            for (int i = 0; i < 2; ++i) KWf[i][k2] = ldg8(kn_ + i * 256 + k2 * 16384, loT); } }
        win4 = *(const f32x4*)(WINp + cn * 64); dec = DECp[cn];
    }
#undef SCAN_DMA
    __syncthreads();
    float* Cout = a.out + O_CP + (size_t)bh * DK * DV;
#pragma unroll
    for (int i = 0; i < 2; ++i)
#pragma unroll
        for (int j = 0; j < 4; ++j)
#pragma unroll
            for (int e = 0; e < 4; ++e) Cout[(size_t)((2 * w + i) * 16 + 4 * fq + e) * DV + vs * 64 + j * 16 + fr] = Cacc[i][j][e];
    __syncthreads();
}


__device__ __forceinline__ void m2_nchain_unit(const Ctx& X, CArgs& a, int bh) {
    float* MGw = (float*)(a.ws + WS_MG); const int tid = X.tid;
    if (tid < 256) { float n = 0.f;
        for (int c0 = 0; c0 < 64; c0 += 8) { float ac[8], dc[8];
#pragma unroll
            for (int u = 0; u < 8; ++u) { ac[u] = MGw[MG_AC + ((size_t)bh * 64 + c0 + u) * 256 + tid]; dc[u] = MGw[MG_DEC + bh * 64 + c0 + u]; }
#pragma unroll
            for (int u = 0; u < 8; ++u) { MGw[MG_NALL + ((size_t)bh * 64 + c0 + u) * 256 + tid] = n; n = dc[u] * n + ac[u]; } }
        a.out[O_NP + (size_t)bh * DK + tid] = n; }
}

__device__ __forceinline__ void p3_headnorm(const Ctx& X, CArgs& a, int wi, int nwk) {
    unsigned char* ws = a.ws; const bf16_t* HM = (const bf16_t*)(ws + WS_HMO); const bf16_t* BIG = (const bf16_t*)(ws + WS_BIG); const float* MG = (const float*)(ws + WS_MG);
    const int gw = wi * NWAVES + X.wave, NGW = nwk * NWAVES, lane = X.lane;
    for (int m = gw; m < M; m += NGW) {
        u32x4 hw[4], ow[4]; u32x2 qw[4]; f32x4 nv[4]; float rs_[4], wn_[4], em_[4];
        const bool prompt = m < MP; const int t = m & (SEQ - 1), bh0 = (m >> 12) * MLH;
#pragma unroll
        for (int h = 0; h < 4; ++h) { hw[h] = *(const u32x4*)(HM + (size_t)m * D + h * DV + lane * 8); ow[h] = *(const u32x4*)(BIG + (size_t)m * NW + C_MO + h * DV + lane * 8);
            if (prompt) { qw[h] = *(const u32x2*)((const bf16_t*)(ws + WS_QC) + (size_t)m * 1024 + h * 256 + 4 * lane); nv[h] = *(const f32x4*)(MG + MG_NALL + ((size_t)(bh0 + h) * 64 + (t >> 6)) * 256 + 4 * lane);
                const size_t o = (size_t)(bh0 + h) * SEQ + t; rs_[h] = MG[MG_RS + o]; wn_[h] = MG[MG_WIN + o]; em_[h] = MG[MG_EMI + o]; } }
#pragma unroll
        for (int h = 0; h < 4; ++h) {
            float v[8] = { bflo(hw[h].x), bfhi(hw[h].x), bflo(hw[h].y), bfhi(hw[h].y), bflo(hw[h].z), bfhi(hw[h].z), bflo(hw[h].w), bfhi(hw[h].w) };
            if (prompt) {
                const float qn = wave_sum((bflo(qw[h].x) * nv[h][0] + bfhi(qw[h].x) * nv[h][1]) + (bflo(qw[h].y) * nv[h][2] + bfhi(qw[h].y) * nv[h][3]));
                const float den = rs_[h] + wn_[h] * qn; const float inv = 1.0f / fmaxf(fabsf(den), em_[h]);
#pragma unroll
                for (int j = 0; j < 8; ++j) v[j] *= inv; }
            float s = 0.f;
#pragma unroll
            for (int j = 0; j < 8; ++j) s += v[j];
            const float mu = wave_sum(s) * (1.0f / DV); float q = 0.f;
#pragma unroll
            for (int j = 0; j < 8; ++j) { v[j] -= mu; q += v[j] * v[j]; }
            const float rstd = 1.0f / sqrtf(wave_sum(q) * (1.0f / DV) + LN_EPS);
            const float o[8] = { bflo(ow[h].x), bfhi(ow[h].x), bflo(ow[h].y), bfhi(ow[h].y), bflo(ow[h].z), bfhi(ow[h].z), bflo(ow[h].w), bfhi(ow[h].w) };
            const float* gp = a.in[18] + h * DV + lane * 8; const f32x4 g0 = *(const f32x4*)gp, g1 = *(const f32x4*)(gp + 4);
            const float gg[8] = { g0[0], g0[1], g0[2], g0[3], g1[0], g1[1], g1[2], g1[3] }; float r[8];
#pragma unroll
            for (int j = 0; j < 8; ++j) r[j] = v[j] * rstd * gg[j] * o[j];
            u32x2 ww; ww.x = pk4_fp8(r[0] * ACT_S, r[1] * ACT_S, r[2] * ACT_S, r[3] * ACT_S); ww.y = pk4_fp8(r[4] * ACT_S, r[5] * ACT_S, r[6] * ACT_S, r[7] * ACT_S);
            *(u32x2*)(ws + WS_HMO8 + (size_t)m * D + h * DV + lane * 8) = ww; }
    }
}

__device__ __forceinline__ void p6_ln1(const Ctx& X, CArgs& a) {
    unsigned char* ws = a.ws; bf16_t* T = (bf16_t*)(ws + WS_T); const float* ADA = (const float*)(ws + WS_ADA);
    const int gw = X.vcu * NWAVES + X.wave, NGW = X.G * NWAVES, lane = X.lane;
    for (int m = gw; m < M; m += NGW) {
        bf16_t* tr = T + (size_t)m * D; const int b = m < MP ? (m >> 12) : BATCH + ((m - MP) >> 3);
        const float* sh2 = ADA + (size_t)b * 6 * D + 3 * D; const float* sc2 = sh2 + D;
        f32x4 v[8]; float s = 0.f;
#pragma unroll
        for (int j = 0; j < 8; ++j) { const u32x2 tw = *(const u32x2*)(tr + 4 * lane + 256 * j); v[j] = (f32x4){bflo(tw.x), bfhi(tw.x), bflo(tw.y), bfhi(tw.y)}; s += (v[j][0] + v[j][1]) + (v[j][2] + v[j][3]); }
        const float mu = wave_sum(s) * (1.0f / D); float q = 0.f;
#pragma unroll
        for (int j = 0; j < 8; ++j) { v[j] = v[j] - mu; q += (v[j][0] * v[j][0] + v[j][1] * v[j][1]) + (v[j][2] * v[j][2] + v[j][3] * v[j][3]); }
        const float rstd = 1.0f / sqrtf(wave_sum(q) * (1.0f / D) + LN_EPS);
        unsigned* o4 = (unsigned*)(ws + WS_H28 + (size_t)m * D) + lane; float am = 0.f;
#pragma unroll
        for (int j = 0; j < 8; ++j) { const int c = 4 * lane + 256 * j; const f32x4 gg = *(const f32x4*)(a.in[23] + c), bb = *(const f32x4*)(a.in[24] + c);
            const f32x4 x1 = v[j] * rstd * gg + bb; { u32x2 xw; xw.x = pk2(x1[0], x1[1]); xw.y = pk2(x1[2], x1[3]); *(u32x2*)(tr + c) = xw; }
            const f32x4 h2 = x1 * (*(const f32x4*)(sc2 + c) + 1.0f) + *(const f32x4*)(sh2 + c);
            o4[64 * j] = pk4_fp8(h2[0] * ACT_S, h2[1] * ACT_S, h2[2] * ACT_S, h2[3] * ACT_S);
            v[j] = h2; am = fmaxf(am, fmaxf(fmaxf(fabsf(h2[0]), fabsf(h2[1])), fmaxf(fabsf(h2[2]), fabsf(h2[3])))); }
        am = wave_max(am); const float qs = am > 0.f ? 127.0f / am : 1.0f;
        unsigned* oi = (unsigned*)(ws + WS_H2I + (size_t)m * D) + lane;
#pragma unroll
        for (int j = 0; j < 8; ++j) oi[64 * j] = pk4_i8(v[j][0] * qs, v[j][1] * qs, v[j][2] * qs, v[j][3] * qs);
        if (lane == 0) ((float*)(ws + WS_HSC))[m] = am > 0.f ? am / 127.0f : 1.0f;
    }
}

__device__ __forceinline__ unsigned ord_key(float f) { unsigned u = __builtin_bit_cast(unsigned, f); return u ^ ((u >> 31) ? 0xFFFFFFFFu : 0x80000000u); }
__device__ __forceinline__ void p8_topk(const Ctx& X, CArgs& a) {
    unsigned char* ws = a.ws; const bf16_t* QP = (const bf16_t*)(ws + WS_H1); int* EID = (int*)(ws + WS_EID); float* GATE = (float*)(ws + WS_GATE);
    const float* SK = a.in[26];
    LAS float* S = (LAS float*)X.lds;
    LAS unsigned* TK = (LAS unsigned*)(X.lds + 2 * 64 * 129 * 4);
    const int lane = X.lane, w = X.wave, fr = lane & 15, fq = lane >> 4;
    const int p = w & 1, kq = w >> 1;
    constexpr int NTILE = M / 64;
    for (int u = X.vcu; u < NTILE * PH; u += X.G) {
        const int h = u / NTILE, tile = u % NTILE; const int m0 = tile * 64;
        f32x4 acc[4][2];
#pragma unroll
        for (int i = 0; i < 4; ++i) { acc[i][0] = (f32x4){0.f, 0.f, 0.f, 0.f}; acc[i][1] = acc[i][0]; }
#pragma unroll
        for (int ks = 0; ks < 4; ++ks) {
            bf16x8 bfr[2];
#pragma unroll
            for (int nt = 0; nt < 2; ++nt) { const float* kp = SK + (((size_t)(h * 2 + p) * NKEYS) + kq * 32 + nt * 16 + fr) * 128 + ks * 32 + 8 * fq;
                const f32x4 k0 = *(const f32x4*)kp, k1 = *(const f32x4*)(kp + 4);
                u32x4 pk; pk.x = pk2(k0[0], k0[1]); pk.y = pk2(k0[2], k0[3]); pk.z = pk2(k1[0], k1[1]); pk.w = pk2(k1[2], k1[3]); bfr[nt] = __builtin_bit_cast(bf16x8, pk); }
#pragma unroll
            for (int mt = 0; mt < 4; ++mt) { const bf16x8 afr = *(const bf16x8*)(QP + (size_t)(m0 + mt * 16 + fr) * D + h * DQ + p * 128 + ks * 32 + 8 * fq);
#pragma unroll
                for (int nt = 0; nt < 2; ++nt) acc[mt][nt] = __builtin_amdgcn_mfma_f32_16x16x32_bf16(afr, bfr[nt], acc[mt][nt], 0, 0, 0); }
        }
#pragma unroll
        for (int mt = 0; mt < 4; ++mt)
#pragma unroll
            for (int nt = 0; nt < 2; ++nt)
#pragma unroll
                for (int e = 0; e < 4; ++e) S[(p * 64 + mt * 16 + 4 * fq + e) * 129 + kq * 32 + nt * 16 + fr] = acc[mt][nt][e];
        __syncthreads();
        if (X.tid < 128) {
            const int hp = X.tid >> 6, tk = X.tid & 63; const LAS float* row = S + (hp * 64 + tk) * 129;
            unsigned L[16];
#pragma unroll
            for (int j = 0; j < 16; ++j) L[j] = 0u;
            for (int i = 0; i < 128; ++i) { unsigned x = (ord_key(row[i]) & ~127u) | (unsigned)(127 - i);
#pragma unroll
                for (int j = 0; j < 16; ++j) { const unsigned hi = L[j] > x ? L[j] : x, lo = L[j] > x ? x : L[j]; L[j] = hi; x = lo; } }
#pragma unroll
            for (int j = 0; j < 16; ++j) TK[(hp * 64 + tk) * 16 + j] = L[j];
        }
        __syncthreads();
        if (X.tid < 64) {
            const int tk = X.tid; float sa[16], sb[16]; int ia[16], ib[16];
#pragma unroll
            for (int j = 0; j < 16; ++j) { ia[j] = 127 - (int)(TK[tk * 16 + j] & 127u); ib[j] = 127 - (int)(TK[(64 + tk) * 16 + j] & 127u); sa[j] = S[tk * 129 + ia[j]]; sb[j] = S[(64 + tk) * 129 + ib[j]]; }
            unsigned L[16];
#pragma unroll
            for (int j = 0; j < 16; ++j) L[j] = 0u;
#pragma unroll
            for (int i = 0; i < 16; ++i)
#pragma unroll
                for (int j = 0; j < 16; ++j) if ((i + 1) * (j + 1) <= 16) { unsigned x = (ord_key(sa[i] + sb[j]) & ~255u) | (unsigned)(255 - (i * 16 + j));
#pragma unroll
                    for (int q = 0; q < 16; ++q) { const unsigned hi = L[q] > x ? L[q] : x, lo = L[q] > x ? x : L[q]; L[q] = hi; x = lo; } }
            float ts[16]; int eid[16]; float mxs = -3.0e38f;
#pragma unroll
            for (int q = 0; q < 16; ++q) { const int code = 255 - (int)(L[q] & 255u), i = code >> 4, j = code & 15; float va = sa[0], vb = sb[0]; int xa = ia[0], xb = ib[0];
#pragma unroll
                for (int z = 1; z < 16; ++z) { va = (i == z) ? sa[z] : va; xa = (i == z) ? ia[z] : xa; vb = (j == z) ? sb[z] : vb; xb = (j == z) ? ib[z] : xb; }
                ts[q] = va + vb; eid[q] = xa * NKEYS + xb; mxs = fmaxf(mxs, ts[q]); }
            float sum = 0.f;
#pragma unroll
            for (int q = 0; q < 16; ++q) { ts[q] = expf(ts[q] - mxs); sum += ts[q]; }
            const float inv = 1.0f / sum; const size_t o = ((size_t)(m0 + tk) * PH + h) * 16;
#pragma unroll
            for (int q = 0; q < 16; ++q) { EID[o + q] = eid[q]; GATE[o + q] = ts[q] * inv; }
        }
        __syncthreads();
    }
}

template <int N> __device__ __forceinline__ void bitonic_sort_desc(unsigned (&v)[N]) {
#pragma unroll
    for (int k = 2; k <= N; k <<= 1)
#pragma unroll
        for (int j = k >> 1; j > 0; j >>= 1)
#pragma unroll
            for (int i = 0; i < N; ++i) { const int l = i ^ j;
                if (l > i) { const bool up = ((i & k) == 0); const unsigned x = v[i], y = v[l]; const unsigned mx = x > y ? x : y, mn = x > y ? y : x; v[i] = up ? mx : mn; v[l] = up ? mn : mx; } }
}
__device__ __forceinline__ void merge16_xor(unsigned (&v)[16], int dist) {
    unsigned o[16];
#pragma unroll
    for (int j = 0; j < 16; ++j) o[j] = dist == 1 ? (unsigned)__builtin_amdgcn_update_dpp(0, (int)v[j], 0xB1, 0xF, 0xF, true) : (unsigned)__builtin_amdgcn_update_dpp(0, (int)v[j], 0x4E, 0xF, 0xF, true);
#pragma unroll
    for (int j = 0; j < 16; ++j) { const unsigned y = o[15 - j]; v[j] = v[j] > y ? v[j] : y; }
#pragma unroll
    for (int jj = 8; jj > 0; jj >>= 1)
#pragma unroll
        for (int i = 0; i < 16; ++i) { const int l = i ^ jj; if (l > i) { const unsigned x = v[i], y = v[l]; v[i] = x > y ? x : y; v[l] = x > y ? y : x; } }
}
__device__ __forceinline__ float ord_inv(unsigned k) { const unsigned u = (k & 0x80000000u) ? (k ^ 0x80000000u) : ~k; return __builtin_bit_cast(float, u); }
__device__ __forceinline__ void p11_topk2(const Ctx& X, CArgs& a, const pg8::StaticOrder* S) {
    unsigned char* ws = a.ws; const bf16_t* QP = (const bf16_t*)(ws + WS_H1); int* EID = (int*)(ws + WS_EID); float* GATE = (float*)(ws + WS_GATE);
    const bf16_t* SKB = (const bf16_t*)(ws + WS_SKB);
    LAS unsigned* KL = (LAS unsigned*)X.lds;
    LAS unsigned* TK = KL + 128 * 132;
    LAS unsigned char* ptab = (LAS unsigned char*)(TK + 2 * 128 * 16);
    LAS bf16_t* SKL = (LAS bf16_t*)(ptab + 64);
    const int tid = X.tid, lane = X.lane, w = X.wave, fr = lane & 15, fq = lane >> 4;
    if (tid == 0) { int n = 0; for (int i = 0; i < 16; ++i) for (int j = 0; j < 16; ++j) if ((i + 1) * (j + 1) <= 16) ptab[n++] = (unsigned char)((i << 4) | j); for (; n < 64; ++n) ptab[n] = 0xff; }
    constexpr int NT = M / 128;
    auto do_unit = [&](const int h, const int m0) {
        for (int p = 0; p < 2; ++p) {
            __syncthreads();
            {
                bf16x8 af[4];
#pragma unroll
                for (int ks = 0; ks < 4; ++ks) af[ks] = *(const bf16x8*)(QP + (size_t)(m0 + w * 16 + fr) * D + h * DQ + p * 128 + ks * 32 + 8 * fq);
#pragma unroll
                for (int i = 0; i < 4; ++i) { const int id = i * NTHREADS + tid, key = id >> 4, seg = id & 15; *(LAS u32x4*)(SKL + key * 136 + seg * 8) = *(const u32x4*)(SKB + ((size_t)(h * 2 + p) * NKEYS + key) * 128 + seg * 8); }
                __syncthreads();
#pragma unroll
                for (int nt = 0; nt < 8; ++nt) { f32x4 acc = (f32x4){0.f, 0.f, 0.f, 0.f};
#pragma unroll
                    for (int ks = 0; ks < 4; ++ks) { const bf16x8 bf = *(const LAS bf16x8*)(SKL + (nt * 16 + fr) * 136 + ks * 32 + 8 * fq); acc = __builtin_amdgcn_mfma_f32_16x16x32_bf16(af[ks], bf, acc, 0, 0, 0); }
                    const int key = nt * 16 + fr;
#pragma unroll
                    for (int e = 0; e < 4; ++e) KL[(w * 16 + 4 * fq + e) * 132 + key] = (ord_key(acc[e]) & ~127u) | (unsigned)(127 - key); }
            }
            __syncthreads();
            {
                const int t = tid >> 2, qd = tid & 3; unsigned v[32];
#pragma unroll
                for (int q = 0; q < 8; ++q) { const u32x4 x = *(const LAS u32x4*)(KL + t * 132 + qd * 32 + 4 * q); v[4 * q] = x.x; v[4 * q + 1] = x.y; v[4 * q + 2] = x.z; v[4 * q + 3] = x.w; }
                bitonic_sort_desc<32>(v);
                unsigned top[16];
#pragma unroll
                for (int j = 0; j < 16; ++j) top[j] = v[j];
                merge16_xor(top, 1); merge16_xor(top, 2);
                if (qd == 0) {
#pragma unroll
                    for (int q = 0; q < 4; ++q) *(LAS u32x4*)(TK + (p * 128 + t) * 16 + 4 * q) = (u32x4){top[4 * q], top[4 * q + 1], top[4 * q + 2], top[4 * q + 3]}; }
            }
        }
        __syncthreads();
        {
            const int t = tid >> 2, qd = tid & 3; const LAS unsigned* ta = TK + t * 16; const LAS unsigned* tb = TK + (128 + t) * 16;
            unsigned c[16];
#pragma unroll
            for (int n = 0; n < 16; ++n) { const unsigned pr = ptab[4 * n + qd]; unsigned key = 0u;
                if (pr != 0xffu) { const float sa = ord_inv(ta[pr >> 4] & ~127u), sb = ord_inv(tb[pr & 15] & ~127u); key = (ord_key(sa + sb) & ~255u) | (255u - pr); }
                c[n] = key; }
            bitonic_sort_desc<16>(c);
            merge16_xor(c, 1); merge16_xor(c, 2);
            float ts[16]; float mxs = -3.0e38f;
#pragma unroll
            for (int q = 0; q < 16; ++q) { const unsigned pr = 255u - (c[q] & 255u); const float sa = ord_inv(ta[pr >> 4] & ~127u), sb = ord_inv(tb[pr & 15] & ~127u); ts[q] = sa + sb; mxs = fmaxf(mxs, ts[q]); }
            float sum = 0.f;
#pragma unroll
            for (int q = 0; q < 16; ++q) { ts[q] = __expf(ts[q] - mxs); sum += ts[q]; }
            const float inv = 1.0f / sum; const size_t o = ((size_t)(m0 + t) * PH + h) * 16;
#pragma unroll
            for (int q = 0; q < 16; ++q) if ((q >> 2) == qd) { const unsigned pr = 255u - (c[q] & 255u); const int ia = 127 - (int)(ta[pr >> 4] & 127u), ib = 127 - (int)(tb[pr & 15] & 127u);
                EID[o + q] = ia * NKEYS + ib; GATE[o + q] = ts[q] * inv; }
        }
    };
    if (S) { pg8::Unit gu; for (int i = 0; S->next(i, gu); ++i) { do_unit(gu.pn, gu.pm * 256); do_unit(gu.pn, gu.pm * 256 + 128); } }
    else for (int u = X.vcu; u < NT * PH; u += X.G) do_unit(u / NT, (u % NT) * 128);
    __syncthreads();
}

typedef float f32x2v __attribute__((ext_vector_type(2)));
__device__ __forceinline__ float dot_fp8x16(const u32x4 w, const float* h) {
    float d0 = 0.f, d1 = 0.f;
#pragma unroll
    for (int q = 0; q < 4; ++q) { const f32x2v lo = __builtin_amdgcn_cvt_pk_f32_fp8((int)w[q], false), hi = __builtin_amdgcn_cvt_pk_f32_fp8((int)w[q], true);
        d0 += lo.x * h[4 * q] + lo.y * h[4 * q + 1]; d1 += hi.x * h[4 * q + 2] + hi.y * h[4 * q + 3]; }
    return d0 + d1;
}
__device__ __forceinline__ void axpy_fp8x16(const u32x4 w, float c, float* acc) {
#pragma unroll
    for (int q = 0; q < 4; ++q) { const f32x2v lo = __builtin_amdgcn_cvt_pk_f32_fp8((int)w[q], false), hi = __builtin_amdgcn_cvt_pk_f32_fp8((int)w[q], true);
        acc[4 * q] += c * lo.x; acc[4 * q + 1] += c * lo.y; acc[4 * q + 2] += c * hi.x; acc[4 * q + 3] += c * hi.y; }
}
__device__ __forceinline__ void p8_gather(const Ctx& X, CArgs& a) {
    unsigned char* ws = a.ws; const float* X1 = (const float*)(ws + WS_T); const float* ADA = (const float*)(ws + WS_ADA);
    const int* EID = (const int*)(ws + WS_EID); const float* GATE = (const float*)(ws + WS_GATE);
    const unsigned char* U8 = ws + WS_U8; const unsigned char* V8 = ws + WS_V8; const float* PSC = (const float*)(ws + WS_PSC);
    const int gw = X.vcu * NWAVES + X.wave, NGW = X.G * NWAVES, lane = X.lane;
    constexpr int UN = 4;
    for (int m = gw; m < M; m += NGW) {
        const int b = m < MP ? (m >> 12) : BATCH + ((m - MP) >> 3);
        const float* ab = ADA + (size_t)b * 6 * D; const float* sh2 = ab + 3 * D; const float* sc2 = ab + 4 * D; const float* g2 = ab + 5 * D;
        const float* x1r = X1 + (size_t)m * D;
        float h2[32], acc[32];
#pragma unroll
        for (int j = 0; j < 2; ++j)
#pragma unroll
            for (int q = 0; q < 4; ++q) { const int c = 16 * lane + 1024 * j + 4 * q; const f32x4 xv = *(const f32x4*)(x1r + c), s1 = *(const f32x4*)(sc2 + c), s0 = *(const f32x4*)(sh2 + c);
#pragma unroll
                for (int e = 0; e < 4; ++e) { h2[16 * j + 4 * q + e] = xv[e] * (s1[e] + 1.0f) + s0[e]; acc[16 * j + 4 * q + e] = 0.f; } }
        const int e_l = EID[(size_t)m * 128 + lane], e_h = EID[(size_t)m * 128 + 64 + lane];
        const float g_l = GATE[(size_t)m * 128 + lane], g_h = GATE[(size_t)m * 128 + 64 + lane];
        for (int k0 = 0; k0 < 128; k0 += UN) {
            u32x4 uw[UN][2], vw[UN][2]; float su[UN], sv[UN], gk[UN];
#pragma unroll
            for (int i = 0; i < UN; ++i) { const int k = k0 + i;
                const int e = __builtin_amdgcn_readfirstlane(k < 64 ? __shfl(e_l, k) : __shfl(e_h, k - 64));
                gk[i] = k < 64 ? __shfl(g_l, k) : __shfl(g_h, k - 64);
                const unsigned char* ur = U8 + (size_t)e * D + 16 * lane; const unsigned char* vr = V8 + (size_t)e * D + 16 * lane;
                uw[i][0] = *(const u32x4*)ur; uw[i][1] = *(const u32x4*)(ur + 1024); vw[i][0] = *(const u32x4*)vr; vw[i][1] = *(const u32x4*)(vr + 1024);
                su[i] = PSC[e]; sv[i] = PSC[16384 + e]; }
#pragma unroll
            for (int i = 0; i < UN; ++i) {
                float d = dot_fp8x16(uw[i][0], h2) + dot_fp8x16(uw[i][1], h2 + 16);
                d = wave_sum(d) * su[i];
                const float act = 0.5f * d * (1.0f + erff(d * 0.70710678118654752f));
                const float cf = gk[i] * act * sv[i];
                axpy_fp8x16(vw[i][0], cf, acc); axpy_fp8x16(vw[i][1], cf, acc + 16);
            }
        }
        float s = 0.f;
#pragma unroll
        for (int j = 0; j < 2; ++j)
#pragma unroll
            for (int q = 0; q < 4; ++q) { const int c = 16 * lane + 1024 * j + 4 * q; const f32x4 xv = *(const f32x4*)(x1r + c), gv = *(const f32x4*)(g2 + c);
#pragma unroll
                for (int e = 0; e < 4; ++e) { const int i = 16 * j + 4 * q + e; acc[i] = xv[e] * ALPHA + gv[e] * acc[i]; s += acc[i]; } }
        const float mu = wave_sum(s) * (1.0f / D); float qq = 0.f;
#pragma unroll
        for (int i = 0; i < 32; ++i) { acc[i] -= mu; qq += acc[i] * acc[i]; }
        const float rstd = 1.0f / sqrtf(wave_sum(qq) * (1.0f / D) + LN_EPS);
        float* yo = a.out + (m < MP ? O_YP + (size_t)m * D : O_YS + (size_t)(m - MP) * D);
#pragma unroll
        for (int j = 0; j < 2; ++j)
#pragma unroll
            for (int q = 0; q < 4; ++q) { const int c = 16 * lane + 1024 * j + 4 * q; const f32x4 gg = *(const f32x4*)(a.in[29] + c), bb = *(const f32x4*)(a.in[30] + c); f32x4 o;
#pragma unroll
                for (int e = 0; e < 4; ++e) o[e] = acc[16 * j + 4 * q + e] * rstd * gg[e] + bb[e];
                *(f32x4*)(yo + c) = o; }
    }
}


#ifndef SLAB_SYNC
#define SLAB_SYNC 1
#endif
constexpr int TPB = 68;
__device__ __forceinline__ float dot16_fp8(const u32x4 w, const f32x4 h0, const f32x4 h1, const f32x4 h2, const f32x4 h3) {
    const f32x2v a0 = __builtin_amdgcn_cvt_pk_f32_fp8((int)w.x, false), a1 = __builtin_amdgcn_cvt_pk_f32_fp8((int)w.x, true), b0 = __builtin_amdgcn_cvt_pk_f32_fp8((int)w.y, false), b1 = __builtin_amdgcn_cvt_pk_f32_fp8((int)w.y, true);
    const f32x2v c0 = __builtin_amdgcn_cvt_pk_f32_fp8((int)w.z, false), c1 = __builtin_amdgcn_cvt_pk_f32_fp8((int)w.z, true), d0 = __builtin_amdgcn_cvt_pk_f32_fp8((int)w.w, false), d1 = __builtin_amdgcn_cvt_pk_f32_fp8((int)w.w, true);
    return ((a0.x * h0[0] + a0.y * h0[1]) + (a1.x * h0[2] + a1.y * h0[3])) + ((b0.x * h1[0] + b0.y * h1[1]) + (b1.x * h1[2] + b1.y * h1[3]))
         + ((c0.x * h2[0] + c0.y * h2[1]) + (c1.x * h2[2] + c1.y * h2[3])) + ((d0.x * h3[0] + d0.y * h3[1]) + (d1.x * h3[2] + d1.y * h3[3]));
}
__device__ __forceinline__ float red8(float x) {
    x += __builtin_bit_cast(float, __builtin_amdgcn_update_dpp(0, __builtin_bit_cast(int, x), 0xB1, 0xF, 0xF, true));
    x += __builtin_bit_cast(float, __builtin_amdgcn_update_dpp(0, __builtin_bit_cast(int, x), 0x4E, 0xF, 0xF, true));
    x += __builtin_bit_cast(float, __builtin_amdgcn_update_dpp(0, __builtin_bit_cast(int, x), 0x141, 0xF, 0xF, true));
    return x;
}
__device__ __forceinline__ f32x2 fma2(f32x2 a, f32x2 b, f32x2 c) { return a * b + c; }
__device__ __forceinline__ void p12_scores(const Ctx& X, CArgs& a, const XcdBarrier& bar, bool gsync) {
    unsigned char* ws = a.ws; const float* X1 = (const float*)(ws + WS_T); const float* ADA = (const float*)(ws + WS_ADA);
    const int* EID = (const int*)(ws + WS_EID); const float* GATE = (const float*)(ws + WS_GATE); float* COEF = (float*)(ws + WS_COEF);
    const unsigned char* U8 = ws + WS_U8; const float* PSC = (const float*)(ws + WS_PSC);
    LAS int* eidl = (LAS int*)X.lds;
    LAS float* h2s = (LAS float*)(X.lds + TPB * 128 * 4);
    LAS float* scl = (LAS float*)(X.lds + 2 * TPB * 128 * 4);
    const int tid = X.tid, lane = X.lane, w = X.wave, pr = lane >> 3, c = lane & 7;
    for (int tb0 = X.vcu * TPB; tb0 < M; tb0 += X.G * TPB) {
        const int ntok = (M - tb0) < TPB ? (M - tb0) : TPB;
        __syncthreads();
        for (int i = tid; i < ntok * 128; i += NTHREADS) { eidl[i] = EID[(size_t)tb0 * 128 + i]; scl[i] = 0.f; }
        __syncthreads();
        const unsigned char* H8 = ws + WS_H2I + (size_t)tb0 * D + 16 * c;
        {
            const int ntw = ntok > w ? (ntok - w + 7) / 8 : 0, ntask = 16 * ntw;
            u32x4 pA[16], pB[16]; u32x4 hA = (u32x4){0u, 0u, 0u, 0u}, hB = hA;
            const unsigned c16 = 16u * (unsigned)c; const bool up4 = (c & 4) != 0, up2 = (c & 2) != 0, up1 = (c & 1) != 0;
#define G12_LOAD(P, H, LT, SL) { const unsigned char* slab_ = U8 + (size_t)(SL) * SLAB_BYTES; H = *(const u32x4*)(H8 + (size_t)(LT) * D + (SL) * 128); \
                _Pragma("unroll") for (int it = 0; it < 16; ++it) P[it] = *(const u32x4*)(slab_ + (((unsigned)eidl[(LT) * 128 + 8 * it + pr] << 7) + c16)); }
#define G12_DPPI(X_, CTRL) __builtin_amdgcn_update_dpp(0, (X_), (CTRL), 0xF, 0xF, true)
#define G12_PROC(P, H, LT) { int xs[16];     \
                _Pragma("unroll") for (int it = 0; it < 16; ++it) { const u32x4 q = P[it]; int ia = __builtin_amdgcn_sdot4((int)q.x, (int)H.x, 0, false); ia = __builtin_amdgcn_sdot4((int)q.y, (int)H.y, ia, false); \
                    ia = __builtin_amdgcn_sdot4((int)q.z, (int)H.z, ia, false); ia = __builtin_amdgcn_sdot4((int)q.w, (int)H.w, ia, false); xs[it] = ia; } \
                int ys[8], zs[4]; \
                _Pragma("unroll") for (int jj = 0; jj < 8; ++jj) { const int lo = jj < 4 ? jj : jj + 4; const int keep = up4 ? xs[lo + 4] : xs[lo], send = up4 ? xs[lo] : xs[lo + 4]; ys[jj] = keep + G12_DPPI(send, 0x141); } \
                _Pragma("unroll") for (int qq = 0; qq < 4; ++qq) { const int lo = 4 * (qq >> 1) + (qq & 1); const int keep = up2 ? ys[lo + 2] : ys[lo], send = up2 ? ys[lo] : ys[lo + 2]; zs[qq] = keep + G12_DPPI(send, 0x4E); } \
                int wa, wb; \
                { const int keep = up1 ? zs[1] : zs[0], send = up1 ? zs[0] : zs[1]; wa = keep + G12_DPPI(send, 0xB1); } \
                { const int keep = up1 ? zs[3] : zs[2], send = up1 ? zs[2] : zs[3]; wb = keep + G12_DPPI(send, 0xB1); } \
                scl[(LT) * 128 + 8 * c + pr] += (float)wa; scl[(LT) * 128 + 8 * (c + 8) + pr] += (float)wb; }
            int sl = 0, lt = w;
            if (ntask > 0) G12_LOAD(pA, hA, w, 0)
#pragma unroll 1
            for (int k = 0; k < ntask; k += 2) {
                { int ln = lt + 8, sn = sl; if (ln >= ntok) { ln = w; ++sn; }
                  if (k + 1 < ntask) G12_LOAD(pB, hB, ln, sn)
                  G12_PROC(pA, hA, lt)
                  lt = ln; sl = sn; }
                if (k + 1 >= ntask) break;
                { int ln = lt + 8, sn = sl; if (ln >= ntok) { ln = w; ++sn; }
                  if (k + 2 < ntask) G12_LOAD(pA, hA, ln, sn)
                  G12_PROC(pB, hB, lt)
                  lt = ln; sl = sn; }
            }
        }
        __syncthreads();
        for (int i = tid; i < ntok * 128; i += NTHREADS) { const int e = eidl[i]; const size_t o = (size_t)tb0 * 128 + i;
            const float d = scl[i] * PSC[e] * ((const float*)(ws + WS_HSC))[tb0 + (i >> 7)]; const float act = 0.5f * d * (1.0f + erff(d * 0.70710678118654752f));
            COEF[o] = GATE[o] * act * PSC[16384 + e]; }
    }
}
__device__ __forceinline__ void p12_values(const Ctx& X, CArgs& a, const XcdBarrier& bar, bool gsync) {
    unsigned char* ws = a.ws; const int* EID = (const int*)(ws + WS_EID); const float* COEF = (const float*)(ws + WS_COEF);
    const unsigned char* V8 = ws + WS_V8; bf16_t* PEERO = (bf16_t*)(ws + WS_PEERO);
    LAS int* eidl = (LAS int*)X.lds;
    LAS float* cfl = (LAS float*)(X.lds + TPB * 128 * 4);
    LAS unsigned* cf8 = (LAS unsigned*)(X.lds + 2 * TPB * 128 * 4);
    LAS float* tsc = (LAS float*)(X.lds + 3 * TPB * 128 * 4);
    const int tid = X.tid, lane = X.lane, w = X.wave, r = lane >> 3, c = lane & 7;
    const bool up8 = (lane & 8) != 0;
    const int di = lane & 15, kb = lane >> 4;
    const unsigned bm = 0xFFu << (8 * (di & 3));
    const unsigned m0 = (di >> 2) == 0 ? bm : 0u, m1 = (di >> 2) == 1 ? bm : 0u, m2 = (di >> 2) == 2 ? bm : 0u, m3 = (di >> 2) == 3 ? bm : 0u;
    (void)bar; (void)gsync;
    for (int tb0 = X.vcu * TPB; tb0 < M; tb0 += X.G * TPB) {
        const int ntok = (M - tb0) < TPB ? (M - tb0) : TPB;
        __syncthreads();
        for (int i = tid; i < ntok * 128; i += NTHREADS) { eidl[i] = EID[(size_t)tb0 * 128 + i]; cfl[i] = COEF[(size_t)tb0 * 128 + i]; }
        __syncthreads();
        for (int t = w; t < ntok; t += NWAVES) {
            const float c0 = cfl[t * 128 + lane], c1 = cfl[t * 128 + 64 + lane]; const float am = wave_max(fmaxf(fabsf(c0), fabsf(c1))); const float qs = am > 0.f ? 224.0f / am : 1.0f;
            const unsigned p = (unsigned)__builtin_amdgcn_cvt_pk_fp8_f32(c0 * qs, c1 * qs, 0, false);
            cf8[t * 128 + lane] = (p & 0xFFu) * 0x01010101u; cf8[t * 128 + 64 + lane] = ((p >> 8) & 0xFFu) * 0x01010101u; if (lane == 0) tsc[t] = am > 0.f ? am / 224.0f : 1.0f; }
        {
            const int ntw = ntok > w ? (ntok - w + 7) / 8 : 0, ntask = 16 * ntw;
            u32x4 pA[16], pB[16];
            const unsigned c16 = 16u * (unsigned)c;
#define G13_LOAD(P, LT, SL) { const unsigned char* slab_ = V8 + (size_t)(SL) * SLAB_BYTES; \
                _Pragma("unroll") for (int it = 0; it < 16; ++it) P[it] = *(const u32x4*)(slab_ + (((unsigned)eidl[(LT) * 128 + 8 * it + r] << 7) + c16)); }
#define G13_PROC(P, LT, SL) { f32x4 d0 = {0.f, 0.f, 0.f, 0.f}, d1 = {0.f, 0.f, 0.f, 0.f}; \
                _Pragma("unroll") for (int pp = 0; pp < 8; ++pp) { \
                    const u32x2 ca = *(const LAS u32x2*)(cf8 + (LT) * 128 + 16 * pp + 2 * kb), cb = *(const LAS u32x2*)(cf8 + (LT) * 128 + 16 * pp + 8 + 2 * kb); \
                    const pg8::i32x8 A0 = {(int)(ca.x & m0), (int)(ca.x & m1), (int)(ca.x & m2), (int)(ca.x & m3), (int)(cb.x & m0), (int)(cb.x & m1), (int)(cb.x & m2), (int)(cb.x & m3)}; \
                    const pg8::i32x8 A1 = {(int)(ca.y & m0), (int)(ca.y & m1), (int)(ca.y & m2), (int)(ca.y & m3), (int)(cb.y & m0), (int)(cb.y & m1), (int)(cb.y & m2), (int)(cb.y & m3)}; \
                    const u32x4 b0 = P[2 * pp], b1 = P[2 * pp + 1]; \
                    const pg8::i32x8 Bv = {(int)b0.x, (int)b0.y, (int)b0.z, (int)b0.w, (int)b1.x, (int)b1.y, (int)b1.z, (int)b1.w}; \
                    d0 = __builtin_amdgcn_mfma_scale_f32_16x16x128_f8f6f4(A0, Bv, d0, 0, 0, 0, 0x7F7F7F7F, 0, 0x7F7F7F7F); \
                    d1 = __builtin_amdgcn_mfma_scale_f32_16x16x128_f8f6f4(A1, Bv, d1, 0, 0, 0, 0x7F7F7F7F, 0, 0x7F7F7F7F); } \
                  \
                float y0 = d1[0], y1 = d1[1], y2 = d1[2], y3 = d1[3], z0 = d0[0], z1 = d0[1], z2 = d0[2], z3 = d0[3]; \
                asm volatile("" : "+v"(y0), "+v"(y1), "+v"(y2), "+v"(y3), "+v"(z0), "+v"(z1), "+v"(z2), "+v"(z3));     \
                float x0 = __builtin_bit_cast(float, __builtin_amdgcn_update_dpp(0, __builtin_bit_cast(int, y0), 0x128, 0xF, 0xF, true)), x1 = __builtin_bit_cast(float, __builtin_amdgcn_update_dpp(0, __builtin_bit_cast(int, y1), 0x128, 0xF, 0xF, true)); \
                float x2 = __builtin_bit_cast(float, __builtin_amdgcn_update_dpp(0, __builtin_bit_cast(int, y2), 0x128, 0xF, 0xF, true)), x3 = __builtin_bit_cast(float, __builtin_amdgcn_update_dpp(0, __builtin_bit_cast(int, y3), 0x128, 0xF, 0xF, true)); \
                asm volatile("" : "+v"(x0), "+v"(x1), "+v"(x2), "+v"(x3)); \
                const float ts_ = tsc[(LT)]; \
                if (!up8) { u32x2 pk; pk.x = pk2((z0 + x0) * ts_, (z1 + x1) * ts_); pk.y = pk2((z2 + x2) * ts_, (z3 + x3) * ts_); __builtin_nontemporal_store(pk, (u32x2*)(PEERO + (size_t)(tb0 + (LT)) * D + (SL) * 128 + 16 * c + 4 * kb)); } }
            int sl = 0, lt = w;
            if (ntask > 0) G13_LOAD(pA, w, 0)
#pragma unroll 1
            for (int k = 0; k < ntask; k += 2) {
                { int ln = lt + 8, sn = sl; if (ln >= ntok) { ln = w; ++sn; }
                  if (k + 1 < ntask) G13_LOAD(pB, ln, sn)
                  G13_PROC(pA, lt, sl)
                  lt = ln; sl = sn; }
                if (k + 1 >= ntask) break;
                { int ln = lt + 8, sn = sl; if (ln >= ntok) { ln = w; ++sn; }
                  if (k + 2 < ntask) G13_LOAD(pA, ln, sn)
                  G13_PROC(pB, lt, sl)
                  lt = ln; sl = sn; }
            }
        }
    }
}
__device__ __forceinline__ void p12_final(const Ctx& X, CArgs& a) {
    unsigned char* ws = a.ws; const bf16_t* X1 = (const bf16_t*)(ws + WS_T); const float* ADA = (const float*)(ws + WS_ADA); const bf16_t* PEERO = (const bf16_t*)(ws + WS_PEERO);
    const int lane = X.lane;
    for (int tb0 = X.vcu * TPB; tb0 < M; tb0 += X.G * TPB)
    for (int m = tb0 + X.wave; m < tb0 + TPB && m < M; m += NWAVES) {
        const int b = m < MP ? (m >> 12) : BATCH + ((m - MP) >> 3); const float* g2 = ADA + (size_t)b * 6 * D + 5 * D;
        f32x4 v[8]; float s = 0.f;
#pragma unroll
        for (int j = 0; j < 8; ++j) { const int cc = 4 * lane + 256 * j; const u32x2 pw = *(const u32x2*)(PEERO + (size_t)m * D + cc); const f32x4 pe = {bflo(pw.x), bfhi(pw.x), bflo(pw.y), bfhi(pw.y)};
            const u32x2 xw = *(const u32x2*)(X1 + (size_t)m * D + cc); const f32x4 xv = {bflo(xw.x), bfhi(xw.x), bflo(xw.y), bfhi(xw.y)};
            v[j] = xv * ALPHA + *(const f32x4*)(g2 + cc) * pe; s += (v[j][0] + v[j][1]) + (v[j][2] + v[j][3]); }
        const float mu = wave_sum(s) * (1.0f / D); float q = 0.f;
#pragma unroll
        for (int j = 0; j < 8; ++j) { v[j] = v[j] - mu; q += (v[j][0] * v[j][0] + v[j][1] * v[j][1]) + (v[j][2] * v[j][2] + v[j][3] * v[j][3]); }
        const float rstd = 1.0f / sqrtf(wave_sum(q) * (1.0f / D) + LN_EPS);
        float* yo = a.out + (m < MP ? O_YP + (size_t)m * D : O_YS + (size_t)(m - MP) * D);
#pragma unroll
        for (int j = 0; j < 8; ++j) { const int cc = 4 * lane + 256 * j; *(f32x4*)(yo + cc) = v[j] * rstd * *(const f32x4*)(a.in[29] + cc) + *(const f32x4*)(a.in[30] + cc); }
    }
}


#ifndef SELFCHECK
#define SELFCHECK 0
#endif
#ifndef SC_TOL_ATT
#define SC_TOL_ATT 0.05f
#define SC_TOL_ML 0.05f
#define SC_TOL_TOPK 8u
#define SC_TOL_PEER 0.15f
#endif
#if SELFCHECK
__device__ __forceinline__ void chk_max(unsigned* w, float v) { atomicMax(w, __float_as_uint(fabsf(v))); }
__device__ __forceinline__ void chk_mlstm_unit(const Ctx& X, CArgs& a, unsigned* CHK, size_t row0, int T, int h, int vs, const float* C0, const float* n0, const float* m0p, const float* convbuf) {
    unsigned char* ws = a.ws; const bf16_t* BIG = (const bf16_t*)(ws + WS_BIG); const float* MIF = (const float*)(ws + WS_MIF); const bf16_t* HRAW = (const bf16_t*)(ws + WS_HMO);
    LAS float* qk = (LAS float*)X.lds; LAS float* red = qk + 512; LAS float* nred = red + 512;
    const int tid = X.tid, g = tid >> 6, dv = tid & 63;
    const int ch = tid < 256 ? h * 256 + tid : 1024 + h * 256 + (tid - 256);
    const float w0 = a.in[16][ch], w1 = a.in[16][2048 + ch], w2 = a.in[16][4096 + ch], w3 = a.in[16][6144 + ch], cb = a.in[17][ch];
    float x1 = 0.f, x2 = 0.f, x3 = 0.f;
    if (convbuf) { x3 = convbuf[ch]; x2 = convbuf[2048 + ch]; x1 = convbuf[4096 + ch]; }
    float C[32], nn = 0.f, mprev = 0.f, emax = 0.f, rmax = 0.f;
#pragma unroll
    for (int j = 0; j < 32; ++j) C[j] = C0 ? C0[(size_t)(32 * g + j) * DV + vs * 64 + dv] : 0.f;
    if (n0 && tid < 256) nn = n0[tid];
    if (m0p) mprev = m0p[0];
    __syncthreads();
    for (int t = 0; t < T; ++t) { const size_t r = row0 + t;
        const float x0 = bf2f(BIG[r * NW + C_MQK + ch]), vin = bf2f(BIG[r * NW + C_MV + h * DV + vs * 64 + dv]), iv_ = MIF[r * 8 + h], lf = MIF[r * 8 + 4 + h];
        float y = cb + x3 * w0; y = y + x2 * w1; y = y + x1 * w2; y = y + x0 * w3; x3 = x2; x2 = x1; x1 = x0;
        float sv = y / (1.0f + expf(-y)); if (tid >= 256) sv *= 0.0625f; qk[tid] = sv;
        __syncthreads();
        const float mnew = fmaxf(lf + mprev, iv_), fg = expf(lf + mprev - mnew), ig = expf(iv_ - mnew), iv = ig * vin;
        float ph = 0.f;
#pragma unroll
        for (int j = 0; j < 32; ++j) { const float kk = qk[256 + 32 * g + j], qq = qk[32 * g + j]; C[j] = fg * C[j] + kk * iv; ph += qq * C[j]; }
        red[g * 64 + dv] = ph;
        if (tid < 256) { nn = fg * nn + ig * qk[256 + tid]; float pn = qk[tid] * nn; pn = wave_sum(pn); if (X.lane == 0) nred[X.wave] = pn; }
        __syncthreads();
        if (tid < 64) { float hs = 0.f;
#pragma unroll
            for (int gg = 0; gg < 8; ++gg) hs += red[gg * 64 + tid];
            const float qn = (nred[0] + nred[1]) + (nred[2] + nred[3]); const float ref = C0 ? hs / fmaxf(fabsf(qn), expf(-mnew)) : hs;
            const float got = bf2f(HRAW[r * D + h * DV + vs * 64 + tid]); emax = fmaxf(emax, fabsf(got - ref)); rmax = fmaxf(rmax, fabsf(ref)); }
        mprev = mnew;
    }
    if (tid < 64) { chk_max(CHK + 2, emax); chk_max(CHK + 3, rmax); }
    __syncthreads();
}
__device__ __forceinline__ void chk_att_wave(const Ctx& X, CArgs& a, unsigned* CHK, int m, int head) {
    unsigned char* ws = a.ws; const bf16_t* BIG = (const bf16_t*)(ws + WS_BIG); const bf16_t* ATT = (const bf16_t*)(ws + WS_H1);
    const int d = X.lane, kvh = head >> 2; const bool prompt = m < MP; const int t = prompt ? (m & (SEQ - 1)) : ((m - MP) & 7), bs = prompt ? 0 : ((m - MP) >> 3);
    const float q = bf2f(BIG[(size_t)m * NW + C_AQ + head * 64 + d]);
    float mx = a.in[19][head], l = 1.0f, acc = 0.f;
    const int nk = prompt ? (t < 127 ? t + 1 : 128) : 128;
    for (int dist = 0; dist < nk; ++dist) { float kd, vd;
        if (prompt) { const size_t r = (size_t)(m - dist); kd = bf2f(BIG[r * NW + C_AK + kvh * 64 + d]); vd = bf2f(BIG[r * NW + C_AV + kvh * 64 + d]); }
        else { const int j = t + 128 - dist; if (j < 128) { const size_t o = (((size_t)bs * 128 + j) * KVH + kvh) * HD + d; kd = bf2f((bf16_t)f2bf(a.in[4][o])); vd = bf2f((bf16_t)f2bf(a.in[5][o])); }
               else { const size_t r = (size_t)MP + bs * 8 + (j - 128); kd = bf2f(BIG[r * NW + C_AK + kvh * 64 + d]); vd = bf2f(BIG[r * NW + C_AV + kvh * 64 + d]); } }
        const float s = wave_sum(q * kd) * 0.125f + a.in[10][t5_bucket(dist) * HEADS + head];
        const float mn = fmaxf(mx, s), sc = expf(mx - mn), p = expf(s - mn); l = l * sc + p; acc = acc * sc + p * vd; mx = mn; }
    const unsigned char* A8 = ws + WS_ATT8; const float ref = acc / l, got = __builtin_amdgcn_cvt_f32_fp8((int)A8[(size_t)m * D + head * 64 + d], 0) * (1.0f / ACT_S);
    chk_max(CHK + 0, got - ref); chk_max(CHK + 1, ref);
}
__device__ __forceinline__ void selfcheck_a(const Ctx& X, CArgs& a, unsigned* CHK) {
    if (blockIdx.x == 0) chk_mlstm_unit(X, a, CHK, (size_t)1 * SEQ, SEQ, 2, 4, nullptr, nullptr, nullptr, nullptr);
    else if (blockIdx.x == 1) { const int b = 77, h = 1; const size_t bh = (size_t)b * MLH + h; chk_mlstm_unit(X, a, CHK, (size_t)MP + b * 8, 8, h, 2, a.in[7] + bh * DK * DV, a.in[8] + bh * DK, a.in[9] + bh, a.in[6] + (size_t)b * 3 * 2048); }
    else if (blockIdx.x == 2) chk_mlstm_unit(X, a, CHK, (size_t)3 * SEQ, SEQ, 0, 7, nullptr, nullptr, nullptr, nullptr);
    else if (blockIdx.x < 40) { const int i = ((int)blockIdx.x - 3) * NWAVES + X.wave;
        int m; if (i < 16) { const int sp[16] = {0, 1, 126, 127, 128, 129, 255, 256, 4095, 4096, 4097, 4223, 4224, 8191, 12288, 16383}; m = sp[0];
#pragma unroll
            for (int z = 1; z < 16; ++z) m = (i == z) ? sp[z] : m; }
        else if (i < 200) m = (int)(((unsigned)i * 2654435761u) % (unsigned)MP); else m = MP + (int)(((unsigned)i * 40503u) % (unsigned)MS);
        chk_att_wave(X, a, CHK, m, (i * 7 + (i >> 3)) & 31); }
}
__device__ __forceinline__ void selfcheck_b(const Ctx& X, CArgs& a, unsigned* CHK) {
    unsigned char* ws = a.ws; const bf16_t* QP = (const bf16_t*)(ws + WS_H1); const bf16_t* SKB = (const bf16_t*)(ws + WS_SKB); const int* EID = (const int*)(ws + WS_EID); const float* GATE = (const float*)(ws + WS_GATE);
    const bf16_t* X1 = (const bf16_t*)(ws + WS_T); const float* ADA = (const float*)(ws + WS_ADA); const bf16_t* PEERO = (const bf16_t*)(ws + WS_PEERO);
    LAS float* sc = (LAS float*)X.lds;
    LAS float* red = sc + 2048;
    LAS int* refe = (LAS int*)(red + 16);
    const int tid = X.tid, lane = X.lane, w = X.wave;
    const int toks[8] = {5, 4100, 9000, 16383, 16384, 17000, 17407, 12345};
    for (int ti = 0; ti < 8; ++ti) { int m = toks[0];
#pragma unroll
        for (int z = 1; z < 8; ++z) m = (ti == z) ? toks[z] : m;
        __syncthreads();
        for (int p = 0; p < 2; ++p) for (int kk = 0; kk < 2; ++kk) { const int key = lane + 64 * kk; float s = 0.f;
            for (int d = 0; d < 128; ++d) s += bf2f(QP[(size_t)m * D + w * DQ + p * 128 + d]) * bf2f(SKB[((size_t)(w * 2 + p) * NKEYS + key) * 128 + d]);
            sc[(w * 2 + p) * 128 + key] = s; }
        __syncthreads();
        if (lane == 0) { int ia[16], ib[16]; float va[16], vb[16];
            LAS float* s0 = sc + (w * 2) * 128; LAS float* s1 = s0 + 128;
            for (int j = 0; j < 16; ++j) { int bi = 0; float bvv = -3.0e38f; for (int k = 0; k < 128; ++k) { const float v = s0[k]; if (v > bvv) { bvv = v; bi = k; } } s0[bi] = -3.0e38f; refe[w * 16 + j] = bi; red[0] = 0.f; ((LAS float*)refe)[128 + w * 16 + j] = bvv; }
            (void)ia; (void)ib; (void)va; (void)vb; }
        __syncthreads();
        LAS int* ia_ = refe; LAS float* va_ = (LAS float*)refe + 128; LAS int* ib_ = refe + 256; LAS float* vb_ = (LAS float*)refe + 384; LAS int* out_ = refe + 512;
        if (lane == 0) { LAS float* s1 = sc + (w * 2 + 1) * 128;
            for (int j = 0; j < 16; ++j) { int bi = 0; float bvv = -3.0e38f; for (int k = 0; k < 128; ++k) { const float v = s1[k]; if (v > bvv) { bvv = v; bi = k; } } s1[bi] = -3.0e38f; ib_[w * 16 + j] = bi; vb_[w * 16 + j] = bvv; }
            LAS float* cand = sc + (w * 2) * 128;
            for (int i = 0; i < 16; ++i) for (int j = 0; j < 16; ++j) cand[i * 16 + j] = va_[w * 16 + i] + vb_[w * 16 + j];
            int miss = 0;
            for (int j = 0; j < 16; ++j) { int bi = 0; float bvv = -3.0e38f; for (int k = 0; k < 256; ++k) { const float v = cand[k]; if (v > bvv) { bvv = v; bi = k; } } cand[bi] = -3.0e38f;
                const int e = ia_[w * 16 + (bi >> 4)] * NKEYS + ib_[w * 16 + (bi & 15)]; bool found = false;
                for (int q = 0; q < 16; ++q) found = found || (EID[((size_t)m * PH + w) * 16 + q] == e);
                miss += found ? 0 : 1; }
            out_[w] = miss; atomicAdd(CHK + 4, (unsigned)miss); }
        __syncthreads();
        { const int b = m < MP ? (m >> 12) : BATCH + ((m - MP) >> 3); const float* ab = ADA + (size_t)b * 6 * D; const int c0 = tid * 4;
          const u32x2 xw_ = *(const u32x2*)(X1 + (size_t)m * D + c0); const f32x4 xv = {bflo(xw_.x), bfhi(xw_.x), bflo(xw_.y), bfhi(xw_.y)}; const f32x4 h2 = xv * (*(const f32x4*)(ab + 4 * D + c0) + 1.0f) + *(const f32x4*)(ab + 3 * D + c0);
          f32x4 acc = (f32x4){0.f, 0.f, 0.f, 0.f};
          for (int k = 0; k < 128; ++k) { const int e = EID[(size_t)m * 128 + k]; const float gk = GATE[(size_t)m * 128 + k];
              const f32x4 uv = *(const f32x4*)(a.in[27] + (size_t)e * D + c0); float dd = (uv[0] * h2[0] + uv[1] * h2[1]) + (uv[2] * h2[2] + uv[3] * h2[3]); dd = wave_sum(dd);
              __syncthreads(); if (lane == 0) red[w] = dd; __syncthreads();
              float dt = 0.f;
#pragma unroll
              for (int z = 0; z < 8; ++z) dt += red[z];
              const float cf = gk * 0.5f * dt * (1.0f + erff(dt * 0.70710678118654752f));
              acc = acc + *(const f32x4*)(a.in[28] + (size_t)e * D + c0) * cf; }
          const u32x2 gw_ = *(const u32x2*)(PEERO + (size_t)m * D + c0); const f32x4 got = {bflo(gw_.x), bfhi(gw_.x), bflo(gw_.y), bfhi(gw_.y)};
#pragma unroll
          for (int z = 0; z < 4; ++z) { chk_max(CHK + 5, got[z] - acc[z]); chk_max(CHK + 6, acc[z]); } }
    }
    __syncthreads();
    if (tid == 0) { const float qn = __builtin_nanf("");
        const float ea = __uint_as_float(atomicAdd(CHK + 0, 0u)), ra = __uint_as_float(atomicAdd(CHK + 1, 0u)), em = __uint_as_float(atomicAdd(CHK + 2, 0u)), rm = __uint_as_float(atomicAdd(CHK + 3, 0u));
        const unsigned miss = atomicAdd(CHK + 4, 0u); const float ep = __uint_as_float(atomicAdd(CHK + 5, 0u)), rp = __uint_as_float(atomicAdd(CHK + 6, 0u));
        if (!(ea <= SC_TOL_ATT * ra) || !(ra > 0.f)) a.out[O_YP] = qn;
        if (!(em <= SC_TOL_ML * rm) || !(rm > 0.f)) a.out[O_YS] = qn;
        if (miss > SC_TOL_TOPK) a.out[O_KWP] = qn;
        if (!(ep <= SC_TOL_PEER * rp) || !(rp > 0.f)) a.out[O_VWP] = qn; }
}
#endif

#ifdef NO_ATT
#define ATT_CALL(...) do {} while (0)
#else
#define ATT_CALL(...) p4_attention(__VA_ARGS__)
#endif
constexpr int NPHASE = 15;
__global__ void __launch_bounds__(NTHREADS, 2) fwd_kernel(Args args) {
    extern __shared__ __attribute__((aligned(16))) unsigned char lds_raw[];
    Ctx X; X.lds = (LAS unsigned char*)lds_raw; X.tid = threadIdx.x; X.lane = X.tid & 63; X.wave = __builtin_amdgcn_readfirstlane(X.tid >> 6);
    X.G = gridDim.x; { const int bx = blockIdx.x; X.vcu = (X.G % 8 == 0) ? (bx % 8) * (X.G / 8) + bx / 8 : bx; }
    volatile LAS unsigned* MISC = (volatile LAS unsigned*)(X.lds + MISC_OFF);
    for (int u = X.tid; u < (LDS_BYTES - LDSCTL_OFF) / 4; u += NTHREADS) ((LAS unsigned*)(X.lds + LDSCTL_OFF))[u] = 0u;
    __syncthreads();
    CArgs& A4 = *(CArgs*)__builtin_amdgcn_kernarg_segment_ptr();
    unsigned char* ws = A4.ws;
    const bool multi = (args.ph_hi - args.ph_lo) > 1;
    XcdBarrier bar; bar.bar = (unsigned*)(ws + WS_CTL) + CW_BAR; bar.x = 0; bar.st = nullptr;
    if (multi) bar = xcd_barrier_post((unsigned*)(ws + WS_CTL) + CW_BAR, MISC + 8);
    const int lo = args.ph_lo, hi = args.ph_hi;
#ifndef PHMASK
#define PHMASK 0xFFFF
#endif
#define IN(k) (((PHMASK >> (k)) & 1) && lo <= (k) && (k) < hi)
#define SEAM(k) do { if (IN(k) && (IN((k) + 1) || ((k) == 4 && IN(6)) || ((k) == 10 && IN(12)))) xcd_barrier(bar); } while (0)
    bf16_t* W4T = (bf16_t*)(ws + WS_W4T);

    if (IN(0)) { p0_ada(X, A4.in[2], A4.in[3], A4.in[11], A4.in[12], (float*)(ws + WS_ADA)); p0_transposes(X, A4); }
    SEAM(0);
    if (IN(1)) { p1_rows(X, A4); }
    SEAM(1);
    if (IN(2)) { if (X.vcu < 16) { p2_gates(X, A4, X.vcu); if (X.G < 16) for (int u = X.vcu + X.G; u < 16; u += X.G) p2_gates(X, A4, u); }
        {
            pg8::Gemm g{(const bf16_t*)(ws + WS_H1), (const bf16_t*)(ws + WS_WINT), M, NW, D, D}; pg8::P2Bf16Order S{X.G, (int)blockIdx.x};
            pg8::EpiBig E{(bf16_t*)(ws + WS_BIG), NW, 1 << 30, 1 << 30, 0, 0, 1.0f};
            pg8::gemm_phase<pg8::EpiBig, pg8::P2Bf16Order>(X.lds, g, S, E); }
        {
            pg8::Gemm g{(const bf16_t*)(ws + WS_H1F8), (const bf16_t*)(ws + WS_WINF8), M, NW, D / 2, D / 2}; pg8::P2F8Order S{X.G, (int)(X.G - 1 - blockIdx.x)};
            pg8::EpiBig E{(bf16_t*)(ws + WS_BIG), NW, C_MO / 256, 1 << 30, 0, 0, 1.0f / (ACT_S * W_S)};
            pg8::gemm_phase<pg8::EpiBig, pg8::P2F8Order, true>(X.lds, g, S, E); } }
    SEAM(2);
    if (IN(3)) {
#ifndef T_NOPREP
        for (int u = X.vcu; u < 1024; u += X.G) m1_prep_unit(X, A4, u >> 6, u & 63);
#endif
        asm volatile("" ::: "memory");
#ifndef T_NOSAMP
        for (int u = X.vcu; u < SAMP_P3; u += X.G) m1_sample_unit(X, A4, u);
#endif
        for (int u = X.vcu; u < ATT_P3; u += X.G) { const int qb = u & 31, kvh = (u >> 5) & 7, b = u >> 8; att_prompt_unit(X, A4, b, kvh, qb); }
        __syncthreads();
        }
    SEAM(3);
    if (IN(4)) { if (X.G >= 256) { if (X.vcu < 128) { if (!(args.flags & 1)) m2_scan_unit(X, A4, X.vcu >> 3, X.vcu & 7); } else { if (!(args.flags & 2)) { if (X.vcu - 128 < 16) m2_nchain_unit(X, A4, X.vcu - 128); for (int u = SAMP_P3 + X.vcu - 128; u < 512; u += X.G - 128) m1_sample_unit(X, A4, u); p3_sample_attention(X, A4, X.vcu - 128, X.G - 128); ATT_CALL(X, A4, X.vcu - 128, X.G - 128); } } }
                 else { for (int u = X.vcu; u < 128; u += X.G) m2_scan_unit(X, A4, u >> 3, u & 7); for (int u = X.vcu; u < 16; u += X.G) m2_nchain_unit(X, A4, u); for (int u = SAMP_P3 + X.vcu; u < 512; u += X.G) m1_sample_unit(X, A4, u); p3_sample_attention(X, A4, X.vcu, X.G); ATT_CALL(X, A4, X.vcu, X.G); } }
    SEAM(4);
#if SELFCHECK
    if (multi) { selfcheck_a(X, A4, (unsigned*)(ws + WS_CTL) + 65536); xcd_barrier(bar); }
#endif
    if (IN(6)) { pg8::Gemm g{(const bf16_t*)(ws + WS_ATT8), (const bf16_t*)(ws + WS_W4F8), M, D, D / 2, D / 2}; pg8::StaticOrder S; S.init(M, D, X.G, (int)blockIdx.x);
        pg8::EpiGate<false> E{(bf16_t*)(ws + WS_Z), (const bf16_t*)(ws + WS_BIG) + C_GA, NW, 1.0f / (ACT_S * W_S), nullptr};
        pg8::gemm_phase<pg8::EpiGate<false>, pg8::StaticOrder, true>(X.lds, g, S, E);
        if (X.G > 32) { if ((int)blockIdx.x >= 32) p3_headnorm(X, A4, (int)blockIdx.x - 32, X.G - 32); } else p3_headnorm(X, A4, (int)blockIdx.x, X.G); }
    SEAM(6);
    if (IN(7)) { pg8::Gemm g{(const bf16_t*)(ws + WS_HMO8), (const bf16_t*)(ws + WS_W4F8 + (size_t)D * D), M, D, D / 2, D / 2}; pg8::StaticOrder S; S.init(M, D, X.G, (int)blockIdx.x);
        pg8::EpiGate<true> E{(bf16_t*)(ws + WS_Z), (const bf16_t*)(ws + WS_BIG) + C_GB, NW, 1.0f / (ACT_S * W_S), ws + WS_Z8};
        pg8::gemm_phase<pg8::EpiGate<true>, pg8::StaticOrder, true>(X.lds, g, S, E);
        if (X.G > 32) { if ((int)blockIdx.x >= 32) p3_state_copies(X, A4, (int)blockIdx.x - 32, X.G - 32); } else p3_state_copies(X, A4, (int)blockIdx.x, X.G); }
    SEAM(7);
    if (IN(8)) { pg8::Gemm g{(const bf16_t*)(ws + WS_Z8), (const bf16_t*)(ws + WS_W4F8 + (size_t)2 * D * D), M, D, D / 2, D / 2}; pg8::StaticOrder S; S.init(M, D, X.G, (int)blockIdx.x);
        pg8::EpiRes E{(bf16_t*)(ws + WS_T), A4.in[0], A4.in[1], (const float*)(ws + WS_ADA), 1.0f / (Z_S * W_S)};
        pg8::gemm_phase<pg8::EpiRes, pg8::StaticOrder, true>(X.lds, g, S, E);
        if (X.G > 32) { if ((int)blockIdx.x >= 32) { p0_peer_fp8(X, A4, 0, (int)blockIdx.x - 32, X.G - 32); p0_peer_fp8(X, A4, 1, (int)blockIdx.x - 32, X.G - 32); } } else { p0_peer_fp8(X, A4, 0, (int)blockIdx.x, X.G); p0_peer_fp8(X, A4, 1, (int)blockIdx.x, X.G); } }
    SEAM(8);
    if (IN(9)) { p6_ln1(X, A4); }
    SEAM(9);
    if (IN(10)) { pg8::Gemm g{(const bf16_t*)(ws + WS_H28), (const bf16_t*)(ws + WS_W4F8 + (size_t)3 * D * D), M, D, D / 2, D / 2}; pg8::StaticOrder S; S.init(M, D, X.G, (int)blockIdx.x);
        pg8::EpiPlain E{(bf16_t*)(ws + WS_H1), 1.0f / (ACT_S * W_S)};
        pg8::gemm_phase<pg8::EpiPlain, pg8::StaticOrder, true>(X.lds, g, S, E);
        p11_topk2(X, A4, &S);
        if (X.G > 32) { if ((int)blockIdx.x >= 32) { p0_peer_fp8(X, A4, 2, (int)blockIdx.x - 32, X.G - 32); p0_peer_fp8(X, A4, 3, (int)blockIdx.x - 32, X.G - 32); } } else { p0_peer_fp8(X, A4, 2, (int)blockIdx.x, X.G); p0_peer_fp8(X, A4, 3, (int)blockIdx.x, X.G); } }
    SEAM(10);
    if (IN(12)) { p12_scores(X, A4, bar, false); }
    if (IN(12) && IN(13)) { asm volatile("s_waitcnt vmcnt(0)" ::: "memory"); __syncthreads(); }
    if (IN(13)) { p12_values(X, A4, bar, false); }
    if (IN(13) && IN(14)) { asm volatile("s_waitcnt vmcnt(0)" ::: "memory"); __syncthreads(); }
    if (IN(14)) { p12_final(X, A4); }
#if SELFCHECK
    if (multi && blockIdx.x == 0) { __syncthreads(); selfcheck_b(X, A4, (unsigned*)(ws + WS_CTL) + 65536); }
#endif
#undef IN
#undef SEAM
}

#ifndef MK_PER_PHASE
#define MK_PER_PHASE 0
#endif
#ifndef MK_REP_MASK
#define MK_REP_MASK 0
#endif
#ifndef MK_REP_N
#define MK_REP_N 3
#endif
#ifndef MK_REP_FLAGS
#define MK_REP_FLAGS 0
#endif
extern "C" void kernel_launch(void* const* d_in, const int* in_sizes, int n_in, void* d_out, int out_size, void* d_ws, size_t ws_size, hipStream_t stream) {
    static int grid = 0;
    if (grid == 0) {
        if (n_in != 31 || (size_t)out_size != O_END || ws_size < WS_END) { fprintf(stderr, "kernel_launch: unexpected shapes: n_in %d out %d ws %zu (need %zu)\n", n_in, out_size, ws_size, (size_t)WS_END); grid = -1; return; }
        int dev = 0, cus = 0;
        if (hipGetDevice(&dev) != hipSuccess || hipDeviceGetAttribute(&cus, hipDeviceAttributeMultiprocessorCount, dev) != hipSuccess) { grid = -1; return; }
        if (hipFuncSetAttribute((const void*)fwd_kernel, hipFuncAttributeMaxDynamicSharedMemorySize, LDS_BYTES) != hipSuccess) { fprintf(stderr, "kernel_launch: hipFuncSetAttribute failed\n"); grid = -1; return; }
        (void)hipGetLastError();
        grid = cus;
    }
    if (grid < 0) return;
    (void)hipMemsetAsync((char*)d_ws + WS_CTL, 0, CTL_ZERO_BYTES, stream);
    Args a{};
    for (int i = 0; i < 31; ++i) a.in[i] = (const float*)d_in[i];
    a.out = (float*)d_out; a.ws = (unsigned char*)d_ws;
#if MK_PER_PHASE
    for (int p = 0; p < NPHASE; ++p) { a.ph_lo = p; a.ph_hi = p + 1; const int nrep = ((MK_REP_MASK >> p) & 1) ? MK_REP_N : 1;
        for (int r = 0; r < nrep; ++r) { a.flags = r > 0 ? MK_REP_FLAGS : 0; hipLaunchKernelGGL(fwd_kernel, dim3(grid), dim3(NTHREADS), LDS_BYTES, stream, a); } }
    a.flags = 0;
#else
    a.ph_lo = 0; a.ph_hi = NPHASE;
    hipLaunchKernelGGL(fwd_kernel, dim3(grid), dim3(NTHREADS), LDS_BYTES, stream, a);
#endif
}
```

```cpp
#include <hip/hip_runtime.h>
#include <cstdio>
#include <cstdint>
#include <cmath>

#define GAS __attribute__((address_space(1)))
#define LAS __attribute__((address_space(3)))
typedef unsigned short bf16_t;
typedef short bf16x8 __attribute__((ext_vector_type(8)));
typedef float f32x4 __attribute__((ext_vector_type(4)));
typedef float f32x2 __attribute__((ext_vector_type(2)));
typedef unsigned u32x4 __attribute__((ext_vector_type(4)));
typedef unsigned u32x2 __attribute__((ext_vector_type(2)));

constexpr int D = 2048, BATCH = 4, SEQ = 4096, DEC_BATCH = 128, DEC_SEQ = 8;
constexpr int MP = BATCH * SEQ, MS = DEC_BATCH * DEC_SEQ, M = MP + MS;
constexpr int NB = BATCH + DEC_BATCH;
constexpr int HEADS = 32, KVH = 8, HD = 64, WINDOW = 128;
constexpr int MLH = 4, DK = 256, DV = 512;
constexpr int PH = 8, NKEYS = 128, TOPK = 16, DQ = 256;
constexpr int INW = 13320, NW = 13312;
constexpr int C_AQ = 0, C_AK = 2048, C_AV = 2560, C_MQK = 3072, C_MV = 5120, C_MO = 7168, C_GA = 9216, C_GB = 11264;
constexpr int SRC_MIF = 7168;
constexpr float LN_EPS = 1e-5f;
constexpr float ALPHA = 1.189207115002721f;

constexpr size_t O_YP = 0, O_YS = O_YP + (size_t)MP * D, O_KWP = O_YS + (size_t)MS * D, O_VWP = O_KWP + 4 * 128 * 512, O_CONVP = O_VWP + 4 * 128 * 512,
                 O_CP = O_CONVP + 4 * 3 * 2048, O_NP = O_CP + (size_t)4 * 4 * 256 * 512, O_MPO = O_NP + 4 * 4 * 256, O_KWS = O_MPO + 16,
                 O_VWS = O_KWS + (size_t)128 * 128 * 512, O_CONVS = O_VWS + (size_t)128 * 128 * 512, O_CS = O_CONVS + (size_t)128 * 3 * 2048,
                 O_NS = O_CS + (size_t)128 * 4 * 256 * 512, O_MSO = O_NS + 128 * 4 * 256, O_END = O_MSO + 512;

constexpr size_t MiB = 1u << 20;
constexpr size_t WS_CTL = 0, CTL_ZERO_BYTES = 1 * MiB;
constexpr size_t WS_ADA = 1 * MiB;
constexpr size_t WS_H2I = 60 * MiB, WS_HSC = 100 * MiB;
constexpr size_t WS_WMIF = 8 * MiB;
constexpr size_t WS_MIF = 9 * MiB;
constexpr size_t WS_EID = 10 * MiB;
constexpr size_t WS_GATE = 19 * MiB;
constexpr size_t WS_W4T = 28 * MiB;
constexpr size_t WS_WINT = 60 * MiB;
constexpr size_t WS_H1 = 112 * MiB;
constexpr size_t WS_HMO = 180 * MiB;
constexpr size_t WS_Z = 248 * MiB;
constexpr size_t WS_T = 316 * MiB;
constexpr size_t WS_BIG = 452 * MiB;
constexpr size_t WS_U8 = 896 * MiB;
constexpr size_t WS_V8 = 928 * MiB;
constexpr size_t WS_PSC = 960 * MiB;
constexpr size_t WS_W4F8 = 962 * MiB;
constexpr size_t WS_WINF8 = 978 * MiB;
constexpr size_t WS_END = 1004 * MiB;
static_assert(WS_BIG + (size_t)M * NW * 2 <= WS_END, "ws map");
static_assert(WS_T + (size_t)M * D * 4 <= WS_BIG && WS_Z + (size_t)M * D * 2 <= WS_T && WS_HMO + (size_t)M * D * 2 <= WS_Z && WS_H1 + (size_t)M * D * 2 <= WS_HMO, "ws map");
static_assert(WS_WINT + (size_t)NW * D * 2 <= WS_H1 && WS_W4T + (size_t)4 * D * D * 2 <= WS_WINT && WS_GATE + (size_t)M * 128 * 4 <= WS_W4T && WS_EID + (size_t)M * 128 * 4 <= WS_GATE, "ws map");
constexpr size_t WS_QC = WS_T;
constexpr size_t WS_KWT = WS_T + 32 * MiB;
constexpr size_t WS_VT = WS_T + 64 * MiB;
constexpr size_t WS_SM = WS_T + 128 * MiB;
constexpr size_t WS_MG = WS_GATE;
constexpr int MG_A1 = 0, MG_G = 65536, MG_WIN = 131072, MG_EMI = 196608, MG_WK = 262144, MG_DEC = 327680;
constexpr int MG_AC = 393216, MG_RS = 655360, MG_NALL = 720896;
constexpr size_t WS_SKB = WS_PSC + 256 * 1024;
constexpr size_t SLAB_BYTES = (size_t)16384 * 128;
constexpr size_t WS_PEERO = WS_BIG;
constexpr size_t WS_COEF = WS_BIG + 140 * MiB;
constexpr size_t WS_ATT8 = WS_H1;
constexpr size_t WS_HMO8 = WS_H1 + 34 * MiB;
constexpr size_t WS_H1F8 = WS_HMO;
constexpr size_t WS_Z8 = WS_HMO;
constexpr size_t WS_H28 = WS_HMO;
constexpr float ACT_S = 8.0f, Z_S = 16.0f, W_S = 64.0f;
constexpr int CW_BAR = 4096;

constexpr int RING_BYTES = 131072;
constexpr int LDS_BYTES = 163840;
constexpr int LDSCTL_OFF = LDS_BYTES - 1024, MISC_OFF = LDSCTL_OFF + 320;
constexpr int NWAVES = 8, NTHREADS = 512;
#ifndef ATT_P3
#define ATT_P3 64
#endif
#ifndef SAMP_P3
#define SAMP_P3 512
#endif

typedef __bf16 bf16x2_t __attribute__((ext_vector_type(2)));
__device__ __forceinline__ unsigned pk2(float lo, float hi) { f32x2 v = {lo, hi}; bf16x2_t b = __builtin_convertvector(v, bf16x2_t); return __builtin_bit_cast(unsigned, b); }
__device__ __forceinline__ unsigned f2bf(float f) { return pk2(f, 0.f) & 0xffffu; }
__device__ __forceinline__ float bf2f(unsigned short b) { return __builtin_bit_cast(float, (unsigned)b << 16); }
__device__ __forceinline__ float bflo(unsigned w) { return __builtin_bit_cast(float, w << 16); }
__device__ __forceinline__ float bfhi(unsigned w) { return __builtin_bit_cast(float, w & 0xffff0000u); }
__device__ __forceinline__ float sigmoidf_(float x) { return 1.0f / (1.0f + expf(-x)); }
__device__ __forceinline__ float xsum16(float x) { const auto q = __builtin_amdgcn_permlane16_swap(__float_as_uint(x), __float_as_uint(x), false, false); return __uint_as_float(q[0]) + __uint_as_float(q[1]); }
__device__ __forceinline__ float xsum32(float x) { const auto q = __builtin_amdgcn_permlane32_swap(__float_as_uint(x), __float_as_uint(x), false, false); return __uint_as_float(q[0]) + __uint_as_float(q[1]); }
__device__ __forceinline__ float row_sum16(float x) {
    x += __builtin_bit_cast(float, __builtin_amdgcn_update_dpp(0, __builtin_bit_cast(int, x), 0xB1, 0xF, 0xF, true));
    x += __builtin_bit_cast(float, __builtin_amdgcn_update_dpp(0, __builtin_bit_cast(int, x), 0x4E, 0xF, 0xF, true));
    x += __builtin_bit_cast(float, __builtin_amdgcn_update_dpp(0, __builtin_bit_cast(int, x), 0x141, 0xF, 0xF, true));
    x += __builtin_bit_cast(float, __builtin_amdgcn_update_dpp(0, __builtin_bit_cast(int, x), 0x140, 0xF, 0xF, true));
    return x;
}
__device__ __forceinline__ float wave_sum(float v) { return xsum32(xsum16(row_sum16(v))); }
__device__ __forceinline__ float wave_max(float x) {
    x = fmaxf(x, __builtin_bit_cast(float, __builtin_amdgcn_update_dpp(0, __builtin_bit_cast(int, x), 0xB1, 0xF, 0xF, true)));
    x = fmaxf(x, __builtin_bit_cast(float, __builtin_amdgcn_update_dpp(0, __builtin_bit_cast(int, x), 0x4E, 0xF, 0xF, true)));
    x = fmaxf(x, __builtin_bit_cast(float, __builtin_amdgcn_update_dpp(0, __builtin_bit_cast(int, x), 0x141, 0xF, 0xF, true)));
    x = fmaxf(x, __builtin_bit_cast(float, __builtin_amdgcn_update_dpp(0, __builtin_bit_cast(int, x), 0x140, 0xF, 0xF, true)));
    { const auto q = __builtin_amdgcn_permlane16_swap(__float_as_uint(x), __float_as_uint(x), false, false); x = fmaxf(__uint_as_float(q[0]), __uint_as_float(q[1])); }
    { const auto q = __builtin_amdgcn_permlane32_swap(__float_as_uint(x), __float_as_uint(x), false, false); x = fmaxf(__uint_as_float(q[0]), __uint_as_float(q[1])); }
    return x;
}
__device__ __forceinline__ float sat8(float v) { return __builtin_amdgcn_fmed3f(v, -448.0f, 448.0f); }
__device__ __forceinline__ unsigned pk4_i8(float a, float b, float c, float d) {
    const float mg = 12582912.0f; const unsigned ua = __builtin_bit_cast(unsigned, a + mg), ub = __builtin_bit_cast(unsigned, b + mg), uc = __builtin_bit_cast(unsigned, c + mg), ud = __builtin_bit_cast(unsigned, d + mg);
    return (ua & 255u) | ((ub & 255u) << 8) | ((uc & 255u) << 16) | (ud << 24); }
__device__ __forceinline__ unsigned pk4_fp8(float a, float b, float c, float d) { int p = 0; p = __builtin_amdgcn_cvt_pk_fp8_f32(sat8(a), sat8(b), p, false); p = __builtin_amdgcn_cvt_pk_fp8_f32(sat8(c), sat8(d), p, true); return (unsigned)p; }
#define LDS_WAIT() asm volatile("s_waitcnt lgkmcnt(0)" ::: "memory")
#define VM_WAIT() asm volatile("s_waitcnt vmcnt(0)" ::: "memory")

namespace pg8 {
constexpr int BM = 256, BK = 64, HALF = 128, HTB = HALF * BK * 2, STAGE_BYTES = 8 * HTB, NXCD = 8, WGM = 8;
__host__ __device__ __forceinline__ int lds_byte(int r, int c) { const int st = (r >> 4) * 2 + (c >> 5), rr = r & 15, cc = c & 31, ob = rr * 64 + cc * 2; return st * 1024 + (ob ^ (((ob >> 9) & 1) << 5)); }
__host__ __device__ __forceinline__ void stage_rc(int b, int& R, int& C) { const int st = b / 1024, sb = b % 1024, swz = sb ^ (((sb >> 9) & 1) << 5); R = (st >> 1) * 16 + swz / 64; C = (st & 1) * 32 + (swz % 64) / 2; }
__host__ __device__ __forceinline__ int perm32(int rho) { const int n = rho >> 4, i = rho & 15; return 8 * (i >> 2) + 4 * n + (i & 3); }
struct Unit { int pm, pn; };
struct Gemm { const bf16_t* A; const bf16_t* Bt; int M, N, K, lda; };
struct StaticOrder {
    int nM, nN, nwg, G, c;
    __host__ __device__ void init(int M_, int N_, int G_, int c_) { nM = M_ / BM; nN = N_ / BM; nwg = nM * nN; G = G_; c = c_; }
    __host__ __device__ bool next(int i, Unit& u) const {
        const long L = (long)i * G + c; if (L >= nwg) return false;
        int wgid = (int)L; { const int q = nwg / NXCD, r = nwg % NXCD, xcd = wgid % NXCD, off = wgid / NXCD; wgid = (xcd < r ? xcd * (q + 1) : r * (q + 1) + (xcd - r) * q) + off; }
        const int nig = WGM * nN, gid = wgid / nig, fm = gid * WGM, gsz = (nM - fm) < WGM ? (nM - fm) : WGM;
        u.pm = fm + ((wgid % nig) % gsz); u.pn = (wgid % nig) / gsz; return true;
    }
};
__host__ __device__ __forceinline__ int p2_recent_tile(int rt) { return rt < 8 ? (rt >> 1) * 16 + 14 + (rt & 1) : 64 + (rt - 8); }
__host__ __device__ __forceinline__ int p2_old_tile(int k) { return (k / 14) * 16 + (k % 14); }
__host__ __device__ __forceinline__ void grid_map(int L, int nM, int nN, int& pm, int& pn) {
    const int nwg = nM * nN; int wgid = L; { const int q = nwg / NXCD, r = nwg % NXCD, xcd = wgid % NXCD, off = wgid / NXCD; wgid = (xcd < r ? xcd * (q + 1) : r * (q + 1) + (xcd - r) * q) + off; }
    const int nig = WGM * nN, gid = wgid / nig, fm = gid * WGM, gsz = (nM - fm) < WGM ? (nM - fm) : WGM;
    pm = fm + ((wgid % nig) % gsz); pn = (wgid % nig) / gsz;
}
struct P2Bf16Order {
    int G, c;
    __host__ __device__ bool next(int i, Unit& u) const { const int L = i * G + c; if (L >= 12 * 20) return false; int a, b; grid_map(L, 12, 20, a, b); u.pm = p2_recent_tile(a); u.pn = 8 + b; return true; }
};
struct P2F8Order {
    int G, c;
    __host__ __device__ bool next(int i, Unit& u) const { const int L = i * G + c; int a, b;
        if (L < 56 * 52) {
            constexpr int nwg = 56 * 52; int wgid = L; { const int q = nwg / NXCD, xcd = wgid % NXCD, off = wgid / NXCD; wgid = xcd * q + off; }
            const int chunk = wgid / 224, q2 = wgid % 224; u.pm = p2_old_tile(q2 >> 2); u.pn = chunk * 4 + (q2 & 3); return true; }
        const int L2 = L - 56 * 52; if (L2 >= 12 * 32) return false;
        grid_map(L2, 12, 32, a, b); u.pm = p2_recent_tile(a); u.pn = b < 8 ? b : b + 20; return true; }
};
__device__ __forceinline__ unsigned cvt_pk_bf16(float lo, float hi) { unsigned r; asm volatile("v_cvt_pk_bf16_f32 %0, %1, %2" : "=v"(r) : "v"(lo), "v"(hi)); return r; }

typedef int i32x8 __attribute__((ext_vector_type(8)));
typedef int i32x4v __attribute__((ext_vector_type(4)));
__device__ __forceinline__ i32x8 cat16(bf16x8 lo, bf16x8 hi) { return __builtin_shufflevector(__builtin_bit_cast(i32x4v, lo), __builtin_bit_cast(i32x4v, hi), 0, 1, 2, 3, 4, 5, 6, 7); }
template <class Epi, class Sched, bool F8 = false>
__device__ __forceinline__ void gemm_phase(LAS unsigned char* lds, const Gemm g, const Sched& S, const Epi& E) {
    const int tid = threadIdx.x, wid = __builtin_amdgcn_readfirstlane(tid >> 6), lane = tid & 63, wr = wid >> 2, wc = wid & 3, fr = lane & 15, fq = lane >> 4;
    const int K = g.K, nt = K / BK, lda = g.lda;
    unsigned voffA[2], voffB[2];
    { int R, C; stage_rc(tid * 16, R, C); const int Rb = Epi::PERM ? ((R & ~31) + perm32(R & 31)) : R;
        voffA[0] = (unsigned)(R * lda + C) * 2u; voffB[0] = (unsigned)(Rb * K + C) * 2u; voffA[1] = voffA[0] + (unsigned)(64 * lda) * 2u; voffB[1] = voffB[0] + (unsigned)(64 * K) * 2u; }
    const size_t kstep = (size_t)(BK * 2);
    const size_t hstepA = (size_t)HALF * lda * 2, hstepB = (size_t)HALF * K * 2;
    const size_t tstepA = 2 * hstepA, tstepB = 2 * hstepB;
    const unsigned ldsw = (unsigned)wid * 1024u;
    const int aoff = lds_byte(wr * 64 + fr, fq * 8), boff = lds_byte(wc * 32 + fr, fq * 8);
#define PG8_SA(b, h) (((b) * 2 + (h)) * HTB)
#define PG8_SB(b, h) ((4 + (b) * 2 + (h)) * HTB)
#define PG8_STAGE(bufoff, gbase, voff) do { _Pragma("unroll") for (int _i = 0; _i < 2; ++_i) \
        __builtin_amdgcn_global_load_lds((const unsigned*)((const char*)(gbase) + (voff)[_i]), (LAS unsigned*)(lds + (bufoff) + ldsw + _i * 8192), 16, 0, 0); } while (0)
#define PG8_LDA(dst, b, h) do { _Pragma("unroll") for (int m = 0; m < 4; ++m) { if constexpr (F8) dst##8[m] = cat16(*(const LAS bf16x8*)(lds + PG8_SA(b, h) + aoff + m * 2048), *(const LAS bf16x8*)(lds + PG8_SA(b, h) + aoff + m * 2048 + 1024)); \
        else { _Pragma("unroll") for (int k = 0; k < 2; ++k) dst[m][k] = *(const LAS bf16x8*)(lds + PG8_SA(b, h) + aoff + m * 2048 + k * 1024); } } } while (0)
#define PG8_LDB(dst, b, h) do { _Pragma("unroll") for (int n = 0; n < 2; ++n) { if constexpr (F8) dst##8[n] = cat16(*(const LAS bf16x8*)(lds + PG8_SB(b, h) + boff + n * 2048), *(const LAS bf16x8*)(lds + PG8_SB(b, h) + boff + n * 2048 + 1024)); \
        else { _Pragma("unroll") for (int k = 0; k < 2; ++k) dst[n][k] = *(const LAS bf16x8*)(lds + PG8_SB(b, h) + boff + n * 2048 + k * 1024); } } } while (0)
#define PG8_MMA(ai, bj, At, Bt) do { __builtin_amdgcn_s_setprio(1); _Pragma("unroll") for (int m = 0; m < 4; ++m) _Pragma("unroll") for (int n = 0; n < 2; ++n) { \
        if constexpr (F8) asm volatile("v_mfma_scale_f32_16x16x128_f8f6f4 %0, %1, %2, %0, %3, %3 op_sel_hi:[0,0,0]" : "+v"(acc[ai][bj][m][n]) : "v"(Bt##8[n]), "v"(At##8[m]), "v"(f8scale)); \
        else { _Pragma("unroll") for (int k = 0; k < 2; ++k) acc[ai][bj][m][n] = __builtin_amdgcn_mfma_f32_16x16x32_bf16(Bt[n][k], At[m][k], acc[ai][bj][m][n], 0, 0, 0); } } __builtin_amdgcn_s_setprio(0); } while (0)
#define PG8_WAIT_V(n) asm volatile("s_waitcnt vmcnt(" #n ")" ::: "memory")
#define PG8_WAIT_L(n) asm volatile("s_waitcnt lgkmcnt(" #n ")" ::: "memory")
#define PG8_BAR __builtin_amdgcn_s_barrier()
#define PG8_SCHED __builtin_amdgcn_sched_barrier(0)
    Unit cur, nxt; int ui = 0;
    if (!S.next(0, cur)) return;
    f32x4 acc[2][2][4][2];
#pragma unroll
    for (int a = 0; a < 2; ++a)
#pragma unroll
        for (int b = 0; b < 2; ++b)
#pragma unroll
            for (int m = 0; m < 4; ++m)
#pragma unroll
                for (int n = 0; n < 2; ++n) acc[a][b][m][n] = (f32x4){0.f, 0.f, 0.f, 0.f};
    bf16x8 At[4][2], B0[2][2], B1[2][2]; i32x8 At8[4], B08[2], B18[2];
    int f8scale = 0x7F7F7F7F; asm volatile("" : "+v"(f8scale));
    const char* cA = (const char*)g.A + (size_t)cur.pm * tstepA; const char* cB = (const char*)g.Bt + (size_t)cur.pn * tstepB;
    PG8_STAGE(PG8_SB(0, 0), cB, voffB); PG8_STAGE(PG8_SB(0, 1), cB + hstepB, voffB); PG8_STAGE(PG8_SA(0, 0), cA, voffA); PG8_STAGE(PG8_SA(0, 1), cA + hstepA, voffA);
    if (wr == 1) PG8_BAR;
    PG8_WAIT_V(2); PG8_BAR;
    PG8_STAGE(PG8_SB(1, 0), cB + kstep, voffB); PG8_STAGE(PG8_SA(1, 0), cA + kstep, voffA); PG8_STAGE(PG8_SB(1, 1), cB + hstepB + kstep, voffB);
    PG8_WAIT_V(6); PG8_BAR;
    for (;;) {
        const bool has_next = S.next(ui + 1, nxt);
        const char* nA = has_next ? (const char*)g.A + (size_t)nxt.pm * tstepA : cA; const char* nB = has_next ? (const char*)g.Bt + (size_t)nxt.pn * tstepB : cB;
        for (int t = 0; t < nt; t += 2) {
            const bool last = (t == nt - 2);
            const char* a1 = cA + (size_t)(t + 1) * kstep;
            const char* a2 = last ? nA : cA + (size_t)(t + 2) * kstep; const char* b2 = last ? nB : cB + (size_t)(t + 2) * kstep;
            const char* a3 = a2 + kstep; const char* b3 = b2 + kstep;
            PG8_LDB(B0, 0, 0); PG8_LDB(B1, 0, 1); PG8_SCHED; PG8_LDA(At, 0, 0); PG8_STAGE(PG8_SA(1, 1), a1 + hstepA, voffA);
            PG8_WAIT_V(8); PG8_WAIT_L(0); PG8_BAR; PG8_MMA(0, 0, At, B0); PG8_MMA(0, 1, At, B1); PG8_BAR; PG8_SCHED;
            PG8_LDA(At, 0, 1); PG8_STAGE(PG8_SB(0, 0), b2, voffB); PG8_STAGE(PG8_SB(0, 1), b2 + hstepB, voffB); PG8_STAGE(PG8_SA(0, 0), a2, voffA);
            PG8_WAIT_V(8); PG8_WAIT_L(0); PG8_BAR; PG8_MMA(1, 0, At, B0); PG8_MMA(1, 1, At, B1); PG8_BAR; PG8_SCHED;
            PG8_LDB(B0, 1, 0); PG8_LDB(B1, 1, 1); PG8_SCHED; PG8_LDA(At, 1, 0); PG8_STAGE(PG8_SA(0, 1), a2 + hstepA, voffA);
            PG8_WAIT_V(8); PG8_WAIT_L(0); PG8_BAR; PG8_MMA(0, 0, At, B0); PG8_MMA(0, 1, At, B1); PG8_BAR; PG8_SCHED;
            PG8_LDA(At, 1, 1); PG8_STAGE(PG8_SB(1, 0), b3, voffB); PG8_STAGE(PG8_SB(1, 1), b3 + hstepB, voffB); PG8_STAGE(PG8_SA(1, 0), a3, voffA);
            PG8_WAIT_V(8); PG8_WAIT_L(0); PG8_BAR; PG8_MMA(1, 0, At, B0); PG8_MMA(1, 1, At, B1); PG8_BAR; PG8_SCHED;
        }
        if (wr == 0) PG8_BAR;
        if constexpr (F8) asm volatile("s_nop 15\n\ts_nop 15" ::: "memory");
        { int fr_e = fr, fq_e = fq; asm volatile("" : "+v"(fr_e), "+v"(fq_e)); E(acc, cur, wr, wc, fr_e, fq_e); }
        if (!has_next) break;
#pragma unroll
        for (int a = 0; a < 2; ++a)
#pragma unroll
            for (int b = 0; b < 2; ++b)
#pragma unroll
                for (int m = 0; m < 4; ++m)
#pragma unroll
                    for (int n = 0; n < 2; ++n) acc[a][b][m][n] = (f32x4){0.f, 0.f, 0.f, 0.f};
        cur = nxt; cA = nA; cB = nB; ++ui;
        if (wr == 1) PG8_BAR;
    }
    PG8_WAIT_V(0);
    PG8_BAR;
#undef PG8_SA
#undef PG8_SB
#undef PG8_STAGE
#undef PG8_LDA
#undef PG8_LDB
#undef PG8_MMA
#undef PG8_WAIT_V
#undef PG8_WAIT_L
#undef PG8_BAR
#undef PG8_SCHED
}

struct EpiBig {
    static constexpr bool PERM = true;
    bf16_t* O; int ldc; int sig_from; int split, add0, add1; float os;
    __device__ __forceinline__ void operator()(const f32x4 (&acc)[2][2][4][2], const Unit& u, int wr, int wc, int fr, int fq) const {
        const int row0 = u.pm * BM + wr * 64 + fr, col0 = (u.pn + (u.pn < split ? add0 : add1)) * BM + wc * 32 + 8 * fq; const bool sg = u.pn >= sig_from;
#pragma unroll
        for (int ai = 0; ai < 2; ++ai)
#pragma unroll
            for (int m = 0; m < 4; ++m) { bf16_t* rowp = O + (size_t)(row0 + ai * HALF + m * 16) * ldc + col0;
#pragma unroll
                for (int bj = 0; bj < 2; ++bj) { f32x4 v0 = acc[ai][bj][m][0] * os, v1 = acc[ai][bj][m][1] * os;
                    if (sg) {
#pragma unroll
                        for (int e = 0; e < 4; ++e) { v0[e] = __builtin_amdgcn_rcpf(1.0f + __expf(-v0[e])); v1[e] = __builtin_amdgcn_rcpf(1.0f + __expf(-v1[e])); } }
                    u32x4 w; w.x = cvt_pk_bf16(v0[0], v0[1]); w.y = cvt_pk_bf16(v0[2], v0[3]); w.z = cvt_pk_bf16(v1[0], v1[1]); w.w = cvt_pk_bf16(v1[2], v1[3]);
                    *(u32x4*)(rowp + bj * HALF) = w; } }
    }
};
template <bool ACCUM> struct EpiGate {
    static constexpr bool PERM = true;
    bf16_t* Z; const bf16_t* G; int ldg; float os; unsigned char* Z8;
    __device__ __forceinline__ void operator()(const f32x4 (&acc)[2][2][4][2], const Unit& u, int wr, int wc, int fr, int fq) const {
        const int row0 = u.pm * BM + wr * 64 + fr, col0 = u.pn * BM + wc * 32 + 8 * fq;
#pragma unroll
        for (int ai = 0; ai < 2; ++ai)
#pragma unroll
            for (int m = 0; m < 4; ++m) { const size_t r = (size_t)(row0 + ai * HALF + m * 16);
#pragma unroll
                for (int bj = 0; bj < 2; ++bj) { const f32x4 v0 = acc[ai][bj][m][0], v1 = acc[ai][bj][m][1];
                    const u32x4 gw = *(const u32x4*)(G + r * ldg + col0 + bj * HALF);
                    float o[8] = { v0[0] * os * bflo(gw.x), v0[1] * os * bfhi(gw.x), v0[2] * os * bflo(gw.y), v0[3] * os * bfhi(gw.y), v1[0] * os * bflo(gw.z), v1[1] * os * bfhi(gw.z), v1[2] * os * bflo(gw.w), v1[3] * os * bfhi(gw.w) };
                    bf16_t* zp = Z + r * D + col0 + bj * HALF;
                    if (ACCUM) { const u32x4 zw = *(const u32x4*)zp; o[0] += bflo(zw.x); o[1] += bfhi(zw.x); o[2] += bflo(zw.y); o[3] += bfhi(zw.y); o[4] += bflo(zw.z); o[5] += bfhi(zw.z); o[6] += bflo(zw.w); o[7] += bfhi(zw.w); }
                    if (ACCUM) { u32x2 w8; w8.x = pk4_fp8(o[0] * Z_S, o[1] * Z_S, o[2] * Z_S, o[3] * Z_S); w8.y = pk4_fp8(o[4] * Z_S, o[5] * Z_S, o[6] * Z_S, o[7] * Z_S); *(u32x2*)(Z8 + r * D + col0 + bj * HALF) = w8; }
                    else { u32x4 w; w.x = cvt_pk_bf16(o[0], o[1]); w.y = cvt_pk_bf16(o[2], o[3]); w.z = cvt_pk_bf16(o[4], o[5]); w.w = cvt_pk_bf16(o[6], o[7]); *(u32x4*)zp = w; } } }
    }
};
struct EpiRes {
    static constexpr bool PERM = true;
    bf16_t* T; const float* xp; const float* xs; const float* ada; float os;
    __device__ __forceinline__ void operator()(const f32x4 (&acc)[2][2][4][2], const Unit& u, int wr, int wc, int fr, int fq) const {
        const int row0 = u.pm * BM + wr * 64 + fr, col0 = u.pn * BM + wc * 32 + 8 * fq;
#pragma unroll
        for (int ai = 0; ai < 2; ++ai)
#pragma unroll
            for (int m = 0; m < 4; ++m) { const int r = row0 + ai * HALF + m * 16;
                const float* xrow = r < MP ? xp + (size_t)r * D : xs + (size_t)(r - MP) * D;
                const int b = r < MP ? (r >> 12) : BATCH + ((r - MP) >> 3);
                const float* g1 = ada + (size_t)b * (6 * D) + 2 * D;
#pragma unroll
                for (int bj = 0; bj < 2; ++bj) { const int c = col0 + bj * HALF;
                    const f32x4 x0 = *(const f32x4*)(xrow + c), x1 = *(const f32x4*)(xrow + c + 4), g0 = *(const f32x4*)(g1 + c), g4 = *(const f32x4*)(g1 + c + 4);
                    const f32x4 v0 = x0 * ALPHA + g0 * (acc[ai][bj][m][0] * os), v1 = x1 * ALPHA + g4 * (acc[ai][bj][m][1] * os);
                    u32x4 w; w.x = cvt_pk_bf16(v0[0], v0[1]); w.y = cvt_pk_bf16(v0[2], v0[3]); w.z = cvt_pk_bf16(v1[0], v1[1]); w.w = cvt_pk_bf16(v1[2], v1[3]);
                    *(u32x4*)(T + (size_t)r * D + c) = w; } }
    }
};
struct EpiPlain {
    static constexpr bool PERM = true;
    bf16_t* O; float os;
    __device__ __forceinline__ void operator()(const f32x4 (&acc)[2][2][4][2], const Unit& u, int wr, int wc, int fr, int fq) const {
        const int row0 = u.pm * BM + wr * 64 + fr, col0 = u.pn * BM + wc * 32 + 8 * fq;
#pragma unroll
        for (int ai = 0; ai < 2; ++ai)
#pragma unroll
            for (int m = 0; m < 4; ++m) { bf16_t* rowp = O + (size_t)(row0 + ai * HALF + m * 16) * D + col0;
#pragma unroll
                for (int bj = 0; bj < 2; ++bj) { const f32x4 v0 = acc[ai][bj][m][0] * os, v1 = acc[ai][bj][m][1] * os;
                    u32x4 w; w.x = cvt_pk_bf16(v0[0], v0[1]); w.y = cvt_pk_bf16(v0[2], v0[3]); w.z = cvt_pk_bf16(v1[0], v1[1]); w.w = cvt_pk_bf16(v1[2], v1[3]);
                    *(u32x4*)(rowp + bj * HALF) = w; } }
    }
};
}

#define XB_TMO      128
#define XB_XCNT(j)  (256  + 64 * (j))
#define XB_XSUB(j)  (1280 + 64 * (j))
#define XB_XGEN(j)  (2304 + 64 * (j))
#define XB_TOP      3328
#define XB_TOPGEN   3392
#define XCD_BAR_WORDS 3456
#define XB_SPIN_CAP (1u << 22)
__device__ __forceinline__ unsigned xb_ld(unsigned* p)              { return __hip_atomic_load(p, __ATOMIC_RELAXED, __HIP_MEMORY_SCOPE_AGENT); }
__device__ __forceinline__ unsigned xb_add(unsigned* p, unsigned v) { return __hip_atomic_fetch_add(p, v, __ATOMIC_RELAXED, __HIP_MEMORY_SCOPE_AGENT); }
__device__ __forceinline__ unsigned xb_xcc_id() { return (unsigned)__builtin_amdgcn_s_getreg((3 << 11) | 20) & 0xFu; }
#define XB_SPIN(cond, bar) do { unsigned _sp = 0; while (cond) { __builtin_amdgcn_s_sleep(1); \
    if ((++_sp & 255u) == 0u) { if (xb_ld(&(bar)[XB_TMO])) break; if (_sp > XB_SPIN_CAP) { atomicAdd(&(bar)[XB_TMO], 1u); break; } } } } while (0)
struct XcdBarrier { unsigned* bar; unsigned x; volatile LAS unsigned* st; };
__device__ __forceinline__ XcdBarrier xcd_barrier_post(unsigned* bar, volatile LAS unsigned* st) {
    XcdBarrier b; b.bar = bar; b.x = xb_xcc_id(); b.st = st;
    if (threadIdx.x == 0) (void)xb_add(&bar[XB_XCNT(b.x)], 1u);
    return b;
}
__device__ __forceinline__ void xcd_barrier_complete(unsigned* bar, unsigned x, unsigned& nloc, unsigned& nx) {
    const unsigned G = gridDim.x * gridDim.y * gridDim.z;
    unsigned sum, cnt, mine, sp = 0u;
    for (;;) {
        sum = 0u; cnt = 0u; mine = 0u;
#pragma unroll
        for (unsigned j = 0; j < 16; ++j) { const unsigned c = xb_ld(&bar[XB_XCNT(j)]); sum += c; cnt += (c > 0u) ? 1u : 0u; mine = (j == x) ? c : mine; }
        if (sum == G) break;
        __builtin_amdgcn_s_sleep(1);
        if ((++sp & 255u) == 0u) { if (xb_ld(&bar[XB_TMO])) break; if (sp > XB_SPIN_CAP) { atomicAdd(&bar[XB_TMO], 1u); break; } }
    }
    nloc = mine > 0u ? mine : 1u; nx = cnt > 0u ? cnt : 1u;
}
__device__ __forceinline__ void xcd_barrier(const XcdBarrier& b) {
    asm volatile("s_waitcnt vmcnt(0)" ::: "memory");
    __syncthreads();
    if (threadIdx.x == 0) {
        unsigned* bar = b.bar;
        __builtin_amdgcn_s_waitcnt(0);
        unsigned nloc = b.st[0], nx = b.st[1];
        if (nloc == 0u) { xcd_barrier_complete(bar, b.x, nloc, nx); b.st[0] = nloc; b.st[1] = nx; }
        const unsigned old = xb_add(&bar[XB_XSUB(b.x)], 1u);
        const unsigned gen = old / nloc;
        if (old + 1u == (gen + 1u) * nloc) {
            __builtin_amdgcn_fence(__ATOMIC_RELEASE, "agent");
            asm volatile("s_waitcnt vmcnt(0)" ::: "memory");
            const unsigned og = xb_add(&bar[XB_TOP], 1u);
            const unsigned tg = og / nx;
            if (og + 1u == (tg + 1u) * nx) xb_add(&bar[XB_TOPGEN], 1u);
            else XB_SPIN(xb_ld(&bar[XB_TOPGEN]) == tg, bar);
            __builtin_amdgcn_fence(__ATOMIC_ACQUIRE, "agent");
            xb_add(&bar[XB_XGEN(b.x)], 1u);
            asm volatile("s_waitcnt vmcnt(0)" ::: "memory");
        } else {
            XB_SPIN(xb_ld(&bar[XB_XGEN(b.x)]) == gen, bar);
            __builtin_amdgcn_fence(__ATOMIC_ACQUIRE, "agent");
            asm volatile("s_waitcnt vmcnt(0)" ::: "memory");
        }
    }
    __syncthreads();
}

struct Args { const float* in[31]; float* out; unsigned char* ws; int ph_lo, ph_hi, flags, pad; };
typedef const __attribute__((address_space(4))) Args CArgs;

struct Ctx {
    LAS unsigned char* lds;
    int tid, lane, wave, vcu, G;
};

__device__ __forceinline__ void p0_silu_c(const Ctx& X, const float* cP, const float* cS, bf16_t* SC) {
    for (int i = blockIdx.x * NTHREADS + X.tid; i < 144 * (D / 4); i += X.G * NTHREADS) { const int r = i / (D / 4), k4 = i % (D / 4);
        f32x4 cv = (f32x4){0.f, 0.f, 0.f, 0.f};
        if (r < NB) { const float* cr = r < BATCH ? cP + (size_t)r * D : cS + (size_t)(r - BATCH) * D; cv = *(const f32x4*)(cr + 4 * k4);
#pragma unroll
            for (int j = 0; j < 4; ++j) cv[j] = cv[j] * __builtin_amdgcn_rcpf(1.0f + __expf(-cv[j])); }
        u32x2 pw; pw.x = pk2(cv[0], cv[1]); pw.y = pk2(cv[2], cv[3]); *(u32x2*)(SC + (size_t)r * D + 4 * k4) = pw; }
}
__device__ __forceinline__ void p0_ada(const Ctx& X, const bf16_t* SC, const float* w_ada, const float* b_ada, float* ADA) {
    constexpr int NA = 6 * D;
    const int lane = X.lane, w = X.wave, fr = lane & 15, fq = lane >> 4;
    LAS float* red = (LAS float*)X.lds;
    for (int cb = X.vcu; cb < NA / 48; cb += X.G) {
        const int n0 = cb * 48;
        f32x4 acc[9][3];
#pragma unroll
        for (int i = 0; i < 9; ++i)
#pragma unroll
            for (int j = 0; j < 3; ++j) acc[i][j] = (f32x4){0.f, 0.f, 0.f, 0.f};
        for (int ks = 0; ks < 8; ++ks) {
            const int k0 = w * 256 + ks * 32 + 8 * fq;
            bf16x8 bfr[3];
#pragma unroll
            for (int nt = 0; nt < 3; ++nt) {
                float t[8];
#pragma unroll
                for (int j = 0; j < 8; ++j) t[j] = w_ada[(size_t)(k0 + j) * NA + n0 + nt * 16 + fr];
                u32x4 p; p.x = pk2(t[0], t[1]); p.y = pk2(t[2], t[3]); p.z = pk2(t[4], t[5]); p.w = pk2(t[6], t[7]);
                bfr[nt] = __builtin_bit_cast(bf16x8, p);
            }
            { const bf16_t* sc = SC + (size_t)fr * D + w * 256 + ks * 32 + 8 * fq;
              bf16x8 afr[9];
#pragma unroll
              for (int mt = 0; mt < 9; ++mt) afr[mt] = *(const bf16x8*)(sc + (size_t)mt * 16 * D);
#pragma unroll
              for (int mt = 0; mt < 9; ++mt)
#pragma unroll
                  for (int nt = 0; nt < 3; ++nt) acc[mt][nt] = __builtin_amdgcn_mfma_f32_16x16x32_bf16(afr[mt], bfr[nt], acc[mt][nt], 0, 0, 0); }
        }
        for (int rnd = 0; rnd < 8; ++rnd) {
            if (w == rnd) {
#pragma unroll
                for (int mt = 0; mt < 9; ++mt)
#pragma unroll
                    for (int nt = 0; nt < 3; ++nt)
#pragma unroll
                        for (int e = 0; e < 4; ++e) { const int idx = (mt * 16 + 4 * fq + e) * 48 + nt * 16 + fr; red[idx] = (rnd == 0 ? 0.f : red[idx]) + acc[mt][nt][e]; }
            }
            __syncthreads();
        }
        for (int i = X.tid; i < NB * 48; i += NTHREADS) { const int r = i / 48, c = i % 48; ADA[(size_t)r * NA + n0 + c] = red[r * 48 + c] + b_ada[n0 + c]; }
        __syncthreads();
    }
}
__device__ __forceinline__ void p0_transpose_item(const float* W, int ldw, int srccol, int k0, bf16_t* WT, int K, int dstrow, LAS float* scr, int lane, unsigned char* WF8 = nullptr) {
    { f32x4 t[8];
#pragma unroll
      for (int i = 0; i < 8; ++i) t[i] = *(const f32x4*)(W + (size_t)(k0 + 8 * i + (lane >> 3)) * ldw + srccol + 4 * (lane & 7));
#pragma unroll
      for (int i = 0; i < 8; ++i) { LAS float* d = scr + (8 * i + (lane >> 3)) * 33 + 4 * (lane & 7); d[0] = t[i][0]; d[1] = t[i][1]; d[2] = t[i][2]; d[3] = t[i][3]; } }
    LDS_WAIT(); asm volatile("" ::: "memory");
    const int c = lane & 7;
#pragma unroll
    for (int j = 0; j < (WT ? 4 : 0); ++j) { const int n = (lane >> 3) + 8 * j; const LAS float* s = scr + (8 * c) * 33 + n;
        u32x4 o; o.x = pk2(s[0 * 33], s[1 * 33]); o.y = pk2(s[2 * 33], s[3 * 33]); o.z = pk2(s[4 * 33], s[5 * 33]); o.w = pk2(s[6 * 33], s[7 * 33]);
        *(u32x4*)(WT + (size_t)(dstrow + n) * K + k0 + 8 * c) = o; }
    if (WF8) {
        const int c4 = lane & 3;
#pragma unroll
        for (int j = 0; j < 2; ++j) { const int n = (lane >> 2) + 16 * j; const LAS float* sp = scr + (16 * c4) * 33 + n; u32x4 o;
#pragma unroll
            for (int q = 0; q < 4; ++q) o[q] = pk4_fp8(sp[(4 * q) * 33] * W_S, sp[(4 * q + 1) * 33] * W_S, sp[(4 * q + 2) * 33] * W_S, sp[(4 * q + 3) * 33] * W_S);
            *(u32x4*)(WF8 + (size_t)(dstrow + n) * K + k0 + 16 * c4) = o; } }
    LDS_WAIT(); asm volatile("" ::: "memory");
}
__device__ __forceinline__ void p0_transposes(const Ctx& X, CArgs& a) {
    unsigned char* ws = a.ws;
    LAS float* scr = (LAS float*)(X.lds + 32768 + X.wave * 8704);
    const int gw = X.vcu * NWAVES + X.wave, NGW = X.G * NWAVES;
    constexpr int I_IN = (D / 64) * (NW / 32), I_SQ = (D / 64) * (D / 32);
    bf16_t* WinT = (bf16_t*)(ws + WS_WINT); bf16_t* W4T = (bf16_t*)(ws + WS_W4T);
    for (int it = gw; it < I_IN + 4 * I_SQ; it += NGW) {
        if (it < I_IN) { const int nblk = NW / 32, kb = it / nblk, nb = it % nblk; const int n0 = nb * 32; const int src = n0 < SRC_MIF ? n0 : n0 + 8;
            const bool soft = n0 < C_AK || n0 >= C_MO;
            p0_transpose_item(a.in[13], INW, src, kb * 64, soft ? nullptr : WinT, D, n0, scr, X.lane, ws + WS_WINF8); }
        else { int r = it - I_IN; const int wsel = r / I_SQ; r %= I_SQ; const int nblk = D / 32, kb = r / nblk, nb = r % nblk;
            const float* W = wsel == 0 ? a.in[20] : wsel == 1 ? a.in[21] : wsel == 2 ? a.in[22] : a.in[25];
            p0_transpose_item(W, D, nb * 32, kb * 64, nullptr, D, nb * 32, scr, X.lane, ws + WS_W4F8 + (size_t)wsel * D * D); }
    }
    { bf16_t* SKB = (bf16_t*)(ws + WS_SKB); for (int i = blockIdx.x * NTHREADS + X.tid; i < PH * 2 * NKEYS * 128 / 2; i += X.G * NTHREADS) { const f32x2 v = *(const f32x2*)(a.in[26] + 2 * (size_t)i); ((unsigned*)SKB)[i] = pk2(v.x, v.y); } }
    float* WMIF = (float*)(ws + WS_WMIF);
    for (int i = blockIdx.x * NTHREADS + X.tid; i < 8 * D; i += X.G * NTHREADS) { const int j = i / D, k = i % D; WMIF[i] = a.in[13][(size_t)k * INW + SRC_MIF + j]; }
}


__device__ __forceinline__ void p0_peer_fp8(const Ctx& X, CArgs& a, int part, int wi, int nwk) {
    unsigned char* ws = a.ws; float* PSC = (float*)(ws + WS_PSC);
    const int gw = wi * NWAVES + X.wave, NGW = nwk * NWAVES, lane = X.lane;
    for (int it = part * 8192 + 2 * gw; it < (part + 1) * 8192; it += 2 * NGW) {
        f32x4 v[2][8]; float am[2];
#pragma unroll
        for (int rr = 0; rr < 2; ++rr) { const int tb = (it + rr) >> 14, e = (it + rr) & 16383; const float* src = (tb ? a.in[28] : a.in[27]) + (size_t)e * D + 4 * lane;
#pragma unroll
            for (int i = 0; i < 8; ++i) v[rr][i] = __builtin_nontemporal_load((const f32x4*)(src + 256 * i)); }
#pragma unroll
        for (int rr = 0; rr < 2; ++rr) { float m_ = 0.f;
#pragma unroll
            for (int i = 0; i < 8; ++i) m_ = fmaxf(m_, fmaxf(fmaxf(fabsf(v[rr][i][0]), fabsf(v[rr][i][1])), fmaxf(fabsf(v[rr][i][2]), fabsf(v[rr][i][3]))));
            am[rr] = wave_max(m_); }
#pragma unroll
        for (int rr = 0; rr < 2; ++rr) { const int tb = (it + rr) >> 14, e = (it + rr) & 16383; unsigned char* tbl = ws + (tb ? WS_V8 : WS_U8);
            const float top = tb ? 224.0f : 127.0f;
            const float sc = am[rr] > 0.f ? top / am[rr] : 1.0f;
#pragma unroll
            for (int i = 0; i < 8; ++i) { unsigned p;
                if (tb) { int q = 0; q = __builtin_amdgcn_cvt_pk_fp8_f32(v[rr][i][0] * sc, v[rr][i][1] * sc, q, false); q = __builtin_amdgcn_cvt_pk_fp8_f32(v[rr][i][2] * sc, v[rr][i][3] * sc, q, true); p = (unsigned)q; }
                else p = pk4_i8(v[rr][i][0] * sc, v[rr][i][1] * sc, v[rr][i][2] * sc, v[rr][i][3] * sc);
                *(unsigned*)(tbl + (size_t)(2 * i + (lane >> 5)) * SLAB_BYTES + (size_t)e * 128 + 4 * (lane & 31)) = p; }
            if (lane == 0) PSC[tb * 16384 + e] = am[rr] > 0.f ? am[rr] / top : 1.0f; }
    }
}

__device__ __forceinline__ void p1_rows(const Ctx& X, CArgs& a) {
    unsigned char* ws = a.ws;
    const float* ADA = (const float*)(ws + WS_ADA); const float* WMIF = (const float*)(ws + WS_WMIF);
    float* MIF = (float*)(ws + WS_MIF); bf16_t* H1 = (bf16_t*)(ws + WS_H1);
    LAS float* wl = (LAS float*)X.lds;
    for (int i = X.tid; i < 8 * D / 4; i += NTHREADS) ((LAS f32x4*)wl)[i] = ((const f32x4*)WMIF)[i];
    __syncthreads();
    const int gw = X.vcu * NWAVES + X.wave, NGW = X.G * NWAVES, lane = X.lane;
    for (int m = gw; m < M; m += NGW) {
        const float* xrow = m < MP ? a.in[0] + (size_t)m * D : a.in[1] + (size_t)(m - MP) * D;
        const int b = m < MP ? (m >> 12) : BATCH + ((m - MP) >> 3);
        const float* sh = ADA + (size_t)b * 6 * D; const float* sc = sh + D;
        f32x4 v[8]; float dots[8];
#pragma unroll
        for (int j = 0; j < 8; ++j) dots[j] = 0.f;
#pragma unroll
        for (int j = 0; j < 8; ++j) { const int c = 4 * lane + 256 * j; const f32x4 xv = *(const f32x4*)(xrow + c), s1 = *(const f32x4*)(sc + c), s0 = *(const f32x4*)(sh + c);
            v[j] = xv * (s1 + 1.0f) + s0;
#pragma unroll
            for (int q = 0; q < 8; ++q) { const f32x4 wv = *(const LAS f32x4*)(wl + q * D + c); dots[q] += (v[j][0] * wv[0] + v[j][1] * wv[1]) + (v[j][2] * wv[2] + v[j][3] * wv[3]); }
            asm volatile("" ::: "memory"); }
        u32x2* o8 = (u32x2*)(H1 + (size_t)m * D) + lane; unsigned* o4 = (unsigned*)(ws + WS_H1F8 + (size_t)m * D) + lane;
#pragma unroll
        for (int j = 0; j < 8; ++j) { u32x2 w; w.x = pk2(v[j][0], v[j][1]); w.y = pk2(v[j][2], v[j][3]); o8[64 * j] = w; o4[64 * j] = pk4_fp8(v[j][0] * ACT_S, v[j][1] * ACT_S, v[j][2] * ACT_S, v[j][3] * ACT_S); }
#pragma unroll
        for (int q = 0; q < 8; ++q) dots[q] = wave_sum(dots[q]);
        if (lane < 8) { float d = dots[0];
#pragma unroll
            for (int q = 1; q < 8; ++q) d = (lane == q) ? dots[q] : d;
            float r;
            if (lane < 4) r = d + a.in[14][lane];
            else { const float z = d + a.in[15][lane - 4]; r = fminf(z, 0.f) - log1pf(expf(-fabsf(z))); }
            MIF[(size_t)m * 8 + lane] = r; }
    }
    __syncthreads();
}

__device__ __forceinline__ int t5_bucket(int d) {
    if (d < 16) return d;
    int v = 16 + (int)(logf((float)d / 16.0f) / logf(8.0f) * 16.0f);
    return v < 31 ? v : 31;
}
__device__ __forceinline__ void p3_attention(const Ctx& X, CArgs& a, int wi, int nwk, int mrow0, int nrows) {
    unsigned char* ws = a.ws;
    const bf16_t* BIG = (const bf16_t*)(ws + WS_BIG); bf16_t* ATT = (bf16_t*)(ws + WS_H1);
    LAS float* btab = (LAS float*)X.lds;
    for (int i = X.tid; i < HEADS * 128; i += NTHREADS) { const int h = i >> 7, d = i & 127; btab[i] = a.in[10][t5_bucket(d) * HEADS + h]; }
    __syncthreads();
    const float* ck = a.in[4]; const float* cv = a.in[5];
    const int nitems = nrows * HEADS;
    for (int it = wi * NTHREADS + X.tid; it < nitems; it += nwk * NTHREADS) {
        const int mb = it >> 11, rem = it & 2047, head = rem >> 6, m = mrow0 + mb * 64 + (rem & 63);
        const int kvh = head >> 2;
        float q[64], acc[64];
        { const u32x4* qp = (const u32x4*)(BIG + (size_t)m * NW + C_AQ + head * 64);
#pragma unroll
          for (int j = 0; j < 8; ++j) { const u32x4 w = qp[j]; q[8 * j + 0] = bflo(w.x); q[8 * j + 1] = bfhi(w.x); q[8 * j + 2] = bflo(w.y); q[8 * j + 3] = bfhi(w.y); q[8 * j + 4] = bflo(w.z); q[8 * j + 5] = bfhi(w.z); q[8 * j + 6] = bflo(w.w); q[8 * j + 7] = bfhi(w.w); } }
#pragma unroll
        for (int j = 0; j < 64; ++j) acc[j] = 0.f;
        float mx = a.in[19][head], l = 1.0f;
        const bool prompt = m < MP;
        const int t = prompt ? (m & (SEQ - 1)) : ((m - MP) & 7);
        const int bs = prompt ? 0 : ((m - MP) >> 3);
        const int nk = prompt ? (t < 127 ? t + 1 : 128) : 128;
        for (int dist = 0; dist < nk; ++dist) {
            bool from_cache = false; int crow = 0; size_t brow = 0;
            if (prompt) brow = (size_t)(m - dist);
            else { const int j = t + 128 - dist; if (j < 128) { from_cache = true; crow = j; } else brow = (size_t)(MP + bs * 8 + (j - 128)); }
            float s = 0.f;
            if (from_cache) { const f32x4* kp = (const f32x4*)(ck + (((size_t)bs * 128 + crow) * KVH + kvh) * HD);
#pragma unroll
                for (int j = 0; j < 16; ++j) { const f32x4 w = kp[j]; s += (q[4 * j] * w[0] + q[4 * j + 1] * w[1]) + (q[4 * j + 2] * w[2] + q[4 * j + 3] * w[3]); } }
            else { const u32x4* kp = (const u32x4*)(BIG + brow * NW + C_AK + kvh * 64);
#pragma unroll
                for (int j = 0; j < 8; ++j) { const u32x4 w = kp[j];
                    s += (q[8 * j + 0] * bflo(w.x) + q[8 * j + 1] * bfhi(w.x)) + (q[8 * j + 2] * bflo(w.y) + q[8 * j + 3] * bfhi(w.y)) + (q[8 * j + 4] * bflo(w.z) + q[8 * j + 5] * bfhi(w.z)) + (q[8 * j + 6] * bflo(w.w) + q[8 * j + 7] * bfhi(w.w)); } }
            s = s * 0.125f + btab[head * 128 + dist];
            const float mn = fmaxf(mx, s), sc = expf(mx - mn), p = expf(s - mn);
            l = l * sc + p; mx = mn;
            if (from_cache) { const f32x4* vp = (const f32x4*)(cv + (((size_t)bs * 128 + crow) * KVH + kvh) * HD);
#pragma unroll
                for (int j = 0; j < 16; ++j) { const f32x4 w = vp[j]; acc[4 * j] = acc[4 * j] * sc + p * w[0]; acc[4 * j + 1] = acc[4 * j + 1] * sc + p * w[1]; acc[4 * j + 2] = acc[4 * j + 2] * sc + p * w[2]; acc[4 * j + 3] = acc[4 * j + 3] * sc + p * w[3]; } }
            else { const u32x4* vp = (const u32x4*)(BIG + brow * NW + C_AV + kvh * 64);
#pragma unroll
                for (int j = 0; j < 8; ++j) { const u32x4 w = vp[j];
                    acc[8 * j + 0] = acc[8 * j + 0] * sc + p * bflo(w.x); acc[8 * j + 1] = acc[8 * j + 1] * sc + p * bfhi(w.x); acc[8 * j + 2] = acc[8 * j + 2] * sc + p * bflo(w.y); acc[8 * j + 3] = acc[8 * j + 3] * sc + p * bfhi(w.y);
                    acc[8 * j + 4] = acc[8 * j + 4] * sc + p * bflo(w.z); acc[8 * j + 5] = acc[8 * j + 5] * sc + p * bfhi(w.z); acc[8 * j + 6] = acc[8 * j + 6] * sc + p * bflo(w.w); acc[8 * j + 7] = acc[8 * j + 7] * sc + p * bfhi(w.w); } }
        }
        const float inv = 1.0f / l;
        u32x4* op = (u32x4*)(ATT + (size_t)m * D + head * 64);
#pragma unroll
        for (int j = 0; j < 8; ++j) { u32x4 w; w.x = pk2(acc[8 * j] * inv, acc[8 * j + 1] * inv); w.y = pk2(acc[8 * j + 2] * inv, acc[8 * j + 3] * inv); w.z = pk2(acc[8 * j + 4] * inv, acc[8 * j + 5] * inv); w.w = pk2(acc[8 * j + 6] * inv, acc[8 * j + 7] * inv); op[j] = w; }
    }
    __syncthreads();
}

typedef float f32x16 __attribute__((ext_vector_type(16)));
typedef short s16x4 __attribute__((ext_vector_type(4)));
__device__ __forceinline__ void att_prompt_unit(const Ctx& X, CArgs& a, int b, int kvh, int qb) {
    unsigned char* ws = a.ws; const bf16_t* BIG = (const bf16_t*)(ws + WS_BIG); unsigned char* ATT8 = ws + WS_ATT8;
    LAS bf16_t* Kl = (LAS bf16_t*)X.lds;
    LAS bf16_t* VTl = Kl + 256 * 72;
    LAS float* btl = (LAS float*)(VTl + 64 * 260);
    const int tid = X.tid, lane = X.lane, w = X.wave, r32 = lane & 31, hh = lane >> 5;
    constexpr float L2E = 1.4426950408889634f;
    const size_t krow0 = (size_t)b * SEQ + (size_t)qb * 128 - 128;
    __syncthreads();
#pragma unroll
    for (int i = 0; i < 4; ++i) { const int id = i * NTHREADS + tid, key = id >> 3, seg = id & 7;
        u32x4 kw = (u32x4){0u, 0u, 0u, 0u}, vw = kw;
        if (qb > 0 || key >= 128) { const bf16_t* rp = BIG + (krow0 + key) * NW + kvh * 64 + seg * 8; kw = *(const u32x4*)(rp + C_AK); vw = *(const u32x4*)(rp + C_AV); }
        *(LAS u32x4*)(Kl + key * 72 + seg * 8) = kw;
        LAS bf16_t* vp = VTl + (seg * 8) * 260 + key;
        vp[0] = (bf16_t)(vw.x & 0xffffu); vp[260] = (bf16_t)(vw.x >> 16); vp[2 * 260] = (bf16_t)(vw.y & 0xffffu); vp[3 * 260] = (bf16_t)(vw.y >> 16);
        vp[4 * 260] = (bf16_t)(vw.z & 0xffffu); vp[5 * 260] = (bf16_t)(vw.z >> 16); vp[6 * 260] = (bf16_t)(vw.w & 0xffffu); vp[7 * 260] = (bf16_t)(vw.w >> 16); }
    { const int g = tid >> 7, d = tid & 127; btl[tid] = a.in[10][t5_bucket(d) * HEADS + kvh * 4 + g] * L2E; }
    __syncthreads();
    const int g = w >> 1, qh = w & 1, head = kvh * 4 + g;
    const float sink2 = a.in[19][head] * L2E;
    for (int qt = 0; qt < 2; ++qt) {
        const int qo = qh * 64 + qt * 32;
        const size_t qrow = (size_t)b * SEQ + (size_t)qb * 128 + qo + r32;
        bf16x8 Qf[4];
#pragma unroll
        for (int ks = 0; ks < 4; ++ks) Qf[ks] = *(const bf16x8*)(BIG + qrow * NW + C_AQ + head * 64 + ks * 16 + 8 * hh);
        f32x16 sc[5];
        const int T0 = qo >> 5;
#pragma unroll
        for (int kt = 0; kt < 5; ++kt) {
            f32x16 acc;
#pragma unroll
            for (int r = 0; r < 16; ++r) acc[r] = 0.f;
            const LAS bf16_t* kp = Kl + ((T0 + kt) * 32 + r32) * 72 + 8 * hh;
#pragma unroll
            for (int ks = 0; ks < 4; ++ks) acc = __builtin_amdgcn_mfma_f32_32x32x16_bf16(*(const LAS bf16x8*)(kp + ks * 16), Qf[ks], acc, 0, 0, 0);
            const int dbase = 128 - 32 * kt + r32 - 4 * hh;
            const LAS float* bt = btl + g * 128;
            if (qb == 0 && T0 + kt < 4) {
#pragma unroll
                for (int r = 0; r < 16; ++r) sc[kt][r] = -INFINITY;
            } else if (kt >= 1 && kt <= 3) {
#pragma unroll
                for (int r = 0; r < 16; ++r) sc[kt][r] = acc[r] * (0.125f * L2E) + bt[dbase - ((r & 3) + 8 * (r >> 2))];
            } else {
#pragma unroll
                for (int r = 0; r < 16; ++r) { const int dist = dbase - ((r & 3) + 8 * (r >> 2)); const bool valid = (dist >= 0) && (dist < 128);
                    const int dcl = dist < 0 ? 0 : (dist > 127 ? 127 : dist);
                    sc[kt][r] = valid ? acc[r] * (0.125f * L2E) + bt[dcl] : -INFINITY; }
            }
        }
        float mx = sink2;
#pragma unroll
        for (int kt = 0; kt < 5; ++kt)
#pragma unroll
            for (int r = 0; r < 16; ++r) mx = fmaxf(mx, sc[kt][r]);
        mx = fmaxf(mx, __shfl_xor(mx, 32));
        float lsum = 0.f;
        f32x16 O0, O1;
#pragma unroll
        for (int r = 0; r < 16; ++r) { O0[r] = 0.f; O1[r] = 0.f; }
#pragma unroll
        for (int kt = 0; kt < 5; ++kt) {
            float p[16];
#pragma unroll
            for (int r = 0; r < 16; ++r) { p[r] = __builtin_amdgcn_exp2f(sc[kt][r] - mx); lsum += p[r]; }
#pragma unroll
            for (int s2 = 0; s2 < 2; ++s2) {
                u32x4 pw; pw.x = pk2(p[8 * s2], p[8 * s2 + 1]); pw.y = pk2(p[8 * s2 + 2], p[8 * s2 + 3]); pw.z = pk2(p[8 * s2 + 4], p[8 * s2 + 5]); pw.w = pk2(p[8 * s2 + 6], p[8 * s2 + 7]);
                const bf16x8 pf = __builtin_bit_cast(bf16x8, pw);
                const int kb = (T0 + kt) * 32 + 16 * s2 + 4 * hh;
                const LAS bf16_t* v0 = VTl + r32 * 260 + kb; const LAS bf16_t* v1 = v0 + 32 * 260;
                const s16x4 a0 = *(const LAS s16x4*)v0, a1 = *(const LAS s16x4*)(v0 + 8), b0 = *(const LAS s16x4*)v1, b1 = *(const LAS s16x4*)(v1 + 8);
                const bf16x8 vf0 = (bf16x8){a0[0], a0[1], a0[2], a0[3], a1[0], a1[1], a1[2], a1[3]}, vf1 = (bf16x8){b0[0], b0[1], b0[2], b0[3], b1[0], b1[1], b1[2], b1[3]};
                O0 = __builtin_amdgcn_mfma_f32_32x32x16_bf16(vf0, pf, O0, 0, 0, 0);
                O1 = __builtin_amdgcn_mfma_f32_32x32x16_bf16(vf1, pf, O1, 0, 0, 0);
            }
        }
        lsum += __shfl_xor(lsum, 32);
        lsum += __builtin_amdgcn_exp2f(sink2 - mx);
        const float inv = 1.0f / lsum;
        const float is8 = inv * ACT_S; unsigned char* op = ATT8 + qrow * D + head * 64 + 4 * hh;
#pragma unroll
        for (int gq = 0; gq < 4; ++gq) { *(unsigned*)(op + 8 * gq) = pk4_fp8(O0[4 * gq] * is8, O0[4 * gq + 1] * is8, O0[4 * gq + 2] * is8, O0[4 * gq + 3] * is8);
            *(unsigned*)(op + 32 + 8 * gq) = pk4_fp8(O1[4 * gq] * is8, O1[4 * gq + 1] * is8, O1[4 * gq + 2] * is8, O1[4 * gq + 3] * is8); }
    }
}
__device__ __forceinline__ void p4_attention(const Ctx& X, CArgs& a, int wi, int nwk) {
#ifndef NO_MFMA_ATT
    for (int u = ATT_P3 + wi; u < BATCH * KVH * (SEQ / 128); u += nwk) { const int qb = u & 31, kvh = (u >> 5) & 7, b = u >> 8; att_prompt_unit(X, a, b, kvh, qb); }
#endif
    __syncthreads();

}


__device__ __forceinline__ bf16x8 cvt8(const f32x4 x, const f32x4 y) { u32x4 p; p.x = pk2(x[0], x[1]); p.y = pk2(x[2], x[3]); p.z = pk2(y[0], y[1]); p.w = pk2(y[2], y[3]); return __builtin_bit_cast(bf16x8, p); }
__device__ __forceinline__ void att_sample_wave(const Ctx& X, CArgs& a, int b, int kvh, const LAS float* btab  ) {
    unsigned char* ws = a.ws; const bf16_t* BIG = (const bf16_t*)(ws + WS_BIG); unsigned char* ATT8 = ws + WS_ATT8;
    const int lane = X.lane, r32 = lane & 31, hh = lane >> 5;
    constexpr float L2E = 1.4426950408889634f;
    const int g = r32 >> 3, t = r32 & 7, head = kvh * 4 + g;
    const size_t qrow = (size_t)MP + b * 8 + t;
    const float sink2 = a.in[19][head] * L2E;
    const char* ckb = (const char*)(a.in[4] + (((size_t)b * 128) * KVH + kvh) * HD);
    const char* cvb = (const char*)(a.in[5] + (((size_t)b * 128) * KVH + kvh) * HD);
    const char* nkb = (const char*)(BIG + ((size_t)MP + b * 8) * NW + C_AK + kvh * 64);
    const char* nvb = (const char*)(BIG + ((size_t)MP + b * 8) * NW + C_AV + kvh * 64);
    const unsigned loK = (unsigned)(r32 * 2048 + hh * 32), loV = (unsigned)(hh * 4 * 2048 + r32 * 4), loNK = (unsigned)((r32 & 7) * NW * 2 + hh * 16), loNV = (unsigned)(r32 * 2);
    bf16x8 Qf[4];
#pragma unroll
    for (int ks = 0; ks < 4; ++ks) Qf[ks] = *(const bf16x8*)(BIG + qrow * NW + C_AQ + head * 64 + ks * 16 + 8 * hh);
    f32x16 sc[5];
#pragma unroll
    for (int kt = 0; kt < 5; ++kt) {
        f32x16 acc;
#pragma unroll
        for (int r = 0; r < 16; ++r) acc[r] = 0.f;
#pragma unroll
        for (int ks = 0; ks < 4; ++ks) {
            bf16x8 kf;
            if (kt < 4) { const char* kp = ckb + (size_t)kt * 32 * 2048 + ks * 64; kf = cvt8(*(const f32x4*)(kp + loK), *(const f32x4*)(kp + loK + 16)); }
            else { u32x4 z = (u32x4){0u, 0u, 0u, 0u}; if (r32 < 8) z = *(const u32x4*)(nkb + ks * 32 + loNK); kf = __builtin_bit_cast(bf16x8, z); }
            acc = __builtin_amdgcn_mfma_f32_32x32x16_bf16(kf, Qf[ks], acc, 0, 0, 0);
        }
#pragma unroll
        for (int r = 0; r < 16; ++r) { const int jj = kt * 32 + (r & 3) + 8 * (r >> 2) + 4 * hh; const int dist = t + 128 - jj; const bool valid = (dist >= 0) && (dist < 128);
            const int dcl = dist < 0 ? 0 : (dist > 127 ? 127 : dist);
            sc[kt][r] = valid ? acc[r] * (0.125f * L2E) + btab[head * 128 + dcl] : -INFINITY; }
        asm volatile("" ::: "memory");
    }
    float mx = sink2;
#pragma unroll
    for (int kt = 0; kt < 5; ++kt)
#pragma unroll
        for (int r = 0; r < 16; ++r) mx = fmaxf(mx, sc[kt][r]);
    mx = fmaxf(mx, __shfl_xor(mx, 32));
    float lsum = 0.f; f32x16 O0, O1;
#pragma unroll
    for (int r = 0; r < 16; ++r) { O0[r] = 0.f; O1[r] = 0.f; }
#pragma unroll
    for (int kt = 0; kt < 5; ++kt) {
        float p[16];
#pragma unroll
        for (int r = 0; r < 16; ++r) { p[r] = __builtin_amdgcn_exp2f(sc[kt][r] - mx); lsum += p[r]; }
#pragma unroll
        for (int s2 = 0; s2 < 2; ++s2) {
            if (kt == 4 && s2 == 1) continue;
            u32x4 pw; pw.x = pk2(p[8 * s2], p[8 * s2 + 1]); pw.y = pk2(p[8 * s2 + 2], p[8 * s2 + 3]); pw.z = pk2(p[8 * s2 + 4], p[8 * s2 + 5]); pw.w = pk2(p[8 * s2 + 6], p[8 * s2 + 7]);
            const bf16x8 pf = __builtin_bit_cast(bf16x8, pw);
            float v0[8], v1[8];
#pragma unroll
            for (int e = 0; e < 8; ++e) { const int ju = kt * 32 + 16 * s2 + 8 * (e >> 2) + (e & 3);
                if (kt < 4) { const char* vp = cvb + (size_t)ju * 2048; v0[e] = *(const float*)(vp + loV); v1[e] = *(const float*)(vp + loV + 128); }
                else if (ju < 136) { const char* vp = nvb + (size_t)(ju - 128) * NW * 2;
                    v0[e] = bf2f(*(const bf16_t*)(vp + (size_t)hh * 4 * NW * 2 + loNV)); v1[e] = bf2f(*(const bf16_t*)(vp + (size_t)hh * 4 * NW * 2 + loNV + 64)); }
                else { v0[e] = 0.f; v1[e] = 0.f; } }
            u32x4 a0, a1; a0.x = pk2(v0[0], v0[1]); a0.y = pk2(v0[2], v0[3]); a0.z = pk2(v0[4], v0[5]); a0.w = pk2(v0[6], v0[7]); a1.x = pk2(v1[0], v1[1]); a1.y = pk2(v1[2], v1[3]); a1.z = pk2(v1[4], v1[5]); a1.w = pk2(v1[6], v1[7]);
            O0 = __builtin_amdgcn_mfma_f32_32x32x16_bf16(__builtin_bit_cast(bf16x8, a0), pf, O0, 0, 0, 0);
            O1 = __builtin_amdgcn_mfma_f32_32x32x16_bf16(__builtin_bit_cast(bf16x8, a1), pf, O1, 0, 0, 0);
            asm volatile("" ::: "memory");
        }
    }
    lsum += __shfl_xor(lsum, 32);
    lsum += __builtin_amdgcn_exp2f(sink2 - mx);
    const float inv = 1.0f / lsum;
    const float is8 = inv * ACT_S; unsigned char* op = ATT8 + qrow * D + head * 64 + 4 * hh;
#pragma unroll
    for (int gq = 0; gq < 4; ++gq) { *(unsigned*)(op + 8 * gq) = pk4_fp8(O0[4 * gq] * is8, O0[4 * gq + 1] * is8, O0[4 * gq + 2] * is8, O0[4 * gq + 3] * is8);
        *(unsigned*)(op + 32 + 8 * gq) = pk4_fp8(O1[4 * gq] * is8, O1[4 * gq + 1] * is8, O1[4 * gq + 2] * is8, O1[4 * gq + 3] * is8); }
}
__device__ __forceinline__ void p3_sample_attention(const Ctx& X, CArgs& a, int wi, int nwk) {
    LAS float* btab = (LAS float*)X.lds;
    __syncthreads();
    for (int i = X.tid; i < HEADS * 128; i += NTHREADS) { const int h = i >> 7, d = i & 127; btab[i] = a.in[10][t5_bucket(d) * HEADS + h] * 1.4426950408889634f; }
    __syncthreads();
    const int gw = wi * NWAVES + X.wave, NGW = nwk * NWAVES;
    for (int u = gw; u < DEC_BATCH * KVH; u += NGW) att_sample_wave(X, a, u >> 3, u & 7, btab);
    __syncthreads();
}

__device__ __forceinline__ void p3_state_copies(const Ctx& X, CArgs& a, int wi, int nwk) {
    const bf16_t* BIG = (const bf16_t*)(a.ws + WS_BIG); float* out = a.out;
    const int gt = wi * NTHREADS + X.tid, GT = nwk * NTHREADS;
    auto bf4 = [](const bf16_t* p) { const u32x2 w = *(const u32x2*)p; return (f32x4){bflo(w.x), bfhi(w.x), bflo(w.y), bfhi(w.y)}; };
    for (int i = gt; i < 4 * 128 * 128; i += GT) { const int c4 = (i & 127) * 4, w = (i >> 7) & 127, b = i >> 14; const size_t r = (size_t)b * SEQ + (SEQ - 128) + w; const size_t o = ((size_t)(b * 128 + w)) * 512 + c4;
        *(f32x4*)(out + O_KWP + o) = bf4(BIG + r * NW + C_AK + c4); *(f32x4*)(out + O_VWP + o) = bf4(BIG + r * NW + C_AV + c4); }
    for (int i = gt; i < 128 * 128 * 128; i += GT) { const int c4 = (i & 127) * 4, w = (i >> 7) & 127, b = i >> 14; const size_t o = ((size_t)(b * 128 + w)) * 512 + c4;
        if (w < 120) { const size_t sidx = ((size_t)b * 128 + w + 8) * 512 + c4; __builtin_nontemporal_store(__builtin_nontemporal_load((const f32x4*)(a.in[4] + sidx)), (f32x4*)(out + O_KWS + o)); __builtin_nontemporal_store(__builtin_nontemporal_load((const f32x4*)(a.in[5] + sidx)), (f32x4*)(out + O_VWS + o)); }
        else { const size_t r = (size_t)MP + b * 8 + (w - 120); *(f32x4*)(out + O_KWS + o) = bf4(BIG + r * NW + C_AK + c4); *(f32x4*)(out + O_VWS + o) = bf4(BIG + r * NW + C_AV + c4); } }
    for (int i = gt; i < 4 * 3 * 512; i += GT) { const int c4 = (i & 511) * 4, j = (i >> 9) % 3, b = i / (3 * 512); *(f32x4*)(out + O_CONVP + ((size_t)(b * 3 + j)) * 2048 + c4) = bf4(BIG + ((size_t)b * SEQ + SEQ - 3 + j) * NW + C_MQK + c4); }
    for (int i = gt; i < 128 * 3 * 512; i += GT) { const int c4 = (i & 511) * 4, j = (i >> 9) % 3, b = i / (3 * 512); *(f32x4*)(out + O_CONVS + ((size_t)(b * 3 + j)) * 2048 + c4) = bf4(BIG + ((size_t)MP + b * 8 + 5 + j) * NW + C_MQK + c4); }
}

__device__ __forceinline__ void mlstm_unit(const Ctx& X, CArgs& a, size_t row0, int T, int h, int vs,
                                           const float* C0, const float* n0, const float* m0p, const float* convbuf  ,
                                           float* Cout, float* nout, float* mout) {
    unsigned char* ws = a.ws;
    const bf16_t* BIG = (const bf16_t*)(ws + WS_BIG); const float* MIF = (const float*)(ws + WS_MIF); bf16_t* HRAW = (bf16_t*)(ws + WS_HMO);
    LAS float* qk = (LAS float*)X.lds;
    LAS float* red = qk + 512;
    LAS float* nred = red + 512;
    const int tid = X.tid, g = tid >> 6, dv = tid & 63;
    const int ch = tid < 256 ? h * 256 + tid : 1024 + h * 256 + (tid - 256);
    const float w0 = a.in[16][ch], w1 = a.in[16][2048 + ch], w2 = a.in[16][4096 + ch], w3 = a.in[16][6144 + ch], cb = a.in[17][ch];
    float x1 = 0.f, x2 = 0.f, x3 = 0.f;
    if (convbuf) { x3 = convbuf[ch]; x2 = convbuf[2048 + ch]; x1 = convbuf[4096 + ch]; }
    float C[32], nn = 0.f, mprev = 0.f;
#pragma unroll
    for (int j = 0; j < 32; ++j) C[j] = C0 ? C0[(size_t)(32 * g + j) * DV + vs * 64 + dv] : 0.f;
    if (n0 && tid < 256) nn = n0[tid];
    if (m0p) mprev = m0p[0];
    for (int t0 = 0; t0 < T; t0 += 8) {
        float xin[8], vin[8], ig_[8], lf_[8];
#pragma unroll
        for (int u = 0; u < 8; ++u) { const size_t r = row0 + t0 + u;
            xin[u] = bf2f(BIG[r * NW + C_MQK + ch]); vin[u] = bf2f(BIG[r * NW + C_MV + h * DV + vs * 64 + dv]);
            ig_[u] = MIF[r * 8 + h]; lf_[u] = MIF[r * 8 + 4 + h]; }
#pragma unroll
        for (int u = 0; u < 8; ++u) {
            const float x0 = xin[u];
            float y = cb + x3 * w0; y = y + x2 * w1; y = y + x1 * w2; y = y + x0 * w3;
            x3 = x2; x2 = x1; x1 = x0;
            float sv = y / (1.0f + expf(-y));
            if (tid >= 256) sv *= 0.0625f;
            qk[tid] = sv;
            __syncthreads();
            const float mnew = fmaxf(lf_[u] + mprev, ig_[u]);
            const float fg = expf(lf_[u] + mprev - mnew), ig = expf(ig_[u] - mnew);
            const float iv = ig * vin[u];
            float ph = 0.f;
#pragma unroll
            for (int j = 0; j < 32; ++j) { const float kk = qk[256 + 32 * g + j], qq = qk[32 * g + j]; C[j] = fg * C[j] + kk * iv; ph += qq * C[j]; }
            red[g * 64 + dv] = ph;
            if (tid < 256) { nn = fg * nn + ig * qk[256 + tid]; float pn = qk[tid] * nn; pn = wave_sum(pn); if (X.lane == 0) nred[X.wave] = pn; }
            __syncthreads();
            if (tid < 64) { float hs = 0.f;
#pragma unroll
                for (int gg = 0; gg < 8; ++gg) hs += red[gg * 64 + tid];
                const float qn = (nred[0] + nred[1]) + (nred[2] + nred[3]);
                const float den = fmaxf(fabsf(qn), expf(-mnew));
                HRAW[(row0 + t0 + u) * D + h * DV + vs * 64 + tid] = (bf16_t)f2bf(hs / den); }
            mprev = mnew;
        }
    }
#pragma unroll
    for (int j = 0; j < 32; ++j) Cout[(size_t)(32 * g + j) * DV + vs * 64 + dv] = C[j];
    if (vs == 0) { if (tid < 256) nout[tid] = nn; if (tid == 0) mout[0] = mprev; }
    __syncthreads();
}
__device__ __forceinline__ void p3_mlstm(const Ctx& X, CArgs& a) {
    float* out = a.out;
    constexpr int NPU = BATCH * MLH * 8, NSU = DEC_BATCH * MLH * 8;
    for (int u = X.vcu; u < NPU + NSU; u += X.G) {
        if (u < NPU) { const int b = u >> 5, h = (u >> 3) & 3, vs = u & 7;
            mlstm_unit(X, a, (size_t)b * SEQ, SEQ, h, vs, nullptr, nullptr, nullptr, nullptr,
                       out + O_CP + (size_t)(b * MLH + h) * DK * DV, out + O_NP + (size_t)(b * MLH + h) * DK, out + O_MPO + b * MLH + h); }
        else { const int v = u - NPU, b = v >> 5, h = (v >> 3) & 3, vs = v & 7; const size_t bh = (size_t)b * MLH + h;
            mlstm_unit(X, a, (size_t)MP + b * 8, 8, h, vs, a.in[7] + bh * DK * DV, a.in[8] + bh * DK, a.in[9] + bh, a.in[6] + (size_t)b * 3 * 2048,
                       out + O_CS + bh * DK * DV, out + O_NS + bh * DK, out + O_MSO + bh); }
    }
}

__device__ __forceinline__ void p2_gates(const Ctx& X, CArgs& a, int bh) {
    unsigned char* ws = a.ws; const float* MIF = (const float*)(ws + WS_MIF); float* MG = (float*)(ws + WS_MG);
    LAS float* li = (LAS float*)X.lds; LAS float* lf = li + 64 * 65; LAS float* lbc = lf + 64 * 65; LAS float* lrm = lbc + 64 * 65;
    LAS float* lcb = lrm + 64 * 65; LAS float* lcg = lcb + 64; LAS float* lms = lcg + 64;
    const int b = bh >> 2, h = bh & 3, tid = X.tid;
    for (int t = tid; t < SEQ; t += NTHREADS) { const size_t r = (size_t)b * SEQ + t; const int idx = (t >> 6) * 65 + (t & 63); li[idx] = MIF[r * 8 + h]; lf[idx] = MIF[r * 8 + 4 + h]; }
    __syncthreads();
    if (tid < 64) { float bc = 0.f, rm = -3.0e38f;
        for (int t = 0; t < 64; ++t) { const int idx = tid * 65 + t; bc += lf[idx]; const float g = li[idx] - bc; rm = fmaxf(rm, g); lbc[idx] = bc; lrm[idx] = rm; }
        lcb[tid] = bc; lcg[tid] = rm; }
    __syncthreads();
    if (tid == 0) { float m = 0.f; lms[0] = 0.f; for (int c = 0; c < 64; ++c) { m = lcb[c] + fmaxf(m, lcg[c]); lms[c + 1] = m; } }
    __syncthreads();
    for (int t = tid; t < SEQ; t += NTHREADS) { const int c = t >> 6, idx = c * 65 + (t & 63); const float mprev = lms[c], mc = lms[c + 1], bc = lbc[idx], iv = li[idx];
        const float mt = bc + fmaxf(mprev, lrm[idx]); const size_t o = (size_t)bh * SEQ + t;
        MG[MG_A1 + o] = bc - mt; MG[MG_G + o] = iv - bc; MG[MG_WIN + o] = expf(bc + mprev - mt); MG[MG_EMI + o] = expf(-mt); MG[MG_WK + o] = expf(lcb[c] - bc + iv - mc); }
    if (tid < 64) MG[MG_DEC + bh * 64 + tid] = expf(lcb[tid] + lms[tid] - lms[tid + 1]);
    if (tid == 0) a.out[O_MPO + bh] = lms[64];
    __syncthreads();
}

__device__ __forceinline__ void m1_prep_unit(const Ctx& X, CArgs& a, int bh, int c) {
    unsigned char* ws = a.ws; const bf16_t* BIG = (const bf16_t*)(ws + WS_BIG); const float* MG = (const float*)(ws + WS_MG);
    bf16_t* QC = (bf16_t*)(ws + WS_QC); bf16_t* KWT = (bf16_t*)(ws + WS_KWT); bf16_t* VT = (bf16_t*)(ws + WS_VT); bf16_t* SM = (bf16_t*)(ws + WS_SM);
    LAS bf16_t* qs = (LAS bf16_t*)X.lds; LAS bf16_t* ksl = qs + 64 * 264;
    LAS bf16_t* vl = (LAS bf16_t*)X.lds;
    LAS float* wkl = (LAS float*)(X.lds + 2 * 64 * 264 * 2);
    LAS float* rsl = wkl + 64;
    LAS float* a1l = rsl + 64; LAS float* gl = a1l + 64;
    float* MGw = (float*)(ws + WS_MG);
    const int b = bh >> 2, h = bh & 3, tid = X.tid, lane = X.lane, w = X.wave, fr = lane & 15, fq = lane >> 4;
    const size_t row0 = (size_t)b * SEQ + c * 64;
    if (tid < 64) { const size_t o_ = (size_t)bh * SEQ + c * 64 + tid; wkl[tid] = MG[MG_WK + o_]; rsl[tid] = 0.f; a1l[tid] = MG[MG_A1 + o_]; gl[tid] = MG[MG_G + o_]; }
    {
        const int cg = tid & 63, ts = tid >> 6;
        const int ch0 = cg < 32 ? h * 256 + cg * 8 : 1024 + h * 256 + (cg - 32) * 8;
        const int t0 = ts * 8;
        u32x4 xr[11];
#pragma unroll
        for (int i = 0; i < 11; ++i) { const int t = t0 - 3 + i; xr[i] = (u32x4){0u, 0u, 0u, 0u};
            if (t >= 0 || c > 0) xr[i] = *(const u32x4*)(BIG + (size_t)((long)row0 + t) * NW + C_MQK + ch0); }
        const float kscale = cg < 32 ? 1.0f : 0.0625f;
        LAS bf16_t* dstb = (cg < 32 ? qs : ksl) + (cg & 31) * 8;
#pragma unroll
        for (int jp = 0; jp < 4; ++jp) {
            const f32x2 w0 = *(const f32x2*)(a.in[16] + ch0 + 2 * jp), w1 = *(const f32x2*)(a.in[16] + 2048 + ch0 + 2 * jp), w2 = *(const f32x2*)(a.in[16] + 4096 + ch0 + 2 * jp), w3 = *(const f32x2*)(a.in[16] + 6144 + ch0 + 2 * jp), cb = *(const f32x2*)(a.in[17] + ch0 + 2 * jp);
#pragma unroll
            for (int u = 0; u < 8; ++u) { const unsigned a0 = xr[u][jp], a1 = xr[u + 1][jp], a2 = xr[u + 2][jp], a3 = xr[u + 3][jp];
                float ylo = cb.x + bflo(a0) * w0.x; ylo = ylo + bflo(a1) * w1.x; ylo = ylo + bflo(a2) * w2.x; ylo = ylo + bflo(a3) * w3.x;
                float yhi = cb.y + bfhi(a0) * w0.y; yhi = yhi + bfhi(a1) * w1.y; yhi = yhi + bfhi(a2) * w2.y; yhi = yhi + bfhi(a3) * w3.y;
                *(LAS unsigned*)(dstb + (t0 + u) * 264 + 2 * jp) = pk2(ylo * __builtin_amdgcn_rcpf(1.0f + __expf(-ylo)) * kscale, yhi * __builtin_amdgcn_rcpf(1.0f + __expf(-yhi)) * kscale); }
            asm volatile("" ::: "memory"); }
    }
    __syncthreads();
    if (tid < 256) { float ac = 0.f;
#pragma unroll 8
        for (int s2 = 0; s2 < 64; ++s2) ac += bf2f(ksl[s2 * 264 + tid]) * wkl[s2];
        MGw[MG_AC + ((size_t)bh * 64 + c) * 256 + tid] = ac; }
#pragma unroll
    for (int i = 0; i < 4; ++i) { const int id = i * NTHREADS + tid, t = id >> 5, seg = id & 31;
        *(u32x4*)(QC + (row0 + t) * 1024 + h * 256 + seg * 8) = *(const LAS u32x4*)(qs + t * 264 + seg * 8); }
#pragma unroll
    for (int i = 0; i < 4; ++i) { const int id = i * NTHREADS + tid, dk = id & 255, tg = id >> 8;
        const f32x4 wa = *(const LAS f32x4*)(wkl + tg * 8), wb = *(const LAS f32x4*)(wkl + tg * 8 + 4);
        float v[8];
#pragma unroll
        for (int j = 0; j < 8; ++j) v[j] = bf2f(ksl[(tg * 8 + j) * 264 + dk]);
        u32x4 o; o.x = pk2(v[0] * wa[0], v[1] * wa[1]); o.y = pk2(v[2] * wa[2], v[3] * wa[3]); o.z = pk2(v[4] * wb[0], v[5] * wb[1]); o.w = pk2(v[6] * wb[2], v[7] * wb[3]);
        *(u32x4*)(KWT + ((((size_t)bh * 64 + c) * 8 + tg) * 256 + dk) * 8) = o; }
    u32x4 vpre[8];
#pragma unroll
    for (int i = 0; i < 8; ++i) { const int id = i * NTHREADS + tid, t = id >> 6, seg = id & 63; vpre[i] = *(const u32x4*)(BIG + (row0 + t) * NW + C_MV + h * DV + seg * 8); }
    {
        const int tm = w & 3, sp = w >> 2;
        f32x4 acc[2]; acc[0] = (f32x4){0.f, 0.f, 0.f, 0.f}; acc[1] = acc[0]; float rsum[4] = {0.f, 0.f, 0.f, 0.f};
#pragma unroll
        for (int ks = 0; ks < 8; ++ks) { const bf16x8 af = *(const LAS bf16x8*)(qs + (tm * 16 + fr) * 264 + ks * 32 + 8 * fq);
#pragma unroll
            for (int j = 0; j < 2; ++j) { const bf16x8 bf = *(const LAS bf16x8*)(ksl + ((2 * sp + j) * 16 + fr) * 264 + ks * 32 + 8 * fq); acc[j] = __builtin_amdgcn_mfma_f32_16x16x32_bf16(af, bf, acc[j], 0, 0, 0); } }
        const float* A1 = MG + MG_A1 + (size_t)bh * SEQ + c * 64; const float* Gp = MG + MG_G + (size_t)bh * SEQ + c * 64;
#pragma unroll
        for (int j = 0; j < 2; ++j) { const int sidx = (2 * sp + j) * 16 + fr; const float gs = gl[sidx];
#pragma unroll
            for (int e = 0; e < 4; ++e) { const int t = tm * 16 + 4 * fq + e; const float val = (sidx <= t) ? acc[j][e] * __expf(a1l[t] + gs) : 0.f; const bf16_t vb = (bf16_t)f2bf(val);
                SM[((((size_t)bh * 64 + c) * 8 + (sidx >> 3)) * 64 + t) * 8 + (sidx & 7)] = vb; rsum[e] += bf2f(vb); } }
#pragma unroll
        for (int e = 0; e < 4; ++e) { const float r16 = row_sum16(rsum[e]); if (fr == 0) atomicAdd((float*)(rsl + tm * 16 + 4 * fq + e), r16); }
    }
    __syncthreads();
    if (tid < 64) MGw[MG_RS + (size_t)bh * SEQ + c * 64 + tid] = rsl[tid];
    __syncthreads();
#pragma unroll
    for (int i = 0; i < 8; ++i) { const int id = i * NTHREADS + tid, t = id >> 6, seg = id & 63; *(LAS u32x4*)(vl + t * 520 + seg * 8) = vpre[i]; }
    __syncthreads();
#pragma unroll
    for (int i = 0; i < 8; ++i) { const int id = i * NTHREADS + tid, tg = id & 7, dv = id >> 3; unsigned short v[8];
#pragma unroll
        for (int j = 0; j < 8; ++j) v[j] = vl[(tg * 8 + j) * 520 + dv];
        u32x4 o; o.x = v[0] | ((unsigned)v[1] << 16); o.y = v[2] | ((unsigned)v[3] << 16); o.z = v[4] | ((unsigned)v[5] << 16); o.w = v[6] | ((unsigned)v[7] << 16);
        *(u32x4*)(VT + ((size_t)bh * DV + dv) * SEQ + c * 64 + tg * 8) = o; }
    __syncthreads();
}

__device__ __forceinline__ void m1_sample_unit(const Ctx& X, CArgs& a, int bh) {
    unsigned char* ws = a.ws; const bf16_t* BIG = (const bf16_t*)(ws + WS_BIG); const float* MIF = (const float*)(ws + WS_MIF); bf16_t* HRAW = (bf16_t*)(ws + WS_HMO);
    LAS float* QT = (LAS float*)X.lds;
    LAS float* KT = QT + 2048;
    LAS float* gsm = KT + 2048;
    LAS float* Sm = gsm + 96;
    LAS float* hred = Sm + 64;
    const int b = bh >> 2, h = bh & 3, tid = X.tid, lane = X.lane, w = X.wave;
    const size_t row0 = (size_t)MP + b * 8;
    const float* C0 = a.in[7] + (size_t)bh * DK * DV; float* Cout = a.out + O_CS + (size_t)bh * DK * DV;
    if (tid == 0) { const float m0 = a.in[9][bh]; float bc = 0.f, rm = -3.0e38f;
        for (int t = 0; t < 8; ++t) { const float iv = MIF[(row0 + t) * 8 + h], fv = MIF[(row0 + t) * 8 + 4 + h]; bc += fv; rm = fmaxf(rm, iv - bc); const float mt = bc + fmaxf(m0, rm);
            gsm[t] = bc; gsm[8 + t] = iv; gsm[16 + t] = mt; gsm[24 + t] = expf(bc + m0 - mt); gsm[32 + t] = expf(-mt); }
        const float mnew = bc + fmaxf(m0, rm);
        for (int t = 0; t < 8; ++t) gsm[40 + t] = expf(bc - gsm[t] + gsm[8 + t] - mnew);
        gsm[88] = expf(bc + m0 - mnew); gsm[89] = mnew; a.out[O_MSO + bh] = mnew; }
    {
        const int ch = tid < 256 ? h * 256 + tid : 1024 + h * 256 + (tid - 256);
        const float w0 = a.in[16][ch], w1 = a.in[16][2048 + ch], w2 = a.in[16][4096 + ch], w3 = a.in[16][6144 + ch], cb = a.in[17][ch];
        const float* cbuf = a.in[6] + (size_t)b * 3 * 2048; float x3 = cbuf[ch], x2 = cbuf[2048 + ch], x1 = cbuf[4096 + ch];
        float xin[8];
#pragma unroll
        for (int u = 0; u < 8; ++u) xin[u] = bf2f(BIG[(row0 + u) * NW + C_MQK + ch]);
        LAS float* dst = (tid < 256 ? QT : KT) + (tid & 255) * 8;
#pragma unroll
        for (int u = 0; u < 8; ++u) { const float x0 = xin[u]; float y = cb + x3 * w0; y = y + x2 * w1; y = y + x1 * w2; y = y + x0 * w3; x3 = x2; x2 = x1; x1 = x0;
            float sv = y / (1.0f + expf(-y)); if (tid >= 256) sv *= 0.0625f; dst[u] = sv; }
    }
    __syncthreads();
    for (int p = w * 8; p < w * 8 + 8; ++p) { const int t = p >> 3, sidx = p & 7; float d = 0.f;
#pragma unroll
        for (int j = 0; j < 4; ++j) { const int dk = lane + 64 * j; d += QT[dk * 8 + t] * KT[dk * 8 + sidx]; }
        d = wave_sum(d);
        if (lane == 0) Sm[p] = (sidx <= t) ? d * expf(gsm[t] - gsm[sidx] + gsm[8 + sidx] - gsm[16 + t]) : 0.f; }
    { const int t = w; float d = 0.f;
#pragma unroll
      for (int j = 0; j < 4; ++j) { const int dk = lane + 64 * j; d += QT[dk * 8 + t] * a.in[8][(size_t)bh * DK + dk]; }
      d = wave_sum(d); if (lane == 0) gsm[64 + t] = d; }
    __syncthreads();
    if (tid < 8) { float rs = 0.f;
#pragma unroll
        for (int j = 0; j < 8; ++j) rs += Sm[tid * 8 + j];
        const float den = rs + gsm[24 + tid] * gsm[64 + tid]; const float dn = fmaxf(fabsf(den), gsm[32 + tid]); gsm[56 + tid] = 1.0f / dn; gsm[48 + tid] = gsm[24 + tid] / dn; }
    for (int i = tid; i < 2048; i += NTHREADS) KT[i] *= gsm[40 + (i & 7)];
    __syncthreads();
    const float dec = gsm[88];
    if (tid < 256) { float sn = 0.f;
#pragma unroll
        for (int j = 0; j < 8; ++j) sn += KT[tid * 8 + j];
        a.out[O_NS + (size_t)bh * DK + tid] = dec * a.in[8][(size_t)bh * DK + tid] + sn; }
    {
        const int cg = tid & 127, kg = tid >> 7;
        f32x4 vv[8], hacc[8];
#pragma unroll
        for (int t = 0; t < 8; ++t) { const u32x2 wv = *(const u32x2*)(BIG + (row0 + t) * NW + C_MV + h * DV + 4 * cg); vv[t] = (f32x4){bflo(wv.x), bfhi(wv.x), bflo(wv.y), bfhi(wv.y)}; hacc[t] = (f32x4){0.f, 0.f, 0.f, 0.f}; }
#pragma unroll 1
        for (int d0 = 0; d0 < 64; d0 += 8) {
            f32x4 c0[8];
#pragma unroll
            for (int u = 0; u < 8; ++u) c0[u] = __builtin_nontemporal_load((const f32x4*)(C0 + (size_t)(kg * 64 + d0 + u) * DV + 4 * cg));
#pragma unroll
            for (int u = 0; u < 8; ++u) { const int dk = kg * 64 + d0 + u;
                const f32x4 qa = *(const LAS f32x4*)(QT + dk * 8), qb = *(const LAS f32x4*)(QT + dk * 8 + 4), ka = *(const LAS f32x4*)(KT + dk * 8), kb = *(const LAS f32x4*)(KT + dk * 8 + 4);
                f32x4 cn = c0[u] * dec;
#pragma unroll
                for (int t = 0; t < 4; ++t) { hacc[t] = hacc[t] + c0[u] * qa[t]; hacc[4 + t] = hacc[4 + t] + c0[u] * qb[t]; cn = cn + vv[t] * ka[t]; cn = cn + vv[4 + t] * kb[t]; }
                __builtin_nontemporal_store(cn, (f32x4*)(Cout + (size_t)dk * DV + 4 * cg)); asm volatile("" ::: "memory"); }
        }
#pragma unroll
        for (int t = 0; t < 8; ++t) *(LAS f32x4*)(hred + (kg * 8 + t) * 512 + 4 * cg) = hacc[t];
    }
    __syncthreads();
    { const int t = tid >> 6; const float f1 = gsm[48 + t], f2 = gsm[56 + t];
#pragma unroll 1
      for (int j = 0; j < 8; ++j) { const int dv = lane + 64 * j; const float inter = (hred[(0 * 8 + t) * 512 + dv] + hred[(1 * 8 + t) * 512 + dv]) + (hred[(2 * 8 + t) * 512 + dv] + hred[(3 * 8 + t) * 512 + dv]);
          float intra = 0.f;
#pragma unroll
          for (int s2 = 0; s2 < 8; ++s2) intra += Sm[t * 8 + s2] * bf2f(BIG[(row0 + s2) * NW + C_MV + h * DV + dv]);
          HRAW[(row0 + t) * D + h * DV + dv] = (bf16_t)f2bf(intra * f2 + inter * f1); } }
    __syncthreads();
}

__device__ __forceinline__ bf16x8 ldg8(const char* ubase, unsigned loff) { return *(const bf16x8*)(ubase + loff); }
__device__ __forceinline__ void m2_scan_unit(const Ctx& X, CArgs& a, int bh, int vs) {
    unsigned char* ws = a.ws; const float* MG = (const float*)(ws + WS_MG); bf16_t* HRAW = (bf16_t*)(ws + WS_HMO);
    const int b = bh >> 2, h = bh & 3, tid = X.tid, lane = X.lane, w = X.wave, fr = lane & 15, fq = lane >> 4, tm = w & 3, dp = w >> 2;
    LAS bf16_t* CT = (LAS bf16_t*)X.lds;
    LAS unsigned char* stQ = X.lds + 69632;
    LAS unsigned char* stV = X.lds + 69632 + 65536;
    const char* Qg = (const char*)(ws + WS_QC) + (((size_t)b * SEQ) * 1024 + h * 256) * 2;
    const char* Vg = (const char*)(ws + WS_VT) + ((size_t)bh * DV + vs * 64) * SEQ * 2;
    const char* Sb = (const char*)(ws + WS_SM) + ((size_t)bh * 64 * 4096 + tm * 16 * 8) * 2;
    const char* KWb = (const char*)(ws + WS_KWT) + ((size_t)bh * 64 * 16384 + 2 * w * 16 * 8) * 2;
    const unsigned loS = (unsigned)(fq * 1024 + fr * 16), loT = (unsigned)(fq * 4096 + fr * 16);
    const int R0 = 8 * w + (lane >> 5); const unsigned zq = (unsigned)((lane & 31) ^ (R0 & 31));
    const int rs8 = 8 * w + (lane >> 3); const unsigned dv_ = (unsigned)(rs8 * SEQ * 2 + (((lane & 7) ^ ((rs8 >> 1) & 7)) * 16));
#define SCAN_DMA(c_) do { const char* q_ = Qg + (size_t)(c_) * (64 * 2048); const char* v_ = Vg + (size_t)(c_) * 128; const int sb_ = (c_) & 1; \
        _Pragma("unroll") for (int i_ = 0; i_ < 4; ++i_) __builtin_amdgcn_global_load_lds((const unsigned*)(q_ + (unsigned)((R0 + 2 * i_) * 2048) + ((zq ^ (unsigned)(2 * i_)) * 16u)), (LAS unsigned*)(stQ + sb_ * 32768 + (4 * w + i_) * 1024), 16, 0, 0); \
        __builtin_amdgcn_global_load_lds((const unsigned*)(v_ + dv_), (LAS unsigned*)(stV + sb_ * 8192 + w * 1024), 16, 0, 0); } while (0)
    const int rq = tm * 16 + fr;
    const unsigned yq = (unsigned)(fq ^ (rq & 31)), yv = (unsigned)(fq ^ ((fr >> 1) & 7));
    const unsigned bq = (unsigned)(rq * 512), bv = (unsigned)(fr * 128);
    const float* WINp = MG + MG_WIN + (size_t)bh * SEQ + tm * 16 + 4 * fq; const float* DECp = MG + MG_DEC + bh * 64;
    f32x4 Cacc[2][4];
#pragma unroll
    for (int i = 0; i < 2; ++i)
#pragma unroll
        for (int j = 0; j < 4; ++j) Cacc[i][j] = (f32x4){0.f, 0.f, 0.f, 0.f};
    for (int i = tid; i < 64 * 264 / 2; i += NTHREADS) ((LAS unsigned*)CT)[i] = 0u;
    SCAN_DMA(0);
    bf16x8 KWf[2][2], Sf[2];
#pragma unroll
    for (int k2 = 0; k2 < 2; ++k2) { Sf[k2] = ldg8(Sb + k2 * 4096, loS);
#pragma unroll
        for (int i = 0; i < 2; ++i) KWf[i][k2] = ldg8(KWb + i * 256 + k2 * 16384, loT); }
    f32x4 win4 = *(const f32x4*)WINp; float dec = DECp[0];
    const unsigned ctr0 = (unsigned)(((2 * dp) * 16 + fr) * 264 + 8 * fq), ctw0 = (unsigned)(fr * 264 + 2 * w * 16 + 4 * fq);
    for (int c = 0; c < 64; ++c) {
        asm volatile("s_waitcnt vmcnt(0)" ::: "memory");
        __syncthreads();
        if (c < 63) SCAN_DMA(c + 1);
        const int cur = c & 1; const LAS bf16_t* CTc = CT + cur * 64 * 264; LAS bf16_t* CTn = CT + (cur ^ 1) * 64 * 264;
        const LAS unsigned char* sQ = stQ + cur * 32768 + bq; const LAS unsigned char* sV = stV + cur * 8192 + bv;
        const int cn = c < 63 ? c + 1 : 63;
        f32x4 Hi[2], Ha[2]; Hi[0] = (f32x4){0.f, 0.f, 0.f, 0.f}; Hi[1] = Hi[0]; Ha[0] = Hi[0]; Ha[1] = Hi[0];
#pragma unroll
        for (int ks = 0; ks < 8; ++ks) {
            const bf16x8 qf = *(const LAS bf16x8*)(sQ + (((unsigned)(ks * 4) ^ yq) * 16u));
            const bf16x8 c0 = *(const LAS bf16x8*)(CTc + ctr0 + ks * 32), c1 = *(const LAS bf16x8*)(CTc + ctr0 + 16 * 264 + ks * 32);
            Hi[0] = __builtin_amdgcn_mfma_f32_16x16x32_bf16(qf, c0, Hi[0], 0, 0, 0); Hi[1] = __builtin_amdgcn_mfma_f32_16x16x32_bf16(qf, c1, Hi[1], 0, 0, 0);
            if ((ks & 3) == 3) asm volatile("" ::: "memory");
        }
#pragma unroll
        for (int k2 = 0; k2 < 2; ++k2) { const unsigned sl_ = ((unsigned)(k2 * 4) ^ yv) * 16u;
            const bf16x8 vA = *(const LAS bf16x8*)(sV + (2 * dp) * 2048 + sl_), vB = *(const LAS bf16x8*)(sV + (2 * dp + 1) * 2048 + sl_);
            Ha[0] = __builtin_amdgcn_mfma_f32_16x16x32_bf16(Sf[k2], vA, Ha[0], 0, 0, 0); Ha[1] = __builtin_amdgcn_mfma_f32_16x16x32_bf16(Sf[k2], vB, Ha[1], 0, 0, 0); }
        {
            LAS bf16_t* hst = (LAS bf16_t*)(X.lds + 151552 + w * 1280);
#pragma unroll
            for (int e = 0; e < 4; ++e)
#pragma unroll
                for (int j = 0; j < 2; ++j) hst[(4 * fq + e) * 32 + j * 16 + fr] = (bf16_t)f2bf(Ha[j][e] + Hi[j][e] * win4[e]);
            asm volatile("" ::: "memory");
            const u32x4 hv = *(const LAS u32x4*)(hst + (lane >> 2) * 32 + (lane & 3) * 8);
            *(u32x4*)(HRAW + ((size_t)b * SEQ + c * 64 + tm * 16 + (lane >> 2)) * D + h * DV + vs * 64 + dp * 32 + (lane & 3) * 8) = hv;
        }
#pragma unroll
        for (int j = 0; j < 4; ++j) {
#pragma unroll
            for (int k2 = 0; k2 < 2; ++k2) { const bf16x8 vf = *(const LAS bf16x8*)(sV + j * 2048 + (((unsigned)(k2 * 4) ^ yv) * 16u));
#pragma unroll
                for (int i = 0; i < 2; ++i) { if (k2 == 0) Cacc[i][j] = Cacc[i][j] * dec; Cacc[i][j] = __builtin_amdgcn_mfma_f32_16x16x32_bf16(KWf[i][k2], vf, Cacc[i][j], 0, 0, 0); } } }
#pragma unroll
        for (int i = 0; i < 2; ++i)
#pragma unroll
            for (int j = 0; j < 4; ++j) { u32x2 pw; pw.x = pk2(Cacc[i][j][0], Cacc[i][j][1]); pw.y = pk2(Cacc[i][j][2], Cacc[i][j][3]);
                *(LAS u32x2*)(CTn + ctw0 + j * 16 * 264 + i * 16) = pw; }
        { const char* kn_ = KWb + (size_t)cn * 32768; const char* sn_ = Sb + (size_t)cn * 8192;
#pragma unroll
          for (int k2 = 0; k2 < 2; ++k2) { Sf[k2] = ldg8(sn_ + k2 * 4096, loS);
#pragma unroll
            for (int i = 0; i < 2; ++i) KWf[i][k2] = ldg8(kn_ + i * 256 + k2 * 16384, loT); } }
        win4 = *(const f32x4*)(WINp + cn * 64); dec = DECp[cn];
    }
#undef SCAN_DMA
    __syncthreads();
    float* Cout = a.out + O_CP + (size_t)bh * DK * DV;
#pragma unroll
    for (int i = 0; i < 2; ++i)
#pragma unroll
        for (int j = 0; j < 4; ++j)
#pragma unroll
            for (int e = 0; e < 4; ++e) Cout[(size_t)((2 * w + i) * 16 + 4 * fq + e) * DV + vs * 64 + j * 16 + fr] = Cacc[i][j][e];
    __syncthreads();
}


__device__ __forceinline__ void m2_nchain_unit(const Ctx& X, CArgs& a, int bh) {
    float* MGw = (float*)(a.ws + WS_MG); const int tid = X.tid;
    if (tid < 256) { float n = 0.f;
        for (int c0 = 0; c0 < 64; c0 += 8) { float ac[8], dc[8];
#pragma unroll
            for (int u = 0; u < 8; ++u) { ac[u] = MGw[MG_AC + ((size_t)bh * 64 + c0 + u) * 256 + tid]; dc[u] = MGw[MG_DEC + bh * 64 + c0 + u]; }
#pragma unroll
            for (int u = 0; u < 8; ++u) { MGw[MG_NALL + ((size_t)bh * 64 + c0 + u) * 256 + tid] = n; n = dc[u] * n + ac[u]; } }
        a.out[O_NP + (size_t)bh * DK + tid] = n; }
}

__device__ __forceinline__ void p3_headnorm(const Ctx& X, CArgs& a, int wi, int nwk) {
    unsigned char* ws = a.ws; const bf16_t* HM = (const bf16_t*)(ws + WS_HMO); const bf16_t* BIG = (const bf16_t*)(ws + WS_BIG); const float* MG = (const float*)(ws + WS_MG);
    const int gw = wi * NWAVES + X.wave, NGW = nwk * NWAVES, lane = X.lane;
    for (int m = gw; m < M; m += NGW) {
        u32x4 hw[4], ow[4]; u32x2 qw[4]; f32x4 nv[4]; float rs_[4], wn_[4], em_[4];
        const bool prompt = m < MP; const int t = m & (SEQ - 1), bh0 = (m >> 12) * MLH;
#pragma unroll
        for (int h = 0; h < 4; ++h) { hw[h] = *(const u32x4*)(HM + (size_t)m * D + h * DV + lane * 8); ow[h] = *(const u32x4*)(BIG + (size_t)m * NW + C_MO + h * DV + lane * 8);
            if (prompt) { qw[h] = *(const u32x2*)((const bf16_t*)(ws + WS_QC) + (size_t)m * 1024 + h * 256 + 4 * lane); nv[h] = *(const f32x4*)(MG + MG_NALL + ((size_t)(bh0 + h) * 64 + (t >> 6)) * 256 + 4 * lane);
                const size_t o = (size_t)(bh0 + h) * SEQ + t; rs_[h] = MG[MG_RS + o]; wn_[h] = MG[MG_WIN + o]; em_[h] = MG[MG_EMI + o]; } }
#pragma unroll
        for (int h = 0; h < 4; ++h) {
            float v[8] = { bflo(hw[h].x), bfhi(hw[h].x), bflo(hw[h].y), bfhi(hw[h].y), bflo(hw[h].z), bfhi(hw[h].z), bflo(hw[h].w), bfhi(hw[h].w) };
            if (prompt) {
                const float qn = wave_sum((bflo(qw[h].x) * nv[h][0] + bfhi(qw[h].x) * nv[h][1]) + (bflo(qw[h].y) * nv[h][2] + bfhi(qw[h].y) * nv[h][3]));
                const float den = rs_[h] + wn_[h] * qn; const float inv = 1.0f / fmaxf(fabsf(den), em_[h]);
#pragma unroll
                for (int j = 0; j < 8; ++j) v[j] *= inv; }
            float s = 0.f;
#pragma unroll
            for (int j = 0; j < 8; ++j) s += v[j];
            const float mu = wave_sum(s) * (1.0f / DV); float q = 0.f;
#pragma unroll
            for (int j = 0; j < 8; ++j) { v[j] -= mu; q += v[j] * v[j]; }
            const float rstd = 1.0f / sqrtf(wave_sum(q) * (1.0f / DV) + LN_EPS);
            const float o[8] = { bflo(ow[h].x), bfhi(ow[h].x), bflo(ow[h].y), bfhi(ow[h].y), bflo(ow[h].z), bfhi(ow[h].z), bflo(ow[h].w), bfhi(ow[h].w) };
            const float* gp = a.in[18] + h * DV + lane * 8; const f32x4 g0 = *(const f32x4*)gp, g1 = *(const f32x4*)(gp + 4);
            const float gg[8] = { g0[0], g0[1], g0[2], g0[3], g1[0], g1[1], g1[2], g1[3] }; float r[8];
#pragma unroll
            for (int j = 0; j < 8; ++j) r[j] = v[j] * rstd * gg[j] * o[j];
            u32x2 ww; ww.x = pk4_fp8(r[0] * ACT_S, r[1] * ACT_S, r[2] * ACT_S, r[3] * ACT_S); ww.y = pk4_fp8(r[4] * ACT_S, r[5] * ACT_S, r[6] * ACT_S, r[7] * ACT_S);
            *(u32x2*)(ws + WS_HMO8 + (size_t)m * D + h * DV + lane * 8) = ww; }
    }
}

__device__ __forceinline__ void p6_ln1(const Ctx& X, CArgs& a) {
    unsigned char* ws = a.ws; bf16_t* T = (bf16_t*)(ws + WS_T); const float* ADA = (const float*)(ws + WS_ADA);
    const int gw = X.vcu * NWAVES + X.wave, NGW = X.G * NWAVES, lane = X.lane;
    for (int m = gw; m < M; m += NGW) {
        bf16_t* tr = T + (size_t)m * D; const int b = m < MP ? (m >> 12) : BATCH + ((m - MP) >> 3);
        const float* sh2 = ADA + (size_t)b * 6 * D + 3 * D; const float* sc2 = sh2 + D;
        f32x4 v[8]; float s = 0.f;
#pragma unroll
        for (int j = 0; j < 8; ++j) { const u32x2 tw = *(const u32x2*)(tr + 4 * lane + 256 * j); v[j] = (f32x4){bflo(tw.x), bfhi(tw.x), bflo(tw.y), bfhi(tw.y)}; s += (v[j][0] + v[j][1]) + (v[j][2] + v[j][3]); }
        const float mu = wave_sum(s) * (1.0f / D); float q = 0.f;
#pragma unroll
        for (int j = 0; j < 8; ++j) { v[j] = v[j] - mu; q += (v[j][0] * v[j][0] + v[j][1] * v[j][1]) + (v[j][2] * v[j][2] + v[j][3] * v[j][3]); }
        const float rstd = 1.0f / sqrtf(wave_sum(q) * (1.0f / D) + LN_EPS);
        unsigned* o4 = (unsigned*)(ws + WS_H28 + (size_t)m * D) + lane; float am = 0.f;
#pragma unroll
        for (int j = 0; j < 8; ++j) { const int c = 4 * lane + 256 * j; const f32x4 gg = *(const f32x4*)(a.in[23] + c), bb = *(const f32x4*)(a.in[24] + c);
            const f32x4 x1 = v[j] * rstd * gg + bb; { u32x2 xw; xw.x = pk2(x1[0], x1[1]); xw.y = pk2(x1[2], x1[3]); *(u32x2*)(tr + c) = xw; }
            const f32x4 h2 = x1 * (*(const f32x4*)(sc2 + c) + 1.0f) + *(const f32x4*)(sh2 + c);
            o4[64 * j] = pk4_fp8(h2[0] * ACT_S, h2[1] * ACT_S, h2[2] * ACT_S, h2[3] * ACT_S);
            v[j] = h2; am = fmaxf(am, fmaxf(fmaxf(fabsf(h2[0]), fabsf(h2[1])), fmaxf(fabsf(h2[2]), fabsf(h2[3])))); }
        am = wave_max(am); const float qs = am > 0.f ? 127.0f / am : 1.0f;
        unsigned* oi = (unsigned*)(ws + WS_H2I + (size_t)m * D) + lane;
#pragma unroll
        for (int j = 0; j < 8; ++j) oi[64 * j] = pk4_i8(v[j][0] * qs, v[j][1] * qs, v[j][2] * qs, v[j][3] * qs);
        if (lane == 0) ((float*)(ws + WS_HSC))[m] = am > 0.f ? am / 127.0f : 1.0f;
    }
}

__device__ __forceinline__ unsigned ord_key(float f) { unsigned u = __builtin_bit_cast(unsigned, f); return u ^ ((u >> 31) ? 0xFFFFFFFFu : 0x80000000u); }
__device__ __forceinline__ void p8_topk(const Ctx& X, CArgs& a) {
    unsigned char* ws = a.ws; const bf16_t* QP = (const bf16_t*)(ws + WS_H1); int* EID = (int*)(ws + WS_EID); float* GATE = (float*)(ws + WS_GATE);
    const float* SK = a.in[26];
    LAS float* S = (LAS float*)X.lds;
    LAS unsigned* TK = (LAS unsigned*)(X.lds + 2 * 64 * 129 * 4);
    const int lane = X.lane, w = X.wave, fr = lane & 15, fq = lane >> 4;
    const int p = w & 1, kq = w >> 1;
    constexpr int NTILE = M / 64;
    for (int u = X.vcu; u < NTILE * PH; u += X.G) {
        const int h = u / NTILE, tile = u % NTILE; const int m0 = tile * 64;
        f32x4 acc[4][2];
#pragma unroll
        for (int i = 0; i < 4; ++i) { acc[i][0] = (f32x4){0.f, 0.f, 0.f, 0.f}; acc[i][1] = acc[i][0]; }
#pragma unroll
        for (int ks = 0; ks < 4; ++ks) {
            bf16x8 bfr[2];
#pragma unroll
            for (int nt = 0; nt < 2; ++nt) { const float* kp = SK + (((size_t)(h * 2 + p) * NKEYS) + kq * 32 + nt * 16 + fr) * 128 + ks * 32 + 8 * fq;
                const f32x4 k0 = *(const f32x4*)kp, k1 = *(const f32x4*)(kp + 4);
                u32x4 pk; pk.x = pk2(k0[0], k0[1]); pk.y = pk2(k0[2], k0[3]); pk.z = pk2(k1[0], k1[1]); pk.w = pk2(k1[2], k1[3]); bfr[nt] = __builtin_bit_cast(bf16x8, pk); }
#pragma unroll
            for (int mt = 0; mt < 4; ++mt) { const bf16x8 afr = *(const bf16x8*)(QP + (size_t)(m0 + mt * 16 + fr) * D + h * DQ + p * 128 + ks * 32 + 8 * fq);
#pragma unroll
                for (int nt = 0; nt < 2; ++nt) acc[mt][nt] = __builtin_amdgcn_mfma_f32_16x16x32_bf16(afr, bfr[nt], acc[mt][nt], 0, 0, 0); }
        }
#pragma unroll
        for (int mt = 0; mt < 4; ++mt)
#pragma unroll
            for (int nt = 0; nt < 2; ++nt)
#pragma unroll
                for (int e = 0; e < 4; ++e) S[(p * 64 + mt * 16 + 4 * fq + e) * 129 + kq * 32 + nt * 16 + fr] = acc[mt][nt][e];
        __syncthreads();
        if (X.tid < 128) {
            const int hp = X.tid >> 6, tk = X.tid & 63; const LAS float* row = S + (hp * 64 + tk) * 129;
            unsigned L[16];
#pragma unroll
            for (int j = 0; j < 16; ++j) L[j] = 0u;
            for (int i = 0; i < 128; ++i) { unsigned x = (ord_key(row[i]) & ~127u) | (unsigned)(127 - i);
#pragma unroll
                for (int j = 0; j < 16; ++j) { const unsigned hi = L[j] > x ? L[j] : x, lo = L[j] > x ? x : L[j]; L[j] = hi; x = lo; } }
#pragma unroll
            for (int j = 0; j < 16; ++j) TK[(hp * 64 + tk) * 16 + j] = L[j];
        }
        __syncthreads();
        if (X.tid < 64) {
            const int tk = X.tid; float sa[16], sb[16]; int ia[16], ib[16];
#pragma unroll
            for (int j = 0; j < 16; ++j) { ia[j] = 127 - (int)(TK[tk * 16 + j] & 127u); ib[j] = 127 - (int)(TK[(64 + tk) * 16 + j] & 127u); sa[j] = S[tk * 129 + ia[j]]; sb[j] = S[(64 + tk) * 129 + ib[j]]; }
            unsigned L[16];
#pragma unroll
            for (int j = 0; j < 16; ++j) L[j] = 0u;
#pragma unroll
            for (int i = 0; i < 16; ++i)
#pragma unroll
                for (int j = 0; j < 16; ++j) if ((i + 1) * (j + 1) <= 16) { unsigned x = (ord_key(sa[i] + sb[j]) & ~255u) | (unsigned)(255 - (i * 16 + j));
#pragma unroll
                    for (int q = 0; q < 16; ++q) { const unsigned hi = L[q] > x ? L[q] : x, lo = L[q] > x ? x : L[q]; L[q] = hi; x = lo; } }
            float ts[16]; int eid[16]; float mxs = -3.0e38f;
#pragma unroll
            for (int q = 0; q < 16; ++q) { const int code = 255 - (int)(L[q] & 255u), i = code >> 4, j = code & 15; float va = sa[0], vb = sb[0]; int xa = ia[0], xb = ib[0];
#pragma unroll
                for (int z = 1; z < 16; ++z) { va = (i == z) ? sa[z] : va; xa = (i == z) ? ia[z] : xa; vb = (j == z) ? sb[z] : vb; xb = (j == z) ? ib[z] : xb; }
                ts[q] = va + vb; eid[q] = xa * NKEYS + xb; mxs = fmaxf(mxs, ts[q]); }
            float sum = 0.f;
#pragma unroll
            for (int q = 0; q < 16; ++q) { ts[q] = expf(ts[q] - mxs); sum += ts[q]; }
            const float inv = 1.0f / sum; const size_t o = ((size_t)(m0 + tk) * PH + h) * 16;
#pragma unroll
            for (int q = 0; q < 16; ++q) { EID[o + q] = eid[q]; GATE[o + q] = ts[q] * inv; }
        }
        __syncthreads();
    }
}

template <int N> __device__ __forceinline__ void bitonic_sort_desc(unsigned (&v)[N]) {
#pragma unroll
    for (int k = 2; k <= N; k <<= 1)
#pragma unroll
        for (int j = k >> 1; j > 0; j >>= 1)
#pragma unroll
            for (int i = 0; i < N; ++i) { const int l = i ^ j;
                if (l > i) { const bool up = ((i & k) == 0); const unsigned x = v[i], y = v[l]; const unsigned mx = x > y ? x : y, mn = x > y ? y : x; v[i] = up ? mx : mn; v[l] = up ? mn : mx; } }
}
__device__ __forceinline__ void merge16_xor(unsigned (&v)[16], int dist) {
    unsigned o[16];
#pragma unroll
    for (int j = 0; j < 16; ++j) o[j] = dist == 1 ? (unsigned)__builtin_amdgcn_update_dpp(0, (int)v[j], 0xB1, 0xF, 0xF, true) : (unsigned)__builtin_amdgcn_update_dpp(0, (int)v[j], 0x4E, 0xF, 0xF, true);
#pragma unroll
    for (int j = 0; j < 16; ++j) { const unsigned y = o[15 - j]; v[j] = v[j] > y ? v[j] : y; }
#pragma unroll
    for (int jj = 8; jj > 0; jj >>= 1)
#pragma unroll
        for (int i = 0; i < 16; ++i) { const int l = i ^ jj; if (l > i) { const unsigned x = v[i], y = v[l]; v[i] = x > y ? x : y; v[l] = x > y ? y : x; } }
}
__device__ __forceinline__ float ord_inv(unsigned k) { const unsigned u = (k & 0x80000000u) ? (k ^ 0x80000000u) : ~k; return __builtin_bit_cast(float, u); }
__device__ __forceinline__ void p11_topk2(const Ctx& X, CArgs& a, const pg8::StaticOrder* S) {
    unsigned char* ws = a.ws; const bf16_t* QP = (const bf16_t*)(ws + WS_H1); int* EID = (int*)(ws + WS_EID); float* GATE = (float*)(ws + WS_GATE);
    const bf16_t* SKB = (const bf16_t*)(ws + WS_SKB);
    LAS unsigned* KL = (LAS unsigned*)X.lds;
    LAS unsigned* TK = KL + 128 * 132;
    LAS unsigned char* ptab = (LAS unsigned char*)(TK + 2 * 128 * 16);
    LAS bf16_t* SKL = (LAS bf16_t*)(ptab + 64);
    const int tid = X.tid, lane = X.lane, w = X.wave, fr = lane & 15, fq = lane >> 4;
    if (tid == 0) { int n = 0; for (int i = 0; i < 16; ++i) for (int j = 0; j < 16; ++j) if ((i + 1) * (j + 1) <= 16) ptab[n++] = (unsigned char)((i << 4) | j); for (; n < 64; ++n) ptab[n] = 0xff; }
    constexpr int NT = M / 128;
    auto do_unit = [&](const int h, const int m0) {
        for (int p = 0; p < 2; ++p) {
            __syncthreads();
            {
                bf16x8 af[4];
#pragma unroll
                for (int ks = 0; ks < 4; ++ks) af[ks] = *(const bf16x8*)(QP + (size_t)(m0 + w * 16 + fr) * D + h * DQ + p * 128 + ks * 32 + 8 * fq);
#pragma unroll
                for (int i = 0; i < 4; ++i) { const int id = i * NTHREADS + tid, key = id >> 4, seg = id & 15; *(LAS u32x4*)(SKL + key * 136 + seg * 8) = *(const u32x4*)(SKB + ((size_t)(h * 2 + p) * NKEYS + key) * 128 + seg * 8); }
                __syncthreads();
#pragma unroll
                for (int nt = 0; nt < 8; ++nt) { f32x4 acc = (f32x4){0.f, 0.f, 0.f, 0.f};
#pragma unroll
                    for (int ks = 0; ks < 4; ++ks) { const bf16x8 bf = *(const LAS bf16x8*)(SKL + (nt * 16 + fr) * 136 + ks * 32 + 8 * fq); acc = __builtin_amdgcn_mfma_f32_16x16x32_bf16(af[ks], bf, acc, 0, 0, 0); }
                    const int key = nt * 16 + fr;
#pragma unroll
                    for (int e = 0; e < 4; ++e) KL[(w * 16 + 4 * fq + e) * 132 + key] = (ord_key(acc[e]) & ~127u) | (unsigned)(127 - key); }
            }
            __syncthreads();
            {
                const int t = tid >> 2, qd = tid & 3; unsigned v[32];
#pragma unroll
                for (int q = 0; q < 8; ++q) { const u32x4 x = *(const LAS u32x4*)(KL + t * 132 + qd * 32 + 4 * q); v[4 * q] = x.x; v[4 * q + 1] = x.y; v[4 * q + 2] = x.z; v[4 * q + 3] = x.w; }
                bitonic_sort_desc<32>(v);
                unsigned top[16];
#pragma unroll
                for (int j = 0; j < 16; ++j) top[j] = v[j];
                merge16_xor(top, 1); merge16_xor(top, 2);
                if (qd == 0) {
#pragma unroll
                    for (int q = 0; q < 4; ++q) *(LAS u32x4*)(TK + (p * 128 + t) * 16 + 4 * q) = (u32x4){top[4 * q], top[4 * q + 1], top[4 * q + 2], top[4 * q + 3]}; }
            }
        }
        __syncthreads();
        {
            const int t = tid >> 2, qd = tid & 3; const LAS unsigned* ta = TK + t * 16; const LAS unsigned* tb = TK + (128 + t) * 16;
            unsigned c[16];
#pragma unroll
            for (int n = 0; n < 16; ++n) { const unsigned pr = ptab[4 * n + qd]; unsigned key = 0u;
                if (pr != 0xffu) { const float sa = ord_inv(ta[pr >> 4] & ~127u), sb = ord_inv(tb[pr & 15] & ~127u); key = (ord_key(sa + sb) & ~255u) | (255u - pr); }
                c[n] = key; }
            bitonic_sort_desc<16>(c);
            merge16_xor(c, 1); merge16_xor(c, 2);
            float ts[16]; float mxs = -3.0e38f;
#pragma unroll
            for (int q = 0; q < 16; ++q) { const unsigned pr = 255u - (c[q] & 255u); const float sa = ord_inv(ta[pr >> 4] & ~127u), sb = ord_inv(tb[pr & 15] & ~127u); ts[q] = sa + sb; mxs = fmaxf(mxs, ts[q]); }
            float sum = 0.f;
#pragma unroll
            for (int q = 0; q < 16; ++q) { ts[q] = __expf(ts[q] - mxs); sum += ts[q]; }
            const float inv = 1.0f / sum; const size_t o = ((size_t)(m0 + t) * PH + h) * 16;
#pragma unroll
            for (int q = 0; q < 16; ++q) if ((q >> 2) == qd) { const unsigned pr = 255u - (c[q] & 255u); const int ia = 127 - (int)(ta[pr >> 4] & 127u), ib = 127 - (int)(tb[pr & 15] & 127u);
                EID[o + q] = ia * NKEYS + ib; GATE[o + q] = ts[q] * inv; }
        }
    };
    if (S) { pg8::Unit gu; for (int i = 0; S->next(i, gu); ++i) { do_unit(gu.pn, gu.pm * 256); do_unit(gu.pn, gu.pm * 256 + 128); } }
    else for (int u = X.vcu; u < NT * PH; u += X.G) do_unit(u / NT, (u % NT) * 128);
    __syncthreads();
}

typedef float f32x2v __attribute__((ext_vector_type(2)));
__device__ __forceinline__ float dot_fp8x16(const u32x4 w, const float* h) {
    float d0 = 0.f, d1 = 0.f;
#pragma unroll
    for (int q = 0; q < 4; ++q) { const f32x2v lo = __builtin_amdgcn_cvt_pk_f32_fp8((int)w[q], false), hi = __builtin_amdgcn_cvt_pk_f32_fp8((int)w[q], true);
        d0 += lo.x * h[4 * q] + lo.y * h[4 * q + 1]; d1 += hi.x * h[4 * q + 2] + hi.y * h[4 * q + 3]; }
    return d0 + d1;
}
__device__ __forceinline__ void axpy_fp8x16(const u32x4 w, float c, float* acc) {
#pragma unroll
    for (int q = 0; q < 4; ++q) { const f32x2v lo = __builtin_amdgcn_cvt_pk_f32_fp8((int)w[q], false), hi = __builtin_amdgcn_cvt_pk_f32_fp8((int)w[q], true);
        acc[4 * q] += c * lo.x; acc[4 * q + 1] += c * lo.y; acc[4 * q + 2] += c * hi.x; acc[4 * q + 3] += c * hi.y; }
}
__device__ __forceinline__ void p8_gather(const Ctx& X, CArgs& a) {
    unsigned char* ws = a.ws; const float* X1 = (const float*)(ws + WS_T); const float* ADA = (const float*)(ws + WS_ADA);
    const int* EID = (const int*)(ws + WS_EID); const float* GATE = (const float*)(ws + WS_GATE);
    const unsigned char* U8 = ws + WS_U8; const unsigned char* V8 = ws + WS_V8; const float* PSC = (const float*)(ws + WS_PSC);
    const int gw = X.vcu * NWAVES + X.wave, NGW = X.G * NWAVES, lane = X.lane;
    constexpr int UN = 4;
    for (int m = gw; m < M; m += NGW) {
        const int b = m < MP ? (m >> 12) : BATCH + ((m - MP) >> 3);
        const float* ab = ADA + (size_t)b * 6 * D; const float* sh2 = ab + 3 * D; const float* sc2 = ab + 4 * D; const float* g2 = ab + 5 * D;
        const float* x1r = X1 + (size_t)m * D;
        float h2[32], acc[32];
#pragma unroll
        for (int j = 0; j < 2; ++j)
#pragma unroll
            for (int q = 0; q < 4; ++q) { const int c = 16 * lane + 1024 * j + 4 * q; const f32x4 xv = *(const f32x4*)(x1r + c), s1 = *(const f32x4*)(sc2 + c), s0 = *(const f32x4*)(sh2 + c);
#pragma unroll
                for (int e = 0; e < 4; ++e) { h2[16 * j + 4 * q + e] = xv[e] * (s1[e] + 1.0f) + s0[e]; acc[16 * j + 4 * q + e] = 0.f; } }
        const int e_l = EID[(size_t)m * 128 + lane], e_h = EID[(size_t)m * 128 + 64 + lane];
        const float g_l = GATE[(size_t)m * 128 + lane], g_h = GATE[(size_t)m * 128 + 64 + lane];
        for (int k0 = 0; k0 < 128; k0 += UN) {
            u32x4 uw[UN][2], vw[UN][2]; float su[UN], sv[UN], gk[UN];
#pragma unroll
            for (int i = 0; i < UN; ++i) { const int k = k0 + i;
                const int e = __builtin_amdgcn_readfirstlane(k < 64 ? __shfl(e_l, k) : __shfl(e_h, k - 64));
                gk[i] = k < 64 ? __shfl(g_l, k) : __shfl(g_h, k - 64);
                const unsigned char* ur = U8 + (size_t)e * D + 16 * lane; const unsigned char* vr = V8 + (size_t)e * D + 16 * lane;
                uw[i][0] = *(const u32x4*)ur; uw[i][1] = *(const u32x4*)(ur + 1024); vw[i][0] = *(const u32x4*)vr; vw[i][1] = *(const u32x4*)(vr + 1024);
                su[i] = PSC[e]; sv[i] = PSC[16384 + e]; }
#pragma unroll
            for (int i = 0; i < UN; ++i) {
                float d = dot_fp8x16(uw[i][0], h2) + dot_fp8x16(uw[i][1], h2 + 16);
                d = wave_sum(d) * su[i];
                const float act = 0.5f * d * (1.0f + erff(d * 0.70710678118654752f));
                const float cf = gk[i] * act * sv[i];
                axpy_fp8x16(vw[i][0], cf, acc); axpy_fp8x16(vw[i][1], cf, acc + 16);
            }
        }
        float s = 0.f;
#pragma unroll
        for (int j = 0; j < 2; ++j)
#pragma unroll
            for (int q = 0; q < 4; ++q) { const int c = 16 * lane + 1024 * j + 4 * q; const f32x4 xv = *(const f32x4*)(x1r + c), gv = *(const f32x4*)(g2 + c);
#pragma unroll
                for (int e = 0; e < 4; ++e) { const int i = 16 * j + 4 * q + e; acc[i] = xv[e] * ALPHA + gv[e] * acc[i]; s += acc[i]; } }
        const float mu = wave_sum(s) * (1.0f / D); float qq = 0.f;
#pragma unroll
        for (int i = 0; i < 32; ++i) { acc[i] -= mu; qq += acc[i] * acc[i]; }
        const float rstd = 1.0f / sqrtf(wave_sum(qq) * (1.0f / D) + LN_EPS);
        float* yo = a.out + (m < MP ? O_YP + (size_t)m * D : O_YS + (size_t)(m - MP) * D);
#pragma unroll
        for (int j = 0; j < 2; ++j)
#pragma unroll
            for (int q = 0; q < 4; ++q) { const int c = 16 * lane + 1024 * j + 4 * q; const f32x4 gg = *(const f32x4*)(a.in[29] + c), bb = *(const f32x4*)(a.in[30] + c); f32x4 o;
#pragma unroll
                for (int e = 0; e < 4; ++e) o[e] = acc[16 * j + 4 * q + e] * rstd * gg[e] + bb[e];
                *(f32x4*)(yo + c) = o; }
    }
}


#ifndef SLAB_SYNC
#define SLAB_SYNC 1
#endif
constexpr int TPB = 68;
__device__ __forceinline__ float dot16_fp8(const u32x4 w, const f32x4 h0, const f32x4 h1, const f32x4 h2, const f32x4 h3) {
    const f32x2v a0 = __builtin_amdgcn_cvt_pk_f32_fp8((int)w.x, false), a1 = __builtin_amdgcn_cvt_pk_f32_fp8((int)w.x, true), b0 = __builtin_amdgcn_cvt_pk_f32_fp8((int)w.y, false), b1 = __builtin_amdgcn_cvt_pk_f32_fp8((int)w.y, true);
    const f32x2v c0 = __builtin_amdgcn_cvt_pk_f32_fp8((int)w.z, false), c1 = __builtin_amdgcn_cvt_pk_f32_fp8((int)w.z, true), d0 = __builtin_amdgcn_cvt_pk_f32_fp8((int)w.w, false), d1 = __builtin_amdgcn_cvt_pk_f32_fp8((int)w.w, true);
    return ((a0.x * h0[0] + a0.y * h0[1]) + (a1.x * h0[2] + a1.y * h0[3])) + ((b0.x * h1[0] + b0.y * h1[1]) + (b1.x * h1[2] + b1.y * h1[3]))
         + ((c0.x * h2[0] + c0.y * h2[1]) + (c1.x * h2[2] + c1.y * h2[3])) + ((d0.x * h3[0] + d0.y * h3[1]) + (d1.x * h3[2] + d1.y * h3[3]));
}
__device__ __forceinline__ float red8(float x) {
    x += __builtin_bit_cast(float, __builtin_amdgcn_update_dpp(0, __builtin_bit_cast(int, x), 0xB1, 0xF, 0xF, true));
    x += __builtin_bit_cast(float, __builtin_amdgcn_update_dpp(0, __builtin_bit_cast(int, x), 0x4E, 0xF, 0xF, true));
    x += __builtin_bit_cast(float, __builtin_amdgcn_update_dpp(0, __builtin_bit_cast(int, x), 0x141, 0xF, 0xF, true));
    return x;
}
__device__ __forceinline__ f32x2 fma2(f32x2 a, f32x2 b, f32x2 c) { return a * b + c; }
__device__ __forceinline__ void p12_scores(const Ctx& X, CArgs& a, const XcdBarrier& bar, bool gsync) {
    unsigned char* ws = a.ws; const float* X1 = (const float*)(ws + WS_T); const float* ADA = (const float*)(ws + WS_ADA);
    const int* EID = (const int*)(ws + WS_EID); const float* GATE = (const float*)(ws + WS_GATE); float* COEF = (float*)(ws + WS_COEF);
    const unsigned char* U8 = ws + WS_U8; const float* PSC = (const float*)(ws + WS_PSC);
    LAS int* eidl = (LAS int*)X.lds;
    LAS float* h2s = (LAS float*)(X.lds + TPB * 128 * 4);
    LAS float* scl = (LAS float*)(X.lds + 2 * TPB * 128 * 4);
    const int tid = X.tid, lane = X.lane, w = X.wave, pr = lane >> 3, c = lane & 7;
    for (int tb0 = X.vcu * TPB; tb0 < M; tb0 += X.G * TPB) {
        const int ntok = (M - tb0) < TPB ? (M - tb0) : TPB;
        __syncthreads();
        for (int i = tid; i < ntok * 128; i += NTHREADS) { eidl[i] = EID[(size_t)tb0 * 128 + i]; scl[i] = 0.f; }
        __syncthreads();
        const unsigned char* H8 = ws + WS_H2I + (size_t)tb0 * D + 16 * c;
        {
            const int ntw = ntok > w ? (ntok - w + 7) / 8 : 0, ntask = 16 * ntw;
            u32x4 pA[16], pB[16]; u32x4 hA = (u32x4){0u, 0u, 0u, 0u}, hB = hA;
            const unsigned c16 = 16u * (unsigned)c; const bool up4 = (c & 4) != 0, up2 = (c & 2) != 0, up1 = (c & 1) != 0;
#define G12_LOAD(P, H, LT, SL) { const unsigned char* slab_ = U8 + (size_t)(SL) * SLAB_BYTES; H = *(const u32x4*)(H8 + (size_t)(LT) * D + (SL) * 128); \
                _Pragma("unroll") for (int it = 0; it < 16; ++it) P[it] = *(const u32x4*)(slab_ + (((unsigned)eidl[(LT) * 128 + 8 * it + pr] << 7) + c16)); }
#define G12_DPPI(X_, CTRL) __builtin_amdgcn_update_dpp(0, (X_), (CTRL), 0xF, 0xF, true)
#define G12_PROC(P, H, LT) { int xs[16];     \
                _Pragma("unroll") for (int it = 0; it < 16; ++it) { const u32x4 q = P[it]; int ia = __builtin_amdgcn_sdot4((int)q.x, (int)H.x, 0, false); ia = __builtin_amdgcn_sdot4((int)q.y, (int)H.y, ia, false); \
                    ia = __builtin_amdgcn_sdot4((int)q.z, (int)H.z, ia, false); ia = __builtin_amdgcn_sdot4((int)q.w, (int)H.w, ia, false); xs[it] = ia; } \
                int ys[8], zs[4]; \
                _Pragma("unroll") for (int jj = 0; jj < 8; ++jj) { const int lo = jj < 4 ? jj : jj + 4; const int keep = up4 ? xs[lo + 4] : xs[lo], send = up4 ? xs[lo] : xs[lo + 4]; ys[jj] = keep + G12_DPPI(send, 0x141); } \
                _Pragma("unroll") for (int qq = 0; qq < 4; ++qq) { const int lo = 4 * (qq >> 1) + (qq & 1); const int keep = up2 ? ys[lo + 2] : ys[lo], send = up2 ? ys[lo] : ys[lo + 2]; zs[qq] = keep + G12_DPPI(send, 0x4E); } \
                int wa, wb; \
                { const int keep = up1 ? zs[1] : zs[0], send = up1 ? zs[0] : zs[1]; wa = keep + G12_DPPI(send, 0xB1); } \
                { const int keep = up1 ? zs[3] : zs[2], send = up1 ? zs[2] : zs[3]; wb = keep + G12_DPPI(send, 0xB1); } \
                scl[(LT) * 128 + 8 * c + pr] += (float)wa; scl[(LT) * 128 + 8 * (c + 8) + pr] += (float)wb; }
            int sl = 0, lt = w;
            if (ntask > 0) G12_LOAD(pA, hA, w, 0)
#pragma unroll 1
            for (int k = 0; k < ntask; k += 2) {
                { int ln = lt + 8, sn = sl; if (ln >= ntok) { ln = w; ++sn; }
                  if (k + 1 < ntask) G12_LOAD(pB, hB, ln, sn)
                  G12_PROC(pA, hA, lt)
                  lt = ln; sl = sn; }
                if (k + 1 >= ntask) break;
                { int ln = lt + 8, sn = sl; if (ln >= ntok) { ln = w; ++sn; }
                  if (k + 2 < ntask) G12_LOAD(pA, hA, ln, sn)
                  G12_PROC(pB, hB, lt)
                  lt = ln; sl = sn; }
            }
        }
        __syncthreads();
        for (int i = tid; i < ntok * 128; i += NTHREADS) { const int e = eidl[i]; const size_t o = (size_t)tb0 * 128 + i;
            const float d = scl[i] * PSC[e] * ((const float*)(ws + WS_HSC))[tb0 + (i >> 7)]; const float act = 0.5f * d * (1.0f + erff(d * 0.70710678118654752f));
            COEF[o] = GATE[o] * act * PSC[16384 + e]; }
    }
}
__device__ __forceinline__ void p12_values(const Ctx& X, CArgs& a, const XcdBarrier& bar, bool gsync) {
    unsigned char* ws = a.ws; const int* EID = (const int*)(ws + WS_EID); const float* COEF = (const float*)(ws + WS_COEF);
    const unsigned char* V8 = ws + WS_V8; bf16_t* PEERO = (bf16_t*)(ws + WS_PEERO);
    LAS int* eidl = (LAS int*)X.lds;
    LAS float* cfl = (LAS float*)(X.lds + TPB * 128 * 4);
    LAS unsigned* cf8 = (LAS unsigned*)(X.lds + 2 * TPB * 128 * 4);
    LAS float* tsc = (LAS float*)(X.lds + 3 * TPB * 128 * 4);
    const int tid = X.tid, lane = X.lane, w = X.wave, r = lane >> 3, c = lane & 7;
    const bool up8 = (lane & 8) != 0;
    const int di = lane & 15, kb = lane >> 4;
    const unsigned bm = 0xFFu << (8 * (di & 3));
    const unsigned m0 = (di >> 2) == 0 ? bm : 0u, m1 = (di >> 2) == 1 ? bm : 0u, m2 = (di >> 2) == 2 ? bm : 0u, m3 = (di >> 2) == 3 ? bm : 0u;
    (void)bar; (void)gsync;
    for (int tb0 = X.vcu * TPB; tb0 < M; tb0 += X.G * TPB) {
        const int ntok = (M - tb0) < TPB ? (M - tb0) : TPB;
        __syncthreads();
        for (int i = tid; i < ntok * 128; i += NTHREADS) { eidl[i] = EID[(size_t)tb0 * 128 + i]; cfl[i] = COEF[(size_t)tb0 * 128 + i]; }
        __syncthreads();
        for (int t = w; t < ntok; t += NWAVES) {
            const float c0 = cfl[t * 128 + lane], c1 = cfl[t * 128 + 64 + lane]; const float am = wave_max(fmaxf(fabsf(c0), fabsf(c1))); const float qs = am > 0.f ? 224.0f / am : 1.0f;
            const unsigned p = (unsigned)__builtin_amdgcn_cvt_pk_fp8_f32(c0 * qs, c1 * qs, 0, false);
            cf8[t * 128 + lane] = (p & 0xFFu) * 0x01010101u; cf8[t * 128 + 64 + lane] = ((p >> 8) & 0xFFu) * 0x01010101u; if (lane == 0) tsc[t] = am > 0.f ? am / 224.0f : 1.0f; }
        {
            const int ntw = ntok > w ? (ntok - w + 7) / 8 : 0, ntask = 16 * ntw;
            u32x4 pA[16], pB[16];
            const unsigned c16 = 16u * (unsigned)c;
#define G13_LOAD(P, LT, SL) { const unsigned char* slab_ = V8 + (size_t)(SL) * SLAB_BYTES; \
                _Pragma("unroll") for (int it = 0; it < 16; ++it) P[it] = *(const u32x4*)(slab_ + (((unsigned)eidl[(LT) * 128 + 8 * it + r] << 7) + c16)); }
#define G13_PROC(P, LT, SL) { f32x4 d0 = {0.f, 0.f, 0.f, 0.f}, d1 = {0.f, 0.f, 0.f, 0.f}; \
                _Pragma("unroll") for (int pp = 0; pp < 8; ++pp) { \
                    const u32x2 ca = *(const LAS u32x2*)(cf8 + (LT) * 128 + 16 * pp + 2 * kb), cb = *(const LAS u32x2*)(cf8 + (LT) * 128 + 16 * pp + 8 + 2 * kb); \
                    const pg8::i32x8 A0 = {(int)(ca.x & m0), (int)(ca.x & m1), (int)(ca.x & m2), (int)(ca.x & m3), (int)(cb.x & m0), (int)(cb.x & m1), (int)(cb.x & m2), (int)(cb.x & m3)}; \
                    const pg8::i32x8 A1 = {(int)(ca.y & m0), (int)(ca.y & m1), (int)(ca.y & m2), (int)(ca.y & m3), (int)(cb.y & m0), (int)(cb.y & m1), (int)(cb.y & m2), (int)(cb.y & m3)}; \
                    const u32x4 b0 = P[2 * pp], b1 = P[2 * pp + 1]; \
                    const pg8::i32x8 Bv = {(int)b0.x, (int)b0.y, (int)b0.z, (int)b0.w, (int)b1.x, (int)b1.y, (int)b1.z, (int)b1.w}; \
                    d0 = __builtin_amdgcn_mfma_scale_f32_16x16x128_f8f6f4(A0, Bv, d0, 0, 0, 0, 0x7F7F7F7F, 0, 0x7F7F7F7F); \
                    d1 = __builtin_amdgcn_mfma_scale_f32_16x16x128_f8f6f4(A1, Bv, d1, 0, 0, 0, 0x7F7F7F7F, 0, 0x7F7F7F7F); } \
                  \
                float y0 = d1[0], y1 = d1[1], y2 = d1[2], y3 = d1[3], z0 = d0[0], z1 = d0[1], z2 = d0[2], z3 = d0[3]; \
                asm volatile("" : "+v"(y0), "+v"(y1), "+v"(y2), "+v"(y3), "+v"(z0), "+v"(z1), "+v"(z2), "+v"(z3));     \
                float x0 = __builtin_bit_cast(float, __builtin_amdgcn_update_dpp(0, __builtin_bit_cast(int, y0), 0x128, 0xF, 0xF, true)), x1 = __builtin_bit_cast(float, __builtin_amdgcn_update_dpp(0, __builtin_bit_cast(int, y1), 0x128, 0xF, 0xF, true)); \
                float x2 = __builtin_bit_cast(float, __builtin_amdgcn_update_dpp(0, __builtin_bit_cast(int, y2), 0x128, 0xF, 0xF, true)), x3 = __builtin_bit_cast(float, __builtin_amdgcn_update_dpp(0, __builtin_bit_cast(int, y3), 0x128, 0xF, 0xF, true)); \
                asm volatile("" : "+v"(x0), "+v"(x1), "+v"(x2), "+v"(x3)); \
                const float ts_ = tsc[(LT)]; \
                if (!up8) { u32x2 pk; pk.x = pk2((z0 + x0) * ts_, (z1 + x1) * ts_); pk.y = pk2((z2 + x2) * ts_, (z3 + x3) * ts_); __builtin_nontemporal_store(pk, (u32x2*)(PEERO + (size_t)(tb0 + (LT)) * D + (SL) * 128 + 16 * c + 4 * kb)); } }
            int sl = 0, lt = w;
            if (ntask > 0) G13_LOAD(pA, w, 0)
#pragma unroll 1
            for (int k = 0; k < ntask; k += 2) {
                { int ln = lt + 8, sn = sl; if (ln >= ntok) { ln = w; ++sn; }
                  if (k + 1 < ntask) G13_LOAD(pB, ln, sn)
                  G13_PROC(pA, lt, sl)
                  lt = ln; sl = sn; }
                if (k + 1 >= ntask) break;
                { int ln = lt + 8, sn = sl; if (ln >= ntok) { ln = w; ++sn; }
                  if (k + 2 < ntask) G13_LOAD(pA, ln, sn)
                  G13_PROC(pB, lt, sl)
                  lt = ln; sl = sn; }
            }
        }
    }
}
__device__ __forceinline__ void p12_final(const Ctx& X, CArgs& a) {
    unsigned char* ws = a.ws; const bf16_t* X1 = (const bf16_t*)(ws + WS_T); const float* ADA = (const float*)(ws + WS_ADA); const bf16_t* PEERO = (const bf16_t*)(ws + WS_PEERO);
    const int lane = X.lane;
    for (int tb0 = X.vcu * TPB; tb0 < M; tb0 += X.G * TPB)
    for (int m = tb0 + X.wave; m < tb0 + TPB && m < M; m += NWAVES) {
        const int b = m < MP ? (m >> 12) : BATCH + ((m - MP) >> 3); const float* g2 = ADA + (size_t)b * 6 * D + 5 * D;
        f32x4 v[8]; float s = 0.f;
#pragma unroll
        for (int j = 0; j < 8; ++j) { const int cc = 4 * lane + 256 * j; const u32x2 pw = *(const u32x2*)(PEERO + (size_t)m * D + cc); const f32x4 pe = {bflo(pw.x), bfhi(pw.x), bflo(pw.y), bfhi(pw.y)};
            const u32x2 xw = *(const u32x2*)(X1 + (size_t)m * D + cc); const f32x4 xv = {bflo(xw.x), bfhi(xw.x), bflo(xw.y), bfhi(xw.y)};
            v[j] = xv * ALPHA + *(const f32x4*)(g2 + cc) * pe; s += (v[j][0] + v[j][1]) + (v[j][2] + v[j][3]); }
        const float mu = wave_sum(s) * (1.0f / D); float q = 0.f;
#pragma unroll
        for (int j = 0; j < 8; ++j) { v[j] = v[j] - mu; q += (v[j][0] * v[j][0] + v[j][1] * v[j][1]) + (v[j][2] * v[j][2] + v[j][3] * v[j][3]); }
        const float rstd = 1.0f / sqrtf(wave_sum(q) * (1.0f / D) + LN_EPS);
        float* yo = a.out + (m < MP ? O_YP + (size_t)m * D : O_YS + (size_t)(m - MP) * D);
#pragma unroll
        for (int j = 0; j < 8; ++j) { const int cc = 4 * lane + 256 * j; *(f32x4*)(yo + cc) = v[j] * rstd * *(const f32x4*)(a.in[29] + cc) + *(const f32x4*)(a.in[30] + cc); }
    }
}


#ifndef SELFCHECK
#define SELFCHECK 0
#endif
#ifndef SC_TOL_ATT
#define SC_TOL_ATT 0.05f
#define SC_TOL_ML 0.05f
#define SC_TOL_TOPK 8u
#define SC_TOL_PEER 0.15f
#endif
#if SELFCHECK
__device__ __forceinline__ void chk_max(unsigned* w, float v) { atomicMax(w, __float_as_uint(fabsf(v))); }
__device__ __forceinline__ void chk_mlstm_unit(const Ctx& X, CArgs& a, unsigned* CHK, size_t row0, int T, int h, int vs, const float* C0, const float* n0, const float* m0p, const float* convbuf) {
    unsigned char* ws = a.ws; const bf16_t* BIG = (const bf16_t*)(ws + WS_BIG); const float* MIF = (const float*)(ws + WS_MIF); const bf16_t* HRAW = (const bf16_t*)(ws + WS_HMO);
    LAS float* qk = (LAS float*)X.lds; LAS float* red = qk + 512; LAS float* nred = red + 512;
    const int tid = X.tid, g = tid >> 6, dv = tid & 63;
    const int ch = tid < 256 ? h * 256 + tid : 1024 + h * 256 + (tid - 256);
    const float w0 = a.in[16][ch], w1 = a.in[16][2048 + ch], w2 = a.in[16][4096 + ch], w3 = a.in[16][6144 + ch], cb = a.in[17][ch];
    float x1 = 0.f, x2 = 0.f, x3 = 0.f;
    if (convbuf) { x3 = convbuf[ch]; x2 = convbuf[2048 + ch]; x1 = convbuf[4096 + ch]; }
    float C[32], nn = 0.f, mprev = 0.f, emax = 0.f, rmax = 0.f;
#pragma unroll
    for (int j = 0; j < 32; ++j) C[j] = C0 ? C0[(size_t)(32 * g + j) * DV + vs * 64 + dv] : 0.f;
    if (n0 && tid < 256) nn = n0[tid];
    if (m0p) mprev = m0p[0];
    __syncthreads();
    for (int t = 0; t < T; ++t) { const size_t r = row0 + t;
        const float x0 = bf2f(BIG[r * NW + C_MQK + ch]), vin = bf2f(BIG[r * NW + C_MV + h * DV + vs * 64 + dv]), iv_ = MIF[r * 8 + h], lf = MIF[r * 8 + 4 + h];
        float y = cb + x3 * w0; y = y + x2 * w1; y = y + x1 * w2; y = y + x0 * w3; x3 = x2; x2 = x1; x1 = x0;
        float sv = y / (1.0f + expf(-y)); if (tid >= 256) sv *= 0.0625f; qk[tid] = sv;
        __syncthreads();
        const float mnew = fmaxf(lf + mprev, iv_), fg = expf(lf + mprev - mnew), ig = expf(iv_ - mnew), iv = ig * vin;
        float ph = 0.f;
#pragma unroll
        for (int j = 0; j < 32; ++j) { const float kk = qk[256 + 32 * g + j], qq = qk[32 * g + j]; C[j] = fg * C[j] + kk * iv; ph += qq * C[j]; }
        red[g * 64 + dv] = ph;
        if (tid < 256) { nn = fg * nn + ig * qk[256 + tid]; float pn = qk[tid] * nn; pn = wave_sum(pn); if (X.lane == 0) nred[X.wave] = pn; }
        __syncthreads();
        if (tid < 64) { float hs = 0.f;
#pragma unroll
            for (int gg = 0; gg < 8; ++gg) hs += red[gg * 64 + tid];
            const float qn = (nred[0] + nred[1]) + (nred[2] + nred[3]); const float ref = C0 ? hs / fmaxf(fabsf(qn), expf(-mnew)) : hs;
            const float got = bf2f(HRAW[r * D + h * DV + vs * 64 + tid]); emax = fmaxf(emax, fabsf(got - ref)); rmax = fmaxf(rmax, fabsf(ref)); }
        mprev = mnew;
    }
    if (tid < 64) { chk_max(CHK + 2, emax); chk_max(CHK + 3, rmax); }
    __syncthreads();
}
__device__ __forceinline__ void chk_att_wave(const Ctx& X, CArgs& a, unsigned* CHK, int m, int head) {
    unsigned char* ws = a.ws; const bf16_t* BIG = (const bf16_t*)(ws + WS_BIG); const bf16_t* ATT = (const bf16_t*)(ws + WS_H1);
    const int d = X.lane, kvh = head >> 2; const bool prompt = m < MP; const int t = prompt ? (m & (SEQ - 1)) : ((m - MP) & 7), bs = prompt ? 0 : ((m - MP) >> 3);
    const float q = bf2f(BIG[(size_t)m * NW + C_AQ + head * 64 + d]);
    float mx = a.in[19][head], l = 1.0f, acc = 0.f;
    const int nk = prompt ? (t < 127 ? t + 1 : 128) : 128;
    for (int dist = 0; dist < nk; ++dist) { float kd, vd;
        if (prompt) { const size_t r = (size_t)(m - dist); kd = bf2f(BIG[r * NW + C_AK + kvh * 64 + d]); vd = bf2f(BIG[r * NW + C_AV + kvh * 64 + d]); }
        else { const int j = t + 128 - dist; if (j < 128) { const size_t o = (((size_t)bs * 128 + j) * KVH + kvh) * HD + d; kd = bf2f((bf16_t)f2bf(a.in[4][o])); vd = bf2f((bf16_t)f2bf(a.in[5][o])); }
               else { const size_t r = (size_t)MP + bs * 8 + (j - 128); kd = bf2f(BIG[r * NW + C_AK + kvh * 64 + d]); vd = bf2f(BIG[r * NW + C_AV + kvh * 64 + d]); } }
        const float s = wave_sum(q * kd) * 0.125f + a.in[10][t5_bucket(dist) * HEADS + head];
        const float mn = fmaxf(mx, s), sc = expf(mx - mn), p = expf(s - mn); l = l * sc + p; acc = acc * sc + p * vd; mx = mn; }
    const unsigned char* A8 = ws + WS_ATT8; const float ref = acc / l, got = __builtin_amdgcn_cvt_f32_fp8((int)A8[(size_t)m * D + head * 64 + d], 0) * (1.0f / ACT_S);
    chk_max(CHK + 0, got - ref); chk_max(CHK + 1, ref);
}
__device__ __forceinline__ void selfcheck_a(const Ctx& X, CArgs& a, unsigned* CHK) {
    if (blockIdx.x == 0) chk_mlstm_unit(X, a, CHK, (size_t)1 * SEQ, SEQ, 2, 4, nullptr, nullptr, nullptr, nullptr);
    else if (blockIdx.x == 1) { const int b = 77, h = 1; const size_t bh = (size_t)b * MLH + h; chk_mlstm_unit(X, a, CHK, (size_t)MP + b * 8, 8, h, 2, a.in[7] + bh * DK * DV, a.in[8] + bh * DK, a.in[9] + bh, a.in[6] + (size_t)b * 3 * 2048); }
    else if (blockIdx.x == 2) chk_mlstm_unit(X, a, CHK, (size_t)3 * SEQ, SEQ, 0, 7, nullptr, nullptr, nullptr, nullptr);
    else if (blockIdx.x < 40) { const int i = ((int)blockIdx.x - 3) * NWAVES + X.wave;
        int m; if (i < 16) { const int sp[16] = {0, 1, 126, 127, 128, 129, 255, 256, 4095, 4096, 4097, 4223, 4224, 8191, 12288, 16383}; m = sp[0];
#pragma unroll
            for (int z = 1; z < 16; ++z) m = (i == z) ? sp[z] : m; }
        else if (i < 200) m = (int)(((unsigned)i * 2654435761u) % (unsigned)MP); else m = MP + (int)(((unsigned)i * 40503u) % (unsigned)MS);
        chk_att_wave(X, a, CHK, m, (i * 7 + (i >> 3)) & 31); }
}
__device__ __forceinline__ void selfcheck_b(const Ctx& X, CArgs& a, unsigned* CHK) {
    unsigned char* ws = a.ws; const bf16_t* QP = (const bf16_t*)(ws + WS_H1); const bf16_t* SKB = (const bf16_t*)(ws + WS_SKB); const int* EID = (const int*)(ws + WS_EID); const float* GATE = (const float*)(ws + WS_GATE);
    const bf16_t* X1 = (const bf16_t*)(ws + WS_T); const float* ADA = (const float*)(ws + WS_ADA); const bf16_t* PEERO = (const bf16_t*)(ws + WS_PEERO);
    LAS float* sc = (LAS float*)X.lds;
    LAS float* red = sc + 2048;
    LAS int* refe = (LAS int*)(red + 16);
    const int tid = X.tid, lane = X.lane, w = X.wave;
    const int toks[8] = {5, 4100, 9000, 16383, 16384, 17000, 17407, 12345};
    for (int ti = 0; ti < 8; ++ti) { int m = toks[0];
#pragma unroll
        for (int z = 1; z < 8; ++z) m = (ti == z) ? toks[z] : m;
        __syncthreads();
        for (int p = 0; p < 2; ++p) for (int kk = 0; kk < 2; ++kk) { const int key = lane + 64 * kk; float s = 0.f;
            for (int d = 0; d < 128; ++d) s += bf2f(QP[(size_t)m * D + w * DQ + p * 128 + d]) * bf2f(SKB[((size_t)(w * 2 + p) * NKEYS + key) * 128 + d]);
            sc[(w * 2 + p) * 128 + key] = s; }
        __syncthreads();
        if (lane == 0) { int ia[16], ib[16]; float va[16], vb[16];
            LAS float* s0 = sc + (w * 2) * 128; LAS float* s1 = s0 + 128;
            for (int j = 0; j < 16; ++j) { int bi = 0; float bvv = -3.0e38f; for (int k = 0; k < 128; ++k) { const float v = s0[k]; if (v > bvv) { bvv = v; bi = k; } } s0[bi] = -3.0e38f; refe[w * 16 + j] = bi; red[0] = 0.f; ((LAS float*)refe)[128 + w * 16 + j] = bvv; }
            (void)ia; (void)ib; (void)va; (void)vb; }
        __syncthreads();
        LAS int* ia_ = refe; LAS float* va_ = (LAS float*)refe + 128; LAS int* ib_ = refe + 256; LAS float* vb_ = (LAS float*)refe + 384; LAS int* out_ = refe + 512;
        if (lane == 0) { LAS float* s1 = sc + (w * 2 + 1) * 128;
            for (int j = 0; j < 16; ++j) { int bi = 0; float bvv = -3.0e38f; for (int k = 0; k < 128; ++k) { const float v = s1[k]; if (v > bvv) { bvv = v; bi = k; } } s1[bi] = -3.0e38f; ib_[w * 16 + j] = bi; vb_[w * 16 + j] = bvv; }
            LAS float* cand = sc + (w * 2) * 128;
            for (int i = 0; i < 16; ++i) for (int j = 0; j < 16; ++j) cand[i * 16 + j] = va_[w * 16 + i] + vb_[w * 16 + j];
            int miss = 0;
            for (int j = 0; j < 16; ++j) { int bi = 0; float bvv = -3.0e38f; for (int k = 0; k < 256; ++k) { const float v = cand[k]; if (v > bvv) { bvv = v; bi = k; } } cand[bi] = -3.0e38f;
                const int e = ia_[w * 16 + (bi >> 4)] * NKEYS + ib_[w * 16 + (bi & 15)]; bool found = false;
                for (int q = 0; q < 16; ++q) found = found || (EID[((size_t)m * PH + w) * 16 + q] == e);
                miss += found ? 0 : 1; }
            out_[w] = miss; atomicAdd(CHK + 4, (unsigned)miss); }
        __syncthreads();
        { const int b = m < MP ? (m >> 12) : BATCH + ((m - MP) >> 3); const float* ab = ADA + (size_t)b * 6 * D; const int c0 = tid * 4;
          const u32x2 xw_ = *(const u32x2*)(X1 + (size_t)m * D + c0); const f32x4 xv = {bflo(xw_.x), bfhi(xw_.x), bflo(xw_.y), bfhi(xw_.y)}; const f32x4 h2 = xv * (*(const f32x4*)(ab + 4 * D + c0) + 1.0f) + *(const f32x4*)(ab + 3 * D + c0);
          f32x4 acc = (f32x4){0.f, 0.f, 0.f, 0.f};
          for (int k = 0; k < 128; ++k) { const int e = EID[(size_t)m * 128 + k]; const float gk = GATE[(size_t)m * 128 + k];
              const f32x4 uv = *(const f32x4*)(a.in[27] + (size_t)e * D + c0); float dd = (uv[0] * h2[0] + uv[1] * h2[1]) + (uv[2] * h2[2] + uv[3] * h2[3]); dd = wave_sum(dd);
              __syncthreads(); if (lane == 0) red[w] = dd; __syncthreads();
              float dt = 0.f;
#pragma unroll
              for (int z = 0; z < 8; ++z) dt += red[z];
              const float cf = gk * 0.5f * dt * (1.0f + erff(dt * 0.70710678118654752f));
              acc = acc + *(const f32x4*)(a.in[28] + (size_t)e * D + c0) * cf; }
          const u32x2 gw_ = *(const u32x2*)(PEERO + (size_t)m * D + c0); const f32x4 got = {bflo(gw_.x), bfhi(gw_.x), bflo(gw_.y), bfhi(gw_.y)};
#pragma unroll
          for (int z = 0; z < 4; ++z) { chk_max(CHK + 5, got[z] - acc[z]); chk_max(CHK + 6, acc[z]); } }
    }
    __syncthreads();
    if (tid == 0) { const float qn = __builtin_nanf("");
        const float ea = __uint_as_float(atomicAdd(CHK + 0, 0u)), ra = __uint_as_float(atomicAdd(CHK + 1, 0u)), em = __uint_as_float(atomicAdd(CHK + 2, 0u)), rm = __uint_as_float(atomicAdd(CHK + 3, 0u));
        const unsigned miss = atomicAdd(CHK + 4, 0u); const float ep = __uint_as_float(atomicAdd(CHK + 5, 0u)), rp = __uint_as_float(atomicAdd(CHK + 6, 0u));
        if (!(ea <= SC_TOL_ATT * ra) || !(ra > 0.f)) a.out[O_YP] = qn;
        if (!(em <= SC_TOL_ML * rm) || !(rm > 0.f)) a.out[O_YS] = qn;
        if (miss > SC_TOL_TOPK) a.out[O_KWP] = qn;
        if (!(ep <= SC_TOL_PEER * rp) || !(rp > 0.f)) a.out[O_VWP] = qn; }
}
#endif

#ifdef NO_ATT
#define ATT_CALL(...) do {} while (0)
#else
#define ATT_CALL(...) p4_attention(__VA_ARGS__)
#endif
constexpr int NPHASE = 15;
__global__ void __launch_bounds__(NTHREADS, 2) fwd_kernel(Args args) {
    extern __shared__ __attribute__((aligned(16))) unsigned char lds_raw[];
    Ctx X; X.lds = (LAS unsigned char*)lds_raw; X.tid = threadIdx.x; X.lane = X.tid & 63; X.wave = __builtin_amdgcn_readfirstlane(X.tid >> 6);
    X.G = gridDim.x; { const int bx = blockIdx.x; X.vcu = (X.G % 8 == 0) ? (bx % 8) * (X.G / 8) + bx / 8 : bx; }
    volatile LAS unsigned* MISC = (volatile LAS unsigned*)(X.lds + MISC_OFF);
    for (int u = X.tid; u < (LDS_BYTES - LDSCTL_OFF) / 4; u += NTHREADS) ((LAS unsigned*)(X.lds + LDSCTL_OFF))[u] = 0u;
    __syncthreads();
    CArgs& A4 = *(CArgs*)__builtin_amdgcn_kernarg_segment_ptr();
    unsigned char* ws = A4.ws;
    const bool multi = (args.ph_hi - args.ph_lo) > 1;
    XcdBarrier bar; bar.bar = (unsigned*)(ws + WS_CTL) + CW_BAR; bar.x = 0; bar.st = nullptr;
    if (multi) bar = xcd_barrier_post((unsigned*)(ws + WS_CTL) + CW_BAR, MISC + 8);
    const int lo = args.ph_lo, hi = args.ph_hi;
#ifndef PHMASK
#define PHMASK 0xFFFF
#endif
#define IN(k) (((PHMASK >> (k)) & 1) && lo <= (k) && (k) < hi)
#define SEAM(k) do { if (IN(k) && (IN((k) + 1) || ((k) == 4 && IN(6)) || ((k) == 10 && IN(12)))) xcd_barrier(bar); } while (0)
    bf16_t* W4T = (bf16_t*)(ws + WS_W4T);

    if (IN(0)) {
        bf16_t* SC = (bf16_t*)(ws + WS_ADA + 6 * MiB + 262144); unsigned* scnt = (unsigned*)(ws + WS_CTL) + 16384;
        p0_silu_c(X, A4.in[2], A4.in[3], SC);
        asm volatile("s_waitcnt vmcnt(0)" ::: "memory"); __syncthreads();
        if (gridDim.x > 1 && threadIdx.x == 0) { __builtin_amdgcn_fence(__ATOMIC_RELEASE, "agent"); asm volatile("s_waitcnt vmcnt(0)" ::: "memory"); xb_add(scnt, 1u); }
        p0_transposes(X, A4);
        if (gridDim.x > 1 && threadIdx.x == 0) { XB_SPIN(xb_ld(scnt) < gridDim.x, bar.bar); __builtin_amdgcn_fence(__ATOMIC_ACQUIRE, "agent"); asm volatile("s_waitcnt vmcnt(0)" ::: "memory"); }
        __syncthreads();
        p0_ada(X, SC, A4.in[11], A4.in[12], (float*)(ws + WS_ADA)); }
    SEAM(0);
    if (IN(1)) { p1_rows(X, A4); }
    SEAM(1);
    if (IN(2)) { if (X.vcu < 16) { p2_gates(X, A4, X.vcu); if (X.G < 16) for (int u = X.vcu + X.G; u < 16; u += X.G) p2_gates(X, A4, u); }
        {
            pg8::Gemm g{(const bf16_t*)(ws + WS_H1), (const bf16_t*)(ws + WS_WINT), M, NW, D, D}; pg8::P2Bf16Order S{X.G, (int)blockIdx.x};
            pg8::EpiBig E{(bf16_t*)(ws + WS_BIG), NW, 1 << 30, 1 << 30, 0, 0, 1.0f};
            pg8::gemm_phase<pg8::EpiBig, pg8::P2Bf16Order>(X.lds, g, S, E); }
        {
            pg8::Gemm g{(const bf16_t*)(ws + WS_H1F8), (const bf16_t*)(ws + WS_WINF8), M, NW, D / 2, D / 2}; pg8::P2F8Order S{X.G, (int)(X.G - 1 - blockIdx.x)};
            pg8::EpiBig E{(bf16_t*)(ws + WS_BIG), NW, C_MO / 256, 1 << 30, 0, 0, 1.0f / (ACT_S * W_S)};
            pg8::gemm_phase<pg8::EpiBig, pg8::P2F8Order, true>(X.lds, g, S, E); } }
    SEAM(2);
    if (IN(3)) {
#ifndef T_NOPREP
        for (int u = X.vcu; u < 1024; u += X.G) m1_prep_unit(X, A4, u >> 6, u & 63);
#endif
        asm volatile("" ::: "memory");
#ifndef T_NOSAMP
        for (int u = X.vcu; u < SAMP_P3; u += X.G) m1_sample_unit(X, A4, u);
#endif
        for (int u = X.vcu; u < ATT_P3; u += X.G) { const int qb = u & 31, kvh = (u >> 5) & 7, b = u >> 8; att_prompt_unit(X, A4, b, kvh, qb); }
        __syncthreads();
        }
    SEAM(3);
    if (IN(4)) { if (X.G >= 256) { if (X.vcu < 128) { if (!(args.flags & 1)) m2_scan_unit(X, A4, X.vcu >> 3, X.vcu & 7); } else { if (!(args.flags & 2)) { if (X.vcu - 128 < 16) m2_nchain_unit(X, A4, X.vcu - 128); for (int u = SAMP_P3 + X.vcu - 128; u < 512; u += X.G - 128) m1_sample_unit(X, A4, u); p3_sample_attention(X, A4, X.vcu - 128, X.G - 128); ATT_CALL(X, A4, X.vcu - 128, X.G - 128); } } }
                 else { for (int u = X.vcu; u < 128; u += X.G) m2_scan_unit(X, A4, u >> 3, u & 7); for (int u = X.vcu; u < 16; u += X.G) m2_nchain_unit(X, A4, u); for (int u = SAMP_P3 + X.vcu; u < 512; u += X.G) m1_sample_unit(X, A4, u); p3_sample_attention(X, A4, X.vcu, X.G); ATT_CALL(X, A4, X.vcu, X.G); } }
    SEAM(4);
#if SELFCHECK
    if (multi) { selfcheck_a(X, A4, (unsigned*)(ws + WS_CTL) + 65536); xcd_barrier(bar); }
#endif
    if (IN(6)) { pg8::Gemm g{(const bf16_t*)(ws + WS_ATT8), (const bf16_t*)(ws + WS_W4F8), M, D, D / 2, D / 2}; pg8::StaticOrder S; S.init(M, D, X.G, (int)blockIdx.x);
        pg8::EpiGate<false> E{(bf16_t*)(ws + WS_Z), (const bf16_t*)(ws + WS_BIG) + C_GA, NW, 1.0f / (ACT_S * W_S), nullptr};
        pg8::gemm_phase<pg8::EpiGate<false>, pg8::StaticOrder, true>(X.lds, g, S, E);
        if (X.G > 32) { if ((int)blockIdx.x >= 32) p3_headnorm(X, A4, (int)blockIdx.x - 32, X.G - 32); } else p3_headnorm(X, A4, (int)blockIdx.x, X.G); }
    SEAM(6);
    if (IN(7)) { pg8::Gemm g{(const bf16_t*)(ws + WS_HMO8), (const bf16_t*)(ws + WS_W4F8 + (size_t)D * D), M, D, D / 2, D / 2}; pg8::StaticOrder S; S.init(M, D, X.G, (int)blockIdx.x);
        pg8::EpiGate<true> E{(bf16_t*)(ws + WS_Z), (const bf16_t*)(ws + WS_BIG) + C_GB, NW, 1.0f / (ACT_S * W_S), ws + WS_Z8};
        pg8::gemm_phase<pg8::EpiGate<true>, pg8::StaticOrder, true>(X.lds, g, S, E);
        if (X.G > 32) { if ((int)blockIdx.x >= 32) p3_state_copies(X, A4, (int)blockIdx.x - 32, X.G - 32); } else p3_state_copies(X, A4, (int)blockIdx.x, X.G); }
    SEAM(7);
    if (IN(8)) { pg8::Gemm g{(const bf16_t*)(ws + WS_Z8), (const bf16_t*)(ws + WS_W4F8 + (size_t)2 * D * D), M, D, D / 2, D / 2}; pg8::StaticOrder S; S.init(M, D, X.G, (int)blockIdx.x);
        pg8::EpiRes E{(bf16_t*)(ws + WS_T), A4.in[0], A4.in[1], (const float*)(ws + WS_ADA), 1.0f / (Z_S * W_S)};
        pg8::gemm_phase<pg8::EpiRes, pg8::StaticOrder, true>(X.lds, g, S, E);
        if (X.G > 32) { if ((int)blockIdx.x >= 32) { p0_peer_fp8(X, A4, 0, (int)blockIdx.x - 32, X.G - 32); p0_peer_fp8(X, A4, 1, (int)blockIdx.x - 32, X.G - 32); } } else { p0_peer_fp8(X, A4, 0, (int)blockIdx.x, X.G); p0_peer_fp8(X, A4, 1, (int)blockIdx.x, X.G); } }
    SEAM(8);
    if (IN(9)) { p6_ln1(X, A4); }
    SEAM(9);
    if (IN(10)) { pg8::Gemm g{(const bf16_t*)(ws + WS_H28), (const bf16_t*)(ws + WS_W4F8 + (size_t)3 * D * D), M, D, D / 2, D / 2}; pg8::StaticOrder S; S.init(M, D, X.G, (int)blockIdx.x);
        pg8::EpiPlain E{(bf16_t*)(ws + WS_H1), 1.0f / (ACT_S * W_S)};
        pg8::gemm_phase<pg8::EpiPlain, pg8::StaticOrder, true>(X.lds, g, S, E);
        p11_topk2(X, A4, &S);
        if (X.G > 32) { if ((int)blockIdx.x >= 32) { p0_peer_fp8(X, A4, 2, (int)blockIdx.x - 32, X.G - 32); p0_peer_fp8(X, A4, 3, (int)blockIdx.x - 32, X.G - 32); } } else { p0_peer_fp8(X, A4, 2, (int)blockIdx.x, X.G); p0_peer_fp8(X, A4, 3, (int)blockIdx.x, X.G); } }
    SEAM(10);
    if (IN(12)) { p12_scores(X, A4, bar, false); }
    if (IN(12) && IN(13)) { asm volatile("s_waitcnt vmcnt(0)" ::: "memory"); __syncthreads(); }
    if (IN(13)) { p12_values(X, A4, bar, false); }
    if (IN(13) && IN(14)) { asm volatile("s_waitcnt vmcnt(0)" ::: "memory"); __syncthreads(); }
    if (IN(14)) { p12_final(X, A4); }
#if SELFCHECK
    if (multi && blockIdx.x == 0) { __syncthreads(); selfcheck_b(X, A4, (unsigned*)(ws + WS_CTL) + 65536); }
#endif
#undef IN
#undef SEAM
}

#ifndef MK_PER_PHASE
#define MK_PER_PHASE 0
#endif
#ifndef MK_REP_MASK
#define MK_REP_MASK 0
#endif
#ifndef MK_REP_N
#define MK_REP_N 3
#endif
#ifndef MK_REP_FLAGS
#define MK_REP_FLAGS 0
#endif
extern "C" void kernel_launch(void* const* d_in, const int* in_sizes, int n_in, void* d_out, int out_size, void* d_ws, size_t ws_size, hipStream_t stream) {
    static int grid = 0;
    if (grid == 0) {
        if (n_in != 31 || (size_t)out_size != O_END || ws_size < WS_END) { fprintf(stderr, "kernel_launch: unexpected shapes: n_in %d out %d ws %zu (need %zu)\n", n_in, out_size, ws_size, (size_t)WS_END); grid = -1; return; }
        int dev = 0, cus = 0;
        if (hipGetDevice(&dev) != hipSuccess || hipDeviceGetAttribute(&cus, hipDeviceAttributeMultiprocessorCount, dev) != hipSuccess) { grid = -1; return; }
        if (hipFuncSetAttribute((const void*)fwd_kernel, hipFuncAttributeMaxDynamicSharedMemorySize, LDS_BYTES) != hipSuccess) { fprintf(stderr, "kernel_launch: hipFuncSetAttribute failed\n"); grid = -1; return; }
        (void)hipGetLastError();
        grid = cus;
    }
    if (grid < 0) return;
    (void)hipMemsetAsync((char*)d_ws + WS_CTL, 0, CTL_ZERO_BYTES, stream);
    Args a{};
    for (int i = 0; i < 31; ++i) a.in[i] = (const float*)d_in[i];
    a.out = (float*)d_out; a.ws = (unsigned char*)d_ws;
#if MK_PER_PHASE
    for (int p = 0; p < NPHASE; ++p) { a.ph_lo = p; a.ph_hi = p + 1; const int nrep = ((MK_REP_MASK >> p) & 1) ? MK_REP_N : 1;
        for (int r = 0; r < nrep; ++r) { a.flags = r > 0 ? MK_REP_FLAGS : 0; hipLaunchKernelGGL(fwd_kernel, dim3(grid), dim3(NTHREADS), LDS_BYTES, stream, a); } }
    a.flags = 0;
#else
    a.ph_lo = 0; a.ph_hi = NPHASE;
    hipLaunchKernelGGL(fwd_kernel, dim3(grid), dim3(NTHREADS), LDS_BYTES, stream, a);
#endif
}
```
